# Optimizing an MI355X kernel written in HIP

```python
import math
import jax
import jax.numpy as jnp
from jax import lax
import numpy as np


D_MODEL = 2048
BATCH = 4
SEQ = 4096
DEPTH = 2

GRID_W = 64
CTX_LEN = 256
EPS = 1e-6
N_AB = (DEPTH + 1) // 2
N_CD = DEPTH // 2
D_FF = 4 * D_MODEL

RWKV_HEADS = 16
RWKV_HD = 64
RWKV_W = RWKV_HEADS * RWKV_HD
DECAY_LORA = 96
AAA_LORA = 96
GATE_LORA = 256
RWKV_COLS = 3 * RWKV_W + DECAY_LORA + AAA_LORA + GATE_LORA
GN_EPS = 64e-5

S5_W = 1024
S5_P = 16
S5_G = S5_W // S5_P
S5_N = 64
AB_IN = RWKV_COLS + S5_W
AB_MIX = RWKV_W + S5_W

SSD_HEADS = 32
SSD_HD = 64
SSD_W = SSD_HEADS * SSD_HD
SSD_GROUPS = 4
SSD_N = 128
SSD_CHUNK = 128
CONV_W = 5
XBC_W = SSD_W + 2 * SSD_GROUPS * SSD_N

ATT_HEADS = 16
KV_HEADS = 4
ATT_HD = 64
ATT_Q_W = ATT_HEADS * ATT_HD
ATT_KV_W = KV_HEADS * ATT_HD
WINDOW = 128
ATT_BLOCK = 128
ROPE_BASE = 10000.0

CD_IN = SSD_W + XBC_W + 2 * SSD_HEADS + ATT_Q_W + 2 * ATT_KV_W
CD_MIX = SSD_W + ATT_Q_W

kernel_name = 'hybrid_rwkv7_s5_ssd_swa_dit'


def rmsnorm(x, g):
    xf = x.astype(jnp.float32)
    xf = xf * lax.rsqrt(jnp.mean(xf * xf, axis=-1, keepdims=True) + EPS)
    return xf.astype(x.dtype) * g


def modulate(h, shift, scale):
    return h * (1 + scale) + shift


def squared_relu_mlp(h, w1, w2):
    return jnp.square(jax.nn.relu(h @ w1)) @ w2


def token_shift(h, mu):
    prev = jnp.pad(h[:, :-1], ((0, 0), (1, 0), (0, 0)))
    nxt = jnp.pad(h[:, 1:], ((0, 0), (0, 1), (0, 0)))
    return h + mu[0] * (prev - h) + mu[1] * (nxt - h)


def dwconv_centred(h, w, b):
    pad = w.shape[0] // 2
    y = lax.conv_general_dilated(h, w[:, None, :], window_strides=(1,), padding=((pad, pad),),
                                 dimension_numbers=('NWC', 'WIO', 'NWC'), feature_group_count=h.shape[-1])
    return y + b


def rwkv7_scan(S0, r, w, k, v, kk, a, reverse):
    def step(S, inp):
        r_t, w_t, k_t, v_t, kk_t, a_t = inp
        s_kk = jnp.einsum('bhvk,bhk->bhv', S, kk_t)
        S = (S * w_t[:, :, None, :] - s_kk[..., None] * (kk_t * a_t)[:, :, None, :]
             + v_t[..., None] * k_t[:, :, None, :])
        return S, jnp.einsum('bhvk,bhk->bhv', S, r_t)
    xs = tuple(jnp.moveaxis(t, 1, 0) for t in (r, w, k, v, kk, a))
    S_fin, ys = lax.scan(step, S0, xs, reverse=reverse)
    return S_fin, jnp.moveaxis(ys, 0, 1)


def rwkv7_mix(p, S0, w0, w_up, a0, a_up, g_up, k_k, k_a, r_k, ln_g, ln_b):
    Bsz, L, _ = p.shape
    W = RWKV_W
    r, k, v, xw, xa, xg = jnp.split(p, [W, 2 * W, 3 * W, 3 * W + DECAY_LORA, 3 * W + DECAY_LORA + AAA_LORA], axis=-1)
    heads = lambda t: t.reshape(Bsz, L, RWKV_HEADS, RWKV_HD)
    g = jax.nn.sigmoid(xg) @ g_up
    kk = heads(k * k_k).astype(jnp.float32)
    kk = (kk / jnp.maximum(jnp.sqrt(jnp.sum(kk * kk, axis=-1, keepdims=True)), 1e-12)).astype(p.dtype)
    rh, vh = heads(r), heads(v)
    y = jnp.zeros_like(rh)
    bonus = jnp.zeros_like(rh)
    finals = []
    for d in range(2):
        w_log = -jax.nn.softplus(-(w0[d] + jnp.tanh(xw) @ w_up[d])) - 0.5
        decay = jnp.exp(-jnp.exp(w_log))
        a = jax.nn.sigmoid(a0[d] + xa @ a_up[d])
        kd = heads(k * (1 + (a - 1) * k_a))
        S_fin, yd = rwkv7_scan(S0[d], rh, heads(decay), kd, vh, kk, heads(a), reverse=(d == 1))
        y = y + yd
        bonus = bonus + jnp.sum(rh * kd * r_k, axis=-1, keepdims=True) * vh
        finals.append(S_fin)
    yf = y.astype(jnp.float32)
    mean = jnp.mean(yf, axis=-1, keepdims=True)
    var = jnp.mean(jnp.square(yf - mean), axis=-1, keepdims=True)
    yn = ((yf - mean) * lax.rsqrt(var + GN_EPS)).astype(p.dtype).reshape(Bsz, L, W)
    out = (yn * ln_g + ln_b + bonus.reshape(Bsz, L, W)) * g
    return out, (finals[0], finals[1])


def _cplx_combine(e1, e2):
    a1r, a1i, b1r, b1i = e1
    a2r, a2i, b2r, b2i = e2
    return (a2r * a1r - a2i * a1i, a2r * a1i + a2i * a1r,
            a2r * b1r - a2i * b1i + b2r, a2r * b1i + a2i * b1r + b2i)


def s5_scan(ug, A_re, A_im, log_dt, B_re, B_im, h0, reverse):
    lam_re = jnp.minimum(A_re, -1e-4)
    dt = jnp.exp(log_dt)[:, None]
    mag = jnp.exp(lam_re * dt)
    ab_re, ab_im = mag * jnp.cos(A_im * dt), mag * jnp.sin(A_im * dt)
    den = lam_re * lam_re + A_im * A_im
    f_re = ((ab_re - 1) * lam_re + ab_im * A_im) / den
    f_im = (ab_im * lam_re - (ab_re - 1) * A_im) / den
    bb_re = f_re[..., None] * B_re - f_im[..., None] * B_im
    bb_im = f_re[..., None] * B_im + f_im[..., None] * B_re
    if reverse:
        ug = jnp.flip(ug, 1)
    bu_re = jnp.einsum('blgp,gnp->blgn', ug, bb_re)
    bu_im = jnp.einsum('blgp,gnp->blgn', ug, bb_im)
    h0_re, h0_im = h0
    bu_re = bu_re.at[:, 0].add(ab_re * h0_re - ab_im * h0_im)
    bu_im = bu_im.at[:, 0].add(ab_re * h0_im + ab_im * h0_re)
    a_re = jnp.broadcast_to(ab_re, bu_re.shape)
    a_im = jnp.broadcast_to(ab_im, bu_im.shape)
    _, _, h_re, h_im = lax.associative_scan(_cplx_combine, (a_re, a_im, bu_re, bu_im), axis=1)
    final = (h_re[:, -1], h_im[:, -1])
    if reverse:
        h_re, h_im = jnp.flip(h_re, 1), jnp.flip(h_im, 1)
    return h_re, h_im, final


def s5_mix(u, h0, A_re, A_im, log_dt, B_re, B_im, C_re, C_im, D_skip, glu_w, glu_b):
    Bsz, L, _ = u.shape
    ug = u.reshape(Bsz, L, S5_G, S5_P)
    y = D_skip * u
    finals = []
    for d in range(2):
        h_re, h_im, fin = s5_scan(ug, A_re[d], A_im[d], log_dt[d], B_re[d], B_im[d], h0[d], reverse=(d == 1))
        yd = jnp.einsum('blgn,gpn->blgp', h_re, C_re[d]) - jnp.einsum('blgn,gpn->blgp', h_im, C_im[d])
        y = y + yd.reshape(Bsz, L, S5_W)
        finals.append(fin)
    y = jax.nn.gelu(y)
    y = y * jax.nn.sigmoid(y @ glu_w + glu_b)
    return y, (finals[0], finals[1])


def ssd_chunked(x, dt, A, Bm, Cm, h0):
    Bsz, L, H, P = x.shape
    G, N = Bm.shape[2], Bm.shape[3]
    R = H // G
    Q = SSD_CHUNK
    nc = L // Q
    xc = x.reshape(Bsz, nc, Q, G, R, P)
    dtc = dt.reshape(Bsz, nc, Q, G, R)
    Bc = Bm.reshape(Bsz, nc, Q, G, N)
    Cc = Cm.reshape(Bsz, nc, Q, G, N)
    A_cum = jnp.cumsum(dtc * A.reshape(G, R), axis=2)
    lower = jnp.tril(jnp.ones((Q, Q), dtype=bool))
    seg = A_cum[:, :, :, None] - A_cum[:, :, None, :]
    decay_ls = jnp.exp(jnp.where(lower[None, None, :, :, None, None], seg, -jnp.inf))
    cb = jnp.einsum('bclgn,bcsgn->bclsg', Cc, Bc)
    w_ls = cb[..., None] * decay_ls * dtc[:, :, None]
    y_diag = jnp.einsum('bclsgr,bcsgrp->bclgrp', w_ls, xc)
    to_end = jnp.exp(A_cum[:, :, -1:] - A_cum) * dtc
    states = jnp.einsum('bcsgn,bcsgr,bcsgrp->bcgrpn', Bc, to_end, xc)
    chunk_decay = jnp.exp(A_cum[:, :, -1])

    def step(h, inp):
        st, dec = inp
        return h * dec[..., None, None] + st, h

    h_fin, h_in = lax.scan(step, h0.reshape(Bsz, G, R, P, N),
                           (jnp.moveaxis(states, 1, 0), jnp.moveaxis(chunk_decay, 1, 0)))
    h_in = jnp.moveaxis(h_in, 0, 1)
    y_off = jnp.einsum('bclgn,bcgrpn,bclgr->bclgrp', Cc, h_in, jnp.exp(A_cum))
    return (y_diag + y_off).reshape(Bsz, L, H, P), h_fin.reshape(Bsz, H, P, N)


def ssd_mix(z, xbc, dt_raw, h0f, h0b, conv_w, conv_b, A_log, dt_bias, D_skip, norm_g):
    Bsz, L, _ = z.shape
    xbc = jax.nn.silu(dwconv_centred(xbc, conv_w, conv_b))
    xs, Bm, Cm = jnp.split(xbc, [SSD_W, SSD_W + SSD_GROUPS * SSD_N], axis=-1)
    xh = xs.reshape(Bsz, L, SSD_HEADS, SSD_HD)
    Bm = Bm.reshape(Bsz, L, SSD_GROUPS, SSD_N)
    Cm = Cm.reshape(Bsz, L, SSD_GROUPS, SSD_N)
    dt = jax.nn.softplus(dt_raw.reshape(Bsz, L, 2, SSD_HEADS) + dt_bias)
    A = -jnp.exp(A_log)
    flip = lambda t: jnp.flip(t, 1)
    y_f, hf = ssd_chunked(xh, dt[:, :, 0], A[0], Bm, Cm, h0f)
    y_b, hb = ssd_chunked(flip(xh), flip(dt[:, :, 1]), A[1], flip(Bm), flip(Cm), h0b)
    y = y_f + flip(y_b) + D_skip[:, None] * xh
    y = y.reshape(Bsz, L, SSD_W) * jax.nn.silu(z)
    yg = y.reshape(Bsz, L, SSD_GROUPS, SSD_W // SSD_GROUPS).astype(jnp.float32)
    yg = yg * lax.rsqrt(jnp.mean(yg * yg, axis=-1, keepdims=True) + EPS)
    return yg.reshape(Bsz, L, SSD_W).astype(z.dtype) * norm_g, hf, hb


def axial_rope_tables(rows):
    nf = ATT_HD // 4
    inv_freq = ROPE_BASE ** (-jnp.arange(nf, dtype=jnp.float32) / nf)
    row_id = jnp.repeat(jnp.arange(rows, dtype=jnp.float32), GRID_W)
    col_id = jnp.tile(jnp.arange(GRID_W, dtype=jnp.float32), rows)
    ang = jnp.stack([row_id[:, None] * inv_freq, col_id[:, None] * inv_freq], axis=1)
    return jnp.cos(ang), jnp.sin(ang)


def apply_rope(x, cos, sin):
    Bsz, L, H, D = x.shape
    xr = x.reshape(Bsz, L, H, 2, 2, D // 4)
    x1, x2 = xr[..., 0, :], xr[..., 1, :]
    c = cos[None, :, None].astype(x.dtype)
    s = sin[None, :, None].astype(x.dtype)
    return jnp.stack([x1 * c - x2 * s, x1 * s + x2 * c], axis=-2).reshape(Bsz, L, H, D)


def window_attention(q, k, v, kc, vc, sink):
    Bsz, L = q.shape[:2]
    nb = L // ATT_BLOCK
    R = ATT_HEADS // KV_HEADS
    scale = ATT_HD ** -0.5
    qb = q.reshape(Bsz, nb, ATT_BLOCK, KV_HEADS, R, ATT_HD)

    def band(t):
        tp = jnp.pad(t, ((0, 0), (ATT_BLOCK, ATT_BLOCK), (0, 0), (0, 0)))
        tp = tp.reshape(Bsz, nb + 2, ATT_BLOCK, KV_HEADS, ATT_HD)
        return jnp.concatenate([tp[:, :-2], tp[:, 1:-1], tp[:, 2:]], axis=2)

    kb, vb = band(k), band(v)
    s_band = jnp.einsum('bnqhrd,bnkhd->bnhrqk', qb, kb).astype(jnp.float32) * scale
    blk = jnp.arange(nb)[:, None, None]
    q_pos = blk * ATT_BLOCK + jnp.arange(ATT_BLOCK)[None, :, None]
    k_pos = (blk - 1) * ATT_BLOCK + jnp.arange(3 * ATT_BLOCK)[None, None, :]
    valid = (jnp.abs(q_pos - k_pos) <= WINDOW) & (k_pos >= 0) & (k_pos < L)
    s_band = jnp.where(valid[None, :, None, None], s_band, -jnp.inf)
    s_ctx = jnp.einsum('bnqhrd,bchd->bnhrqc', qb, kc).astype(jnp.float32) * scale
    s_sink = jnp.broadcast_to(sink.astype(jnp.float32).reshape(KV_HEADS, R)[None, None, :, :, None, None],
                              s_ctx.shape[:-1] + (1,))
    p = jax.nn.softmax(jnp.concatenate([s_sink, s_ctx, s_band], axis=-1), axis=-1).astype(v.dtype)
    n_ctx = kc.shape[1]
    out = (jnp.einsum('bnhrqc,bchd->bnqhrd', p[..., 1:1 + n_ctx], vc)
           + jnp.einsum('bnhrqk,bnkhd->bnqhrd', p[..., 1 + n_ctx:], vb))
    return out.reshape(Bsz, L, ATT_Q_W)


def context_attention(qc, kc, vc, sink):
    Bsz, C = qc.shape[:2]
    R = ATT_HEADS // KV_HEADS
    qg = qc.reshape(Bsz, C, KV_HEADS, R, ATT_HD)
    s = jnp.einsum('bqhrd,bkhd->bhrqk', qg, kc).astype(jnp.float32) * (ATT_HD ** -0.5)
    s_sink = jnp.broadcast_to(sink.astype(jnp.float32).reshape(KV_HEADS, R)[None, :, :, None, None],
                              s.shape[:-1] + (1,))
    p = jax.nn.softmax(jnp.concatenate([s_sink, s], axis=-1), axis=-1)[..., 1:].astype(vc.dtype)
    return jnp.einsum('bhrqk,bkhd->bqhrd', p, vc).reshape(Bsz, C, ATT_Q_W)


def mixer_ab(h, hc, need_ctx, w_in, w_out, mu, w0, w_up, a0, a_up, g_up, k_k, k_a, r_k, ln_g, ln_b,
             A_re, A_im, log_dt, B_re, B_im, C_re, C_im, D_skip, glu_w, glu_b):
    Bsz = h.shape[0]
    p, pc = h @ w_in, hc @ w_in
    rwkv_prm = (w0, w_up, a0, a_up, g_up, k_k, k_a, r_k, ln_g, ln_b)
    s5_prm = (A_re, A_im, log_dt, B_re, B_im, C_re, C_im, D_skip, glu_w, glu_b)
    S_zero = jnp.zeros((Bsz, RWKV_HEADS, RWKV_HD, RWKV_HD), h.dtype)
    h_zero = jnp.zeros((Bsz, S5_G, S5_N), h.dtype)
    ya_c, S_ctx = rwkv7_mix(token_shift(pc[..., :RWKV_COLS], mu), (S_zero, S_zero), *rwkv_prm)
    ya, _ = rwkv7_mix(token_shift(p[..., :RWKV_COLS], mu), S_ctx, *rwkv_prm)
    yb_c, h_ctx = s5_mix(pc[..., RWKV_COLS:], ((h_zero, h_zero), (h_zero, h_zero)), *s5_prm)
    yb, _ = s5_mix(p[..., RWKV_COLS:], h_ctx, *s5_prm)
    out = jnp.concatenate([ya, yb], axis=-1) @ w_out
    out_c = jnp.concatenate([ya_c, yb_c], axis=-1) @ w_out if need_ctx else None
    return out, out_c


def mixer_cd(h, hc, cos, sin, need_ctx, w_in, w_out, conv_w, conv_b, A_log, dt_bias, D_skip, norm_g, sink):
    Bsz, L, _ = h.shape
    C = hc.shape[1]
    splits = [SSD_W, SSD_W + XBC_W, SSD_W + XBC_W + 2 * SSD_HEADS,
              SSD_W + XBC_W + 2 * SSD_HEADS + ATT_Q_W, SSD_W + XBC_W + 2 * SSD_HEADS + ATT_Q_W + ATT_KV_W]
    z, xbc, dtr, q, k, v = jnp.split(h @ w_in, splits, axis=-1)
    zc, xbcc, dtrc, qc, kc, vc = jnp.split(hc @ w_in, splits, axis=-1)
    ssd_prm = (conv_w, conv_b, A_log, dt_bias, D_skip, norm_g)
    h_zero = jnp.zeros((Bsz, SSD_HEADS, SSD_HD, SSD_N), h.dtype)
    yc_c, hf, hb = ssd_mix(zc, xbcc, dtrc, h_zero, h_zero, *ssd_prm)
    y_c, _, _ = ssd_mix(z, xbc, dtr, hf, hb, *ssd_prm)
    q = apply_rope(q.reshape(Bsz, L, ATT_HEADS, ATT_HD), cos, sin)
    k = apply_rope(k.reshape(Bsz, L, KV_HEADS, ATT_HD), cos, sin)
    v = v.reshape(Bsz, L, KV_HEADS, ATT_HD)
    kc = kc.reshape(Bsz, C, KV_HEADS, ATT_HD)
    vc = vc.reshape(Bsz, C, KV_HEADS, ATT_HD)
    y_d = window_attention(q, k, v, kc, vc, sink)
    out = jnp.concatenate([y_c, y_d], axis=-1) @ w_out
    out_c = None
    if need_ctx:
        yc_d = context_attention(qc.reshape(Bsz, C, ATT_HEADS, ATT_HD), kc, vc, sink)
        out_c = jnp.concatenate([yc_c, yc_d], axis=-1) @ w_out
    return out, out_c


def setup_inputs(seed: int = 0) -> dict:
    key = jax.random.key(seed)
    keys = jax.random.split(key, 64)
    counter = [0]

    def nk():
        counter[0] += 1
        return keys[counter[0] - 1]

    def nrm(shape, scale=1.0):
        return scale * jax.random.normal(nk(), shape, jnp.float32)

    def unif(shape, lo, hi):
        return jax.random.uniform(nk(), shape, jnp.float32, lo, hi)

    D = D_MODEL
    log_dt_lo, log_dt_hi = math.log(1e-3), math.log(1e-1)
    ssd_dt = jnp.exp(unif((N_CD, 2, SSD_HEADS), log_dt_lo, log_dt_hi))
    return {
        'x': nrm((BATCH, SEQ, D)),
        'c': nrm((BATCH, D)),
        'ctx': nrm((BATCH, CTX_LEN, D)),
        'c_ctx': nrm((D,)),
        'ada_w': nrm((DEPTH, D, 6 * D), 0.5 * D ** -0.5),
        'ada_b': nrm((DEPTH, 6 * D), 0.01),
        'norm1_g': 1.0 + nrm((DEPTH, D), 0.02),
        'norm2_g': 1.0 + nrm((DEPTH, D), 0.02),
        'mlp_w1': nrm((DEPTH, D, D_FF), D ** -0.5),
        'mlp_w2': nrm((DEPTH, D_FF, D), D_FF ** -0.5),
        'final_g': 1.0 + nrm((D,), 0.02),
        'ab_w_in': nrm((N_AB, D, AB_IN), D ** -0.5),
        'ab_w_out': nrm((N_AB, AB_MIX, D), AB_MIX ** -0.5),
        'rwkv_mu': unif((N_AB, 2, RWKV_COLS), 0.0, 0.5),
        'rwkv_w0': unif((N_AB, 2, RWKV_W), -7.0, -2.0),
        'rwkv_w_up': nrm((N_AB, 2, DECAY_LORA, RWKV_W), 0.1 * DECAY_LORA ** -0.5),
        'rwkv_a0': nrm((N_AB, 2, RWKV_W), 0.1),
        'rwkv_a_up': nrm((N_AB, 2, AAA_LORA, RWKV_W), AAA_LORA ** -0.5),
        'rwkv_g_up': nrm((N_AB, GATE_LORA, RWKV_W), GATE_LORA ** -0.5),
        'rwkv_k_k': 0.85 + nrm((N_AB, RWKV_W), 0.05),
        'rwkv_k_a': 1.0 + nrm((N_AB, RWKV_W), 0.05),
        'rwkv_r_k': nrm((N_AB, RWKV_HEADS, RWKV_HD), 0.1),
        'rwkv_ln_g': 1.0 + nrm((N_AB, RWKV_W), 0.02),
        'rwkv_ln_b': nrm((N_AB, RWKV_W), 0.01),
        's5_A_re': -0.5 + nrm((N_AB, 2, S5_G, S5_N), 0.01),
        's5_A_im': np.pi * jnp.arange(S5_N, dtype=jnp.float32) + nrm((N_AB, 2, S5_G, S5_N), 0.01),
        's5_log_dt': unif((N_AB, 2, S5_G), log_dt_lo, log_dt_hi),
        's5_B_re': nrm((N_AB, 2, S5_G, S5_N, S5_P), (2 * S5_P) ** -0.5),
        's5_B_im': nrm((N_AB, 2, S5_G, S5_N, S5_P), (2 * S5_P) ** -0.5),
        's5_C_re': nrm((N_AB, 2, S5_G, S5_P, S5_N), (2 * S5_N) ** -0.5),
        's5_C_im': nrm((N_AB, 2, S5_G, S5_P, S5_N), (2 * S5_N) ** -0.5),
        's5_D': nrm((N_AB, S5_W)),
        's5_glu_w': nrm((N_AB, S5_W, S5_W), S5_W ** -0.5),
        's5_glu_b': nrm((N_AB, S5_W), 0.01),
        'cd_w_in': nrm((N_CD, D, CD_IN), D ** -0.5),
        'cd_w_out': nrm((N_CD, CD_MIX, D), CD_MIX ** -0.5),
        'ssd_conv_w': nrm((N_CD, CONV_W, XBC_W), CONV_W ** -0.5),
        'ssd_conv_b': nrm((N_CD, XBC_W), 0.01),
        'ssd_A_log': jnp.log(unif((N_CD, 2, SSD_HEADS), 1.0, 16.0)),
        'ssd_dt_bias': ssd_dt + jnp.log(-jnp.expm1(-ssd_dt)),
        'ssd_D': 1.0 + nrm((N_CD, SSD_HEADS), 0.1),
        'ssd_norm_g': 1.0 + nrm((N_CD, SSD_W), 0.02),
        'attn_sink': nrm((N_CD, ATT_HEADS), 0.5),
    }


def reference(x, c, ctx, c_ctx, ada_w, ada_b, norm1_g, norm2_g, mlp_w1, mlp_w2, final_g,
              ab_w_in, ab_w_out, rwkv_mu, rwkv_w0, rwkv_w_up, rwkv_a0, rwkv_a_up, rwkv_g_up,
              rwkv_k_k, rwkv_k_a, rwkv_r_k, rwkv_ln_g, rwkv_ln_b,
              s5_A_re, s5_A_im, s5_log_dt, s5_B_re, s5_B_im, s5_C_re, s5_C_im, s5_D, s5_glu_w, s5_glu_b,
              cd_w_in, cd_w_out, ssd_conv_w, ssd_conv_b, ssd_A_log, ssd_dt_bias, ssd_D, ssd_norm_g, attn_sink):
    L = x.shape[1]
    rows = L // GRID_W
    cos, sin = axial_rope_tables(rows)
    cond = jax.nn.silu(c)
    cond_ctx = jax.nn.silu(c_ctx)
    cx = ctx
    for i in range(DEPTH):
        last = i == DEPTH - 1
        j = i // 2
        mod = (cond @ ada_w[i] + ada_b[i])[:, None, :]
        mod_c = cond_ctx @ ada_w[i] + ada_b[i]
        sh1, sc1, g1, sh2, sc2, g2 = jnp.split(mod, 6, axis=-1)
        sh1c, sc1c, g1c, sh2c, sc2c, g2c = jnp.split(mod_c, 6, axis=-1)
        h = modulate(rmsnorm(x, norm1_g[i]), sh1, sc1)
        hc = modulate(rmsnorm(cx, norm1_g[i]), sh1c, sc1c)
        if i % 2 == 0:
            out, out_c = mixer_ab(h, hc, not last, ab_w_in[j], ab_w_out[j], rwkv_mu[j], rwkv_w0[j], rwkv_w_up[j],
                                  rwkv_a0[j], rwkv_a_up[j], rwkv_g_up[j], rwkv_k_k[j], rwkv_k_a[j], rwkv_r_k[j],
                                  rwkv_ln_g[j], rwkv_ln_b[j], s5_A_re[j], s5_A_im[j], s5_log_dt[j], s5_B_re[j],
                                  s5_B_im[j], s5_C_re[j], s5_C_im[j], s5_D[j], s5_glu_w[j], s5_glu_b[j])
        else:
            out, out_c = mixer_cd(h, hc, cos, sin, not last, cd_w_in[j], cd_w_out[j], ssd_conv_w[j], ssd_conv_b[j],
                                  ssd_A_log[j], ssd_dt_bias[j], ssd_D[j], ssd_norm_g[j], attn_sink[j])
        x = x + g1 * out
        x = x + g2 * squared_relu_mlp(modulate(rmsnorm(x, norm2_g[i]), sh2, sc2), mlp_w1[i], mlp_w2[i])
        if not last:
            cx = cx + g1c * out_c
            cx = cx + g2c * squared_relu_mlp(modulate(rmsnorm(cx, norm2_g[i]), sh2c, sc2c), mlp_w1[i], mlp_w2[i])
    return rmsnorm(x, final_g)
```

```cpp
#include <hip/hip_runtime.h>
#include <hip/hip_cooperative_groups.h>
#include <cstdio>
namespace cg = cooperative_groups;

typedef unsigned short u16;
using bf16x8 = __attribute__((ext_vector_type(8))) short;
using f32x4 = __attribute__((ext_vector_type(4))) float;
#define DEVI __device__ __forceinline__

constexpr int NB = 4, SEQ = 4096, CL = 256, LT = SEQ + CL, T = NB * LT, D = 2048, DFF = 8192;
constexpr int AB_IN = 4544, AB_INP = 4608, CD_IN = 6720, CD_INP = 6912;
constexpr int NTH = 512, NWV = 8;
constexpr int RCOLS = 3520;

constexpr size_t al256(size_t x) { return (x + 255) & ~(size_t)255; }
constexpr size_t OFF_MOD = 0;
constexpr size_t OFF_CX = al256(OFF_MOD + 2 * 5 * 12288 * 4);
constexpr size_t OFF_RK = al256(OFF_CX + (size_t)NB * CL * D * 4);
constexpr size_t OFF_DT = al256(OFF_RK + (size_t)2 * T * 16 * 4);
constexpr size_t OFF_S5E = al256(OFF_DT + (size_t)2 * T * 32 * 4);
constexpr size_t OFF_W16 = al256(OFF_S5E + (size_t)NB * 64 * 2 * 68 * 128 * 4);
constexpr size_t W_W1 = 0, W_W2 = 33554432, W_L = 67108864;
constexpr size_t W0_IN = W_L, W0_OUT = W0_IN + (size_t)AB_INP * D * 2, W0_LORA = W0_OUT + (size_t)D * D * 2,
                 W0_GLU = W0_LORA + (size_t)5120 * 512 * 2;
constexpr size_t W1_IN = W_L, W1_OUT = W1_IN + (size_t)CD_INP * D * 2;
constexpr size_t W16_SIZE = W1_OUT + (size_t)D * 3072 * 2;
constexpr size_t OFF_H = al256(OFF_W16 + W16_SIZE);
constexpr size_t OFF_BIG = al256(OFF_H + (size_t)T * D * 2);
constexpr size_t B0_P = 0, B0_LIN = B0_P + (size_t)T * AB_INP * 2, B0_WL = B0_LIN + (size_t)T * 512 * 2,
                 B0_AL = B0_WL + (size_t)2 * T * 1024 * 2, B0_G = B0_AL + (size_t)2 * T * 1024 * 2,
                 B0_YR = B0_G + (size_t)T * 1024 * 2, B0_YG = B0_YR + (size_t)2 * T * 1024 * 2,
                 B0_END = B0_YG + (size_t)T * 1024 * 2;
constexpr size_t B1_P = 0, B1_XBC = B1_P + (size_t)T * CD_INP * 2, B1_YB = B1_XBC + (size_t)T * 3072 * 2,
                 B1_CAT = B1_YB + (size_t)T * 2048 * 2, B1_END = B1_CAT + (size_t)T * 3072 * 2;
constexpr size_t BIG_SIZE = B1_END > B0_END ? B1_END : B0_END;
constexpr size_t OFF_BAR = al256(OFF_BIG + BIG_SIZE);
constexpr size_t BAR_BYTES = 16384;
constexpr size_t WS_NEEDED = OFF_BAR + BAR_BYTES;

struct Params {
  const float *x, *c, *ctx, *c_ctx, *ada_w, *ada_b, *norm1_g, *norm2_g, *mlp_w1, *mlp_w2, *final_g;
  const float *ab_w_in, *ab_w_out, *rwkv_mu, *rwkv_w0, *rwkv_w_up, *rwkv_a0, *rwkv_a_up, *rwkv_g_up;
  const float *rwkv_k_k, *rwkv_k_a, *rwkv_r_k, *rwkv_ln_g, *rwkv_ln_b;
  const float *s5_A_re, *s5_A_im, *s5_log_dt, *s5_B_re, *s5_B_im, *s5_C_re, *s5_C_im, *s5_D, *s5_glu_w, *s5_glu_b;
  const float *cd_w_in, *cd_w_out, *ssd_conv_w, *ssd_conv_b, *ssd_A_log, *ssd_dt_bias, *ssd_D, *ssd_norm_g, *attn_sink;
  float* out;
  char* ws;
  int ph_lo, ph_hi;
};

DEVI u16 f2bf(float f) {
  unsigned u = __float_as_uint(f);
  u += 0x7FFFu + ((u >> 16) & 1u);
  return (u16)(u >> 16);
}
DEVI float bf2f(u16 h) { return __uint_as_float(((unsigned)h) << 16); }
DEVI unsigned pack2(float a, float b) { return (unsigned)f2bf(a) | ((unsigned)f2bf(b) << 16); }
DEVI float sigmoidf(float x) { return 1.f / (1.f + __expf(-x)); }
DEVI float dpp_xor1(float v) {
  return __int_as_float(__builtin_amdgcn_update_dpp(0, __float_as_int(v), 0xB1, 0xF, 0xF, true));
}
DEVI float dpp_xor2(float v) {
  return __int_as_float(__builtin_amdgcn_update_dpp(0, __float_as_int(v), 0x4E, 0xF, 0xF, true));
}
DEVI float dpp_half_mirror(float v) {
  return __int_as_float(__builtin_amdgcn_update_dpp(0, __float_as_int(v), 0x141, 0xF, 0xF, true));
}
DEVI float dpp_ror4(float v) {
  return __int_as_float(__builtin_amdgcn_update_dpp(0, __float_as_int(v), 0x124, 0xF, 0xF, true));
}
DEVI float dpp_ror8(float v) {
  return __int_as_float(__builtin_amdgcn_update_dpp(0, __float_as_int(v), 0x128, 0xF, 0xF, true));
}
DEVI float sum16(float v) {
  v += dpp_xor1(v);
  v += dpp_xor2(v);
  v += dpp_ror4(v);
  v += dpp_ror8(v);
  return v;
}
DEVI float sum8(float v) {
  v += dpp_xor1(v);
  v += dpp_xor2(v);
  v += dpp_half_mirror(v);
  return v;
}
DEVI float wave_sum(float v) {
  v += dpp_xor1(v);
  v += dpp_xor2(v);
  v += __shfl_xor(v, 4);
  v += __shfl_xor(v, 8);
  v += __shfl_xor(v, 16);
  v += __shfl_xor(v, 32);
  return v;
}
DEVI void lds_barrier() { asm volatile("s_waitcnt lgkmcnt(0)\n\ts_barrier" ::: "memory"); }
DEVI void wave_lds_fence() { asm volatile("s_waitcnt lgkmcnt(0)" ::: "memory"); }

DEVI float* xrow_ptr(const Params& p, int row) {
  int b = row / LT, pos = row - b * LT;
  return pos < CL ? (float*)(p.ws + OFF_CX) + (size_t)(b * CL + pos) * D : p.out + (size_t)(b * SEQ + pos - CL) * D;
}
DEVI const float* inrow_ptr(const Params& p, int row) {
  int b = row / LT, pos = row - b * LT;
  return pos < CL ? p.ctx + (size_t)(b * CL + pos) * D : p.x + (size_t)(b * SEQ + pos - CL) * D;
}
DEVI int dirpos(int d, int j) { return d == 0 ? j : (j < CL ? CL - 1 - j : LT + CL - 1 - j); }
DEVI const float* mod_ptr(const Params& p, int layer, int row, int idx) {
  int b = row / LT, pos = row - b * LT;
  int r = pos < CL ? 4 : b;
  return (const float*)(p.ws + OFF_MOD) + (size_t)(layer * 5 + r) * 12288 + idx * 2048;
}

DEVI void tjob(const float* __restrict__ src, u16* __restrict__ dst, int K, int N, int Npad, int& t, int& off, int nb,
               char* smem) {
  float* sm = (float*)smem;
  int kt = (K + 63) / 64, nt = Npad / 256, ntiles = kt * nt;
  int tid = threadIdx.x;
  while (t < off + ntiles) {
    int lt = t - off;
    int tk = lt % kt, tn = lt / kt;
    int k0 = tk * 64, n0 = tn * 256;
    float4 v[8];
#pragma unroll
    for (int i = 0; i < 8; ++i) {
      int idx = i * 512 + tid;
      int kk = idx >> 6, c4 = idx & 63;
      v[i] = make_float4(0.f, 0.f, 0.f, 0.f);
      if (k0 + kk < K && n0 + c4 * 4 < N) v[i] = *(const float4*)(src + (size_t)(k0 + kk) * N + n0 + c4 * 4);
    }
    __syncthreads();
#pragma unroll
    for (int i = 0; i < 8; ++i) {
      int idx = i * 512 + tid;
      int kk = idx >> 6, c4 = idx & 63;
      float* d = sm + kk * 257 + c4 * 4;
      d[0] = v[i].x; d[1] = v[i].y; d[2] = v[i].z; d[3] = v[i].w;
    }
    __syncthreads();
#pragma unroll
    for (int i = 0; i < 4; ++i) {
      int gidx = i * 512 + tid;
      int nl = gidx >> 3, kg = gidx & 7;
      if (k0 + kg * 8 < K) {
        unsigned w[4];
#pragma unroll
        for (int j = 0; j < 4; ++j) w[j] = pack2(sm[(kg * 8 + 2 * j) * 257 + nl], sm[(kg * 8 + 2 * j + 1) * 257 + nl]);
        *(uint4*)(dst + (size_t)(n0 + nl) * K + k0 + kg * 8) = make_uint4(w[0], w[1], w[2], w[3]);
      }
    }
    t += nb;
  }
  off += ntiles;
}

DEVI void lora_w_job(const Params& p, u16* dst, int bid, int nb) {
  for (int it = bid * NTH + threadIdx.x; it < 5120 * 64; it += nb * NTH) {
    int n = it % 5120, kg = it / 5120;
    int blk = n >> 10, nn = n & 1023;
    unsigned w[4];
#pragma unroll
    for (int j = 0; j < 4; ++j) {
      float v[2];
#pragma unroll
      for (int e = 0; e < 2; ++e) {
        int k = kg * 8 + j * 2 + e;
        float x = 0.f;
        if (blk < 2) { if (k < 96) x = p.rwkv_w_up[((size_t)blk * 96 + k) * 1024 + nn]; }
        else if (blk < 4) { if (k >= 96 && k < 192) x = p.rwkv_a_up[((size_t)(blk - 2) * 96 + (k - 96)) * 1024 + nn]; }
        else { if (k >= 192 && k < 448) x = p.rwkv_g_up[(size_t)(k - 192) * 1024 + nn]; }
        v[e] = x;
      }
      w[j] = pack2(v[0], v[1]);
    }
    *(uint4*)(dst + (size_t)n * 512 + kg * 8) = make_uint4(w[0], w[1], w[2], w[3]);
  }
}

DEVI void ph_convert(const Params& p, int layer, int bid, int nb, char* smem) {
  char* w16 = p.ws + OFF_W16;
  int t = bid, off = 0;
  tjob(p.mlp_w1 + (size_t)layer * D * DFF, (u16*)(w16 + W_W1), D, DFF, DFF, t, off, nb, smem);
  tjob(p.mlp_w2 + (size_t)layer * D * DFF, (u16*)(w16 + W_W2), DFF, D, D, t, off, nb, smem);
  if (layer == 0) {
    tjob(p.ab_w_in, (u16*)(w16 + W0_IN), D, AB_IN, AB_INP, t, off, nb, smem);
    tjob(p.ab_w_out, (u16*)(w16 + W0_OUT), D, D, D, t, off, nb, smem);
    tjob(p.s5_glu_w, (u16*)(w16 + W0_GLU), 1024, 1024, 1024, t, off, nb, smem);
    lora_w_job(p, (u16*)(w16 + W0_LORA), bid, nb);
  } else {
    tjob(p.cd_w_in, (u16*)(w16 + W1_IN), D, CD_IN, CD_INP, t, off, nb, smem);
    tjob(p.cd_w_out, (u16*)(w16 + W1_OUT), 3072, D, D, t, off, nb, smem);
  }
  __syncthreads();
}

DEVI void ph_mod(const Params& p, int bid, int nb, char* smem) {
  if (bid >= 384) return;
  float* cond = (float*)smem;
  float* red = cond + 5 * 2048;
  int tid = threadIdx.x;
  for (int i = tid; i < 5 * 2048; i += NTH) {
    int r = i >> 11, k = i & 2047;
    float c = r < 4 ? p.c[r * 2048 + k] : p.c_ctx[k];
    cond[i] = c / (1.f + expf(-c));
  }
  __syncthreads();
  int cgp = tid & 15, ks = tid >> 4, lane = tid & 63, wid = tid >> 6;
  float* MOD = (float*)(p.ws + OFF_MOD);
  for (int item = bid; item < 384; item += nb) {
    int l = item / 192, n0 = (item % 192) * 64;
    const float* W = p.ada_w + (size_t)l * 2048 * 12288 + n0 + cgp * 4;
    float acc[5][4];
#pragma unroll
    for (int r = 0; r < 5; ++r)
#pragma unroll
      for (int j = 0; j < 4; ++j) acc[r][j] = 0.f;
#pragma unroll 8
    for (int i = 0; i < 64; ++i) {
      int k = ks + 32 * i;
      float4 w = *(const float4*)(W + (size_t)k * 12288);
#pragma unroll
      for (int r = 0; r < 5; ++r) {
        float c = cond[r * 2048 + k];
        acc[r][0] += c * w.x; acc[r][1] += c * w.y; acc[r][2] += c * w.z; acc[r][3] += c * w.w;
      }
    }
#pragma unroll
    for (int r = 0; r < 5; ++r)
#pragma unroll
      for (int j = 0; j < 4; ++j) {
        float v = acc[r][j];
        v += __shfl_xor(v, 16);
        v += __shfl_xor(v, 32);
        acc[r][j] = v;
      }
    if (lane < 16) {
#pragma unroll
      for (int r = 0; r < 5; ++r)
#pragma unroll
        for (int j = 0; j < 4; ++j) red[(wid * 16 + cgp) * 20 + r * 4 + j] = acc[r][j];
    }
    __syncthreads();
    for (int o = tid; o < 320; o += NTH) {
      int r = o >> 6, col = o & 63;
      int ci = col >> 2, j = col & 3;
      float sacc = 0.f;
#pragma unroll
      for (int w = 0; w < 8; ++w) sacc += red[(w * 16 + ci) * 20 + r * 4 + j];
      MOD[(size_t)(l * 5 + r) * 12288 + n0 + col] = sacc + p.ada_b[l * 12288 + n0 + col];
    }
    __syncthreads();
  }
}

DEVI void ph_norm(const Params& p, int layer, int which, bool src_in, bool xonly, int bid, int nb) {
  int wid = threadIdx.x >> 6, lane = threadIdx.x & 63;
  const float* gam = (which == 0 ? p.norm1_g : p.norm2_g) + layer * D;
  u16* H = (u16*)(p.ws + OFF_H);
  int nrows = xonly ? NB * SEQ : T;
  for (int it = bid * NWV + wid; it < nrows; it += nb * NWV) {
    int row = xonly ? (it / SEQ) * LT + CL + (it % SEQ) : it;
    const float* src = src_in ? inrow_ptr(p, row) : xrow_ptr(p, row);
    const float* sh = mod_ptr(p, layer, row, which * 3 + 0);
    const float* sc = mod_ptr(p, layer, row, which * 3 + 1);
    float4 v[8];
    float ss = 0.f;
#pragma unroll
    for (int i = 0; i < 8; ++i) {
      v[i] = *(const float4*)(src + (i * 64 + lane) * 4);
      ss += v[i].x * v[i].x + v[i].y * v[i].y + v[i].z * v[i].z + v[i].w * v[i].w;
    }
    ss = wave_sum(ss);
    float rs = rsqrtf(ss * (1.f / D) + 1e-6f);
#pragma unroll
    for (int i = 0; i < 8; ++i) {
      int c = (i * 64 + lane) * 4;
      float4 g = *(const float4*)(gam + c);
      float4 s1 = *(const float4*)(sc + c);
      float4 s0 = *(const float4*)(sh + c);
      float a0 = v[i].x * rs * g.x * (1.f + s1.x) + s0.x;
      float a1 = v[i].y * rs * g.y * (1.f + s1.y) + s0.y;
      float a2 = v[i].z * rs * g.z * (1.f + s1.z) + s0.z;
      float a3 = v[i].w * rs * g.w * (1.f + s1.w) + s0.w;
      *(uint2*)(H + (size_t)row * D + c) = make_uint2(pack2(a0, a1), pack2(a2, a3));
    }
  }
}

#define LAS __attribute__((address_space(3)))
typedef unsigned u32x4 __attribute__((ext_vector_type(4)));
constexpr int BM = 256, BK = 64, HALF = 128, HTB = HALF * BK * 2, STAGE_BYTES = 8 * HTB, NXCD = 8, WGM = 8;
DEVI int lds_byte(int r, int c) {
  const int st = (r >> 4) * 2 + (c >> 5), rr = r & 15, cc = c & 31, ob = rr * 64 + cc * 2;
  return st * 1024 + (ob ^ (((ob >> 9) & 1) << 5));
}
DEVI void stage_rc(int b, int& R, int& C) {
  const int st = b / 1024, sb = b % 1024, swz = sb ^ (((sb >> 9) & 1) << 5);
  R = (st >> 1) * 16 + swz / 64;
  C = (st & 1) * 32 + (swz % 64) / 2;
}
DEVI int perm32(int rho) { const int n = rho >> 4, i = rho & 15; return 8 * (i >> 2) + 4 * n + (i & 3); }
struct Unit { int pm, pn; };
struct Gemm { const u16* A; const u16* Bt; int K; };
struct Order {
  int nM, nN, nwg, G, c, xonly;
  DEVI void init(int nM_, int nN_, int G_, int c_, int xonly_) { nM = nM_; nN = nN_; nwg = nM * nN; G = G_; c = c_; xonly = xonly_; }
  DEVI bool next(int i, Unit& u) const {
    const long L = (long)i * G + c;
    if (L >= nwg) return false;
    int wgid = (int)L;
    { const int q = nwg / NXCD, r = nwg % NXCD, xcd = wgid % NXCD, off = wgid / NXCD; wgid = (xcd < r ? xcd * (q + 1) : r * (q + 1) + (xcd - r) * q) + off; }
    const int nig = WGM * nN, gid = wgid / nig, fm = gid * WGM, gsz = (nM - fm) < WGM ? (nM - fm) : WGM;
    int pm = fm + ((wgid % nig) % gsz);
    u.pn = (wgid % nig) / gsz;
    u.pm = xonly ? (pm >> 4) * 17 + 1 + (pm & 15) : pm;
    return true;
  }
};
DEVI bf16x8 mk_bf16x8(unsigned a, unsigned b, unsigned c, unsigned d) {
  u32x4 v = {a, b, c, d};
  return __builtin_bit_cast(bf16x8, v);
}
DEVI unsigned cvt_pk_bf16(float lo, float hi) { unsigned r; asm volatile("v_cvt_pk_bf16_f32 %0, %1, %2" : "=v"(r) : "v"(lo), "v"(hi)); return r; }

template <int ACT>
struct EpiBf16 {
  static constexpr bool PERM = true;
  u16* O; int ldc; int split_cols; size_t split_stride;
  DEVI void operator()(const f32x4 (&acc)[2][2][4][2], const Unit& u, int wr, int wc, int fr, int fq) const {
    const int row0 = u.pm * BM + wr * 64 + fr;
    int colt = u.pn * BM;
    u16* base = O;
    if (split_cols) { const int t = colt / split_cols; base += (size_t)t * split_stride; colt -= t * split_cols; }
    const int col0 = colt + wc * 32 + 8 * fq;
#pragma unroll
    for (int ai = 0; ai < 2; ++ai)
#pragma unroll
      for (int m = 0; m < 4; ++m) {
        u16* rowp = base + (size_t)(row0 + ai * HALF + m * 16) * ldc + col0;
#pragma unroll
        for (int bj = 0; bj < 2; ++bj) {
          f32x4 v0 = acc[ai][bj][m][0], v1 = acc[ai][bj][m][1];
          if (ACT == 1) {
#pragma unroll
            for (int j = 0; j < 4; ++j) { float a = fmaxf(v0[j], 0.f), b = fmaxf(v1[j], 0.f); v0[j] = a * a; v1[j] = b * b; }
          }
          u32x4 w;
          w.x = cvt_pk_bf16(v0[0], v0[1]); w.y = cvt_pk_bf16(v0[2], v0[3]); w.z = cvt_pk_bf16(v1[0], v1[1]); w.w = cvt_pk_bf16(v1[2], v1[3]);
          *(u32x4*)(rowp + bj * HALF) = w;
        }
      }
  }
};
struct EpiGlu {
  static constexpr bool PERM = true;
  const u16* YG; u16* CAT; const float* bias;
  DEVI void operator()(const f32x4 (&acc)[2][2][4][2], const Unit& u, int wr, int wc, int fr, int fq) const {
    const int row0 = u.pm * BM + wr * 64 + fr;
    const int col0 = u.pn * BM + wc * 32 + 8 * fq;
#pragma unroll
    for (int ai = 0; ai < 2; ++ai)
#pragma unroll
      for (int m = 0; m < 4; ++m) {
        const size_t row = (size_t)(row0 + ai * HALF + m * 16);
#pragma unroll
        for (int bj = 0; bj < 2; ++bj) {
          const int col = col0 + bj * HALF;
          u32x4 yv = *(const u32x4*)(YG + row * 1024 + col);
          f32x4 b0 = *(const f32x4*)(bias + col), b1 = *(const f32x4*)(bias + col + 4);
          f32x4 v0 = acc[ai][bj][m][0] + b0, v1 = acc[ai][bj][m][1] + b1;
          float y[8];
          unsigned yw[4] = {yv.x, yv.y, yv.z, yv.w};
#pragma unroll
          for (int j = 0; j < 4; ++j) { y[2 * j] = __uint_as_float(yw[j] << 16); y[2 * j + 1] = __uint_as_float(yw[j] & 0xFFFF0000u); }
          u32x4 w;
          w.x = cvt_pk_bf16(y[0] * sigmoidf(v0[0]), y[1] * sigmoidf(v0[1]));
          w.y = cvt_pk_bf16(y[2] * sigmoidf(v0[2]), y[3] * sigmoidf(v0[3]));
          w.z = cvt_pk_bf16(y[4] * sigmoidf(v1[0]), y[5] * sigmoidf(v1[1]));
          w.w = cvt_pk_bf16(y[6] * sigmoidf(v1[2]), y[7] * sigmoidf(v1[3]));
          *(u32x4*)(CAT + row * D + 1024 + col) = w;
        }
      }
  }
};
struct EpiResid {
  static constexpr bool PERM = false;
  Params p; int layer, gidx, from_in;
  DEVI void operator()(const f32x4 (&acc)[2][2][4][2], const Unit& u, int wr, int wc, int fr, int fq) const {
    const int row0 = u.pm * BM + wr * 64 + fr, col0 = u.pn * BM + wc * 32 + 4 * fq;
    const float* gate = mod_ptr(p, layer, row0, gidx);
    f32x4 gv[2][2];
#pragma unroll
    for (int bj = 0; bj < 2; ++bj)
#pragma unroll
      for (int n = 0; n < 2; ++n) gv[bj][n] = *(const f32x4*)(gate + col0 + bj * HALF + n * 16);
#pragma unroll
    for (int ai = 0; ai < 2; ++ai)
#pragma unroll
      for (int m = 0; m < 4; ++m) {
        const int row = row0 + ai * HALF + m * 16;
        float* dst = xrow_ptr(p, row) + col0;
        const float* src = from_in ? inrow_ptr(p, row) + col0 : dst;
#pragma unroll
        for (int bj = 0; bj < 2; ++bj)
#pragma unroll
          for (int n = 0; n < 2; ++n) {
            f32x4 sv = *(const f32x4*)(src + bj * HALF + n * 16);
            *(f32x4*)(dst + bj * HALF + n * 16) = sv + gv[bj][n] * acc[ai][bj][m][n];
          }
      }
  }
};

template <class Epi>
DEVI void gemm_phase(LAS unsigned char* lds, const Gemm g, const Order& S, const Epi& E) {
  const int tid = threadIdx.x, wid = __builtin_amdgcn_readfirstlane(tid >> 6), lane = tid & 63, wr = wid >> 2, wc = wid & 3, fr = lane & 15, fq = lane >> 4;
  const int K = g.K, nt = K / BK;
  unsigned voffA[2], voffB[2];
#pragma unroll
  for (int i = 0; i < 2; ++i) {
    int R, C;
    stage_rc(tid * 16 + i * 8192, R, C);
    const int Rb = Epi::PERM ? ((R & ~31) + perm32(R & 31)) : R;
    voffA[i] = (unsigned)(R * K + C) * 2u;
    voffB[i] = (unsigned)(Rb * K + C) * 2u;
  }
  const size_t kstep = (size_t)(BK * 2);
  const size_t hstep = (size_t)HALF * K * 2;
  const size_t tstep = 2 * hstep;
  const unsigned ldsw = (unsigned)wid * 1024u;
  const int aoff = lds_byte(wr * 64 + fr, fq * 8), boff = lds_byte(wc * 32 + fr, fq * 8);
#define PG8_SA(b, h) (((b) * 2 + (h)) * HTB)
#define PG8_SB(b, h) ((4 + (b) * 2 + (h)) * HTB)
#define PG8_STAGE(bufoff, gbase, voff) do { _Pragma("unroll") for (int _i = 0; _i < 2; ++_i) \
        __builtin_amdgcn_global_load_lds((const unsigned*)((const char*)(gbase) + (voff)[_i]), (LAS unsigned*)(lds + (bufoff) + ldsw + _i * 8192), 16, 0, 0); } while (0)
#define PG8_LDA(dst, b, h) do { _Pragma("unroll") for (int m = 0; m < 4; ++m) _Pragma("unroll") for (int k = 0; k < 2; ++k) dst[m][k] = *(const LAS bf16x8*)(lds + PG8_SA(b, h) + aoff + m * 2048 + k * 1024); } while (0)
#define PG8_LDB(dst, b, h) do { _Pragma("unroll") for (int n = 0; n < 2; ++n) _Pragma("unroll") for (int k = 0; k < 2; ++k) dst[n][k] = *(const LAS bf16x8*)(lds + PG8_SB(b, h) + boff + n * 2048 + k * 1024); } while (0)
#define PG8_MMA(ai, bj, At, Bt) do { __builtin_amdgcn_s_setprio(1); _Pragma("unroll") for (int m = 0; m < 4; ++m) _Pragma("unroll") for (int n = 0; n < 2; ++n) _Pragma("unroll") for (int k = 0; k < 2; ++k) \
        acc[ai][bj][m][n] = __builtin_amdgcn_mfma_f32_16x16x32_bf16(Bt[n][k], At[m][k], acc[ai][bj][m][n], 0, 0, 0); __builtin_amdgcn_s_setprio(0); } while (0)
#define PG8_WAIT_V(n) asm volatile("s_waitcnt vmcnt(" #n ")" ::: "memory")
#define PG8_WAIT_L(n) asm volatile("s_waitcnt lgkmcnt(" #n ")" ::: "memory")
#define PG8_BAR __builtin_amdgcn_s_barrier()
#define PG8_SCHED __builtin_amdgcn_sched_barrier(0)
  Unit cur, nxt;
  int ui = 0;
  if (!S.next(0, cur)) return;
  f32x4 acc[2][2][4][2];
#pragma unroll
  for (int a = 0; a < 2; ++a)
#pragma unroll
    for (int b = 0; b < 2; ++b)
#pragma unroll
      for (int m = 0; m < 4; ++m)
#pragma unroll
        for (int n = 0; n < 2; ++n) acc[a][b][m][n] = (f32x4){0.f, 0.f, 0.f, 0.f};
  bf16x8 At[4][2], B0[2][2], B1[2][2];
  const char* cA = (const char*)g.A + (size_t)cur.pm * tstep;
  const char* cB = (const char*)g.Bt + (size_t)cur.pn * tstep;
  PG8_STAGE(PG8_SB(0, 0), cB, voffB); PG8_STAGE(PG8_SA(0, 0), cA, voffA); PG8_STAGE(PG8_SB(0, 1), cB + hstep, voffB); PG8_STAGE(PG8_SA(0, 1), cA + hstep, voffA);
  if (wr == 1) PG8_BAR;
  PG8_WAIT_V(4); PG8_BAR;
  PG8_STAGE(PG8_SB(1, 0), cB + kstep, voffB); PG8_STAGE(PG8_SA(1, 0), cA + kstep, voffA); PG8_STAGE(PG8_SB(1, 1), cB + hstep + kstep, voffB);
  PG8_WAIT_V(6); PG8_BAR;
  for (;;) {
    const bool has_next = S.next(ui + 1, nxt);
    const char* nA = has_next ? (const char*)g.A + (size_t)nxt.pm * tstep : cA;
    const char* nB = has_next ? (const char*)g.Bt + (size_t)nxt.pn * tstep : cB;
    for (int t = 0; t < nt; t += 2) {
      const bool last = (t == nt - 2);
      const char* a1 = cA + (size_t)(t + 1) * kstep;
      const char* a2 = last ? nA : cA + (size_t)(t + 2) * kstep;
      const char* b2 = last ? nB : cB + (size_t)(t + 2) * kstep;
      const char* a3 = a2 + kstep;
      const char* b3 = b2 + kstep;
      PG8_LDB(B0, 0, 0); PG8_SCHED; PG8_LDA(At, 0, 0); PG8_STAGE(PG8_SA(1, 1), a1 + hstep, voffA);
      PG8_WAIT_L(8); PG8_BAR; PG8_WAIT_L(0); PG8_MMA(0, 0, At, B0); PG8_BAR; PG8_SCHED;
      PG8_LDB(B1, 0, 1); PG8_STAGE(PG8_SB(0, 0), b2, voffB);
      PG8_BAR; PG8_WAIT_L(0); PG8_MMA(0, 1, At, B1); PG8_BAR;
      PG8_LDA(At, 0, 1); PG8_STAGE(PG8_SA(0, 0), a2, voffA);
      PG8_BAR; PG8_WAIT_L(0); PG8_MMA(1, 0, At, B0); PG8_BAR; PG8_SCHED;
      PG8_STAGE(PG8_SB(0, 1), b2 + hstep, voffB);
      PG8_WAIT_V(6); PG8_BAR; PG8_MMA(1, 1, At, B1); PG8_BAR;
      PG8_LDB(B0, 1, 0); PG8_SCHED; PG8_LDA(At, 1, 0); PG8_STAGE(PG8_SA(0, 1), a2 + hstep, voffA);
      PG8_WAIT_L(8); PG8_BAR; PG8_WAIT_L(0); PG8_MMA(0, 0, At, B0); PG8_BAR; PG8_SCHED;
      PG8_LDB(B1, 1, 1); PG8_STAGE(PG8_SB(1, 0), b3, voffB);
      PG8_BAR; PG8_WAIT_L(0); PG8_MMA(0, 1, At, B1); PG8_BAR;
      PG8_LDA(At, 1, 1); PG8_STAGE(PG8_SA(1, 0), a3, voffA);
      PG8_BAR; PG8_WAIT_L(0); PG8_MMA(1, 0, At, B0); PG8_BAR; PG8_SCHED;
      PG8_STAGE(PG8_SB(1, 1), b3 + hstep, voffB);
      PG8_WAIT_V(6); PG8_BAR; PG8_MMA(1, 1, At, B1); PG8_BAR;
    }
    E(acc, cur, wr, wc, fr, fq);
    if (!has_next) break;
#pragma unroll
    for (int a = 0; a < 2; ++a)
#pragma unroll
      for (int b = 0; b < 2; ++b)
#pragma unroll
        for (int m = 0; m < 4; ++m)
#pragma unroll
          for (int n = 0; n < 2; ++n) acc[a][b][m][n] = (f32x4){0.f, 0.f, 0.f, 0.f};
    cur = nxt; cA = nA; cB = nB; ++ui;
  }
  PG8_WAIT_V(0);
  if (wr == 0) PG8_BAR;
  PG8_BAR;
#undef PG8_SA
#undef PG8_SB
#undef PG8_STAGE
#undef PG8_LDA
#undef PG8_LDB
#undef PG8_MMA
#undef PG8_WAIT_V
#undef PG8_WAIT_L
#undef PG8_BAR
#undef PG8_SCHED
}

struct S5C {
  float ab_re, ab_im;
  float bb_re[16], bb_im[16];
};
DEVI void s5_consts(const Params& p, int d, int g, int n, S5C& c) {
  int ix = (d * 64 + g) * 64 + n;
  float lam = fminf(p.s5_A_re[ix], -1e-4f), aim = p.s5_A_im[ix];
  float dt = expf(p.s5_log_dt[d * 64 + g]);
  float mag = expf(lam * dt), sn, cs;
  sincosf(aim * dt, &sn, &cs);
  c.ab_re = mag * cs;
  c.ab_im = mag * sn;
  float den = lam * lam + aim * aim;
  float f_re = ((c.ab_re - 1.f) * lam + c.ab_im * aim) / den;
  float f_im = (c.ab_im * lam - (c.ab_re - 1.f) * aim) / den;
  const float4* br = (const float4*)(p.s5_B_re + (size_t)ix * 16);
  const float4* bi = (const float4*)(p.s5_B_im + (size_t)ix * 16);
#pragma unroll
  for (int q = 0; q < 4; ++q) {
    float4 r = br[q], i = bi[q];
    c.bb_re[q * 4 + 0] = f_re * r.x - f_im * i.x; c.bb_im[q * 4 + 0] = f_re * i.x + f_im * r.x;
    c.bb_re[q * 4 + 1] = f_re * r.y - f_im * i.y; c.bb_im[q * 4 + 1] = f_re * i.y + f_im * r.y;
    c.bb_re[q * 4 + 2] = f_re * r.z - f_im * i.z; c.bb_im[q * 4 + 2] = f_re * i.z + f_im * r.z;
    c.bb_re[q * 4 + 3] = f_re * r.w - f_im * i.w; c.bb_im[q * 4 + 3] = f_re * i.w + f_im * r.w;
  }
}
DEVI void load_u16x16(const u16* ptr, float* u) {
  uint4 a = *(const uint4*)ptr, b = *(const uint4*)(ptr + 8);
  unsigned w[8] = {a.x, a.y, a.z, a.w, b.x, b.y, b.z, b.w};
#pragma unroll
  for (int i = 0; i < 8; ++i) {
    u[2 * i] = __uint_as_float(w[i] << 16);
    u[2 * i + 1] = __uint_as_float(w[i] & 0xFFFF0000u);
  }
}
DEVI int s5_cu(int d, int q) { return d == 0 ? q : (q < 4 ? 3 - q : 71 - q); }
DEVI int s5_q(int d, int cu) { return d == 0 ? cu : (cu < 4 ? 3 - cu : 71 - cu); }

DEVI void ph_s5_pass1(const Params& p, int gw, int nw, char* smem) {
  int lane = threadIdx.x & 63;
  u16* Us = (u16*)smem + (threadIdx.x >> 6) * 1024;
  const u16* P = (const u16*)(p.ws + OFF_BIG + B0_P);
  float* E = (float*)(p.ws + OFF_S5E);
  for (int task = gw; task < NB * 64 * 2 * 68; task += nw) {
    int q = task % 68, d = (task / 68) & 1, g = (task / 136) & 63, b = task / (136 * 64);
    S5C c;
    s5_consts(p, d, g, lane, c);
    int cu = s5_cu(d, q);
    {
      const u16* up = P + (size_t)(b * LT + cu * 64 + lane) * AB_INP + RCOLS + g * 16;
      uint4 u0 = *(const uint4*)up, u1 = *(const uint4*)(up + 8);
      wave_lds_fence();
      *(uint4*)(Us + lane * 16) = u0;
      *(uint4*)(Us + lane * 16 + 8) = u1;
      wave_lds_fence();
    }
    float hr = 0.f, hi = 0.f;
    for (int i = 0; i < 64; ++i) {
      int tl = d == 0 ? i : 63 - i;
      float u[16];
      load_u16x16(Us + tl * 16, u);
      float br = 0.f, bi = 0.f;
#pragma unroll
      for (int k = 0; k < 16; ++k) { br += c.bb_re[k] * u[k]; bi += c.bb_im[k] * u[k]; }
      float nr = c.ab_re * hr - c.ab_im * hi + br;
      float ni = c.ab_re * hi + c.ab_im * hr + bi;
      hr = nr; hi = ni;
    }
    size_t ei = ((((size_t)(b * 64 + g) * 2 + d) * 68 + q) * 64 + lane) * 2;
    *(float2*)(E + ei) = make_float2(hr, hi);
  }
}

DEVI void ph_s5_prefix(const Params& p, int gw, int nw) {
  const int lane = threadIdx.x & 63;
  float* E = (float*)(p.ws + OFF_S5E);
  for (int task = gw; task < NB * 64 * 2; task += nw) {
    const int d = task & 1, g = (task >> 1) & 63, b = task >> 7;
    const int ix = (d * 64 + g) * 64 + lane;
    const float lam = fminf(p.s5_A_re[ix], -1e-4f), aim = p.s5_A_im[ix];
    const float dt = expf(p.s5_log_dt[d * 64 + g]);
    const float mag = expf(lam * dt);
    float sn, cs;
    sincosf(aim * dt, &sn, &cs);
    float qr = mag * cs, qi = mag * sn;
#pragma unroll
    for (int sq = 0; sq < 6; ++sq) { float t0 = qr * qr - qi * qi, t1 = 2.f * qr * qi; qr = t0; qi = t1; }
    float* Eb = E + (((size_t)(b * 64 + g) * 2 + d) * 68) * 128 + lane * 2;
    float sr = 0.f, si = 0.f;
#pragma unroll 4
    for (int q = 0; q < 68; ++q) {
      float2 e = *(const float2*)(Eb + (size_t)q * 128);
      *(float2*)(Eb + (size_t)q * 128) = make_float2(sr, si);
      float nr = qr * sr - qi * si + e.x, ni = qr * si + qi * sr + e.y;
      sr = nr; si = ni;
    }
  }
}

DEVI void ph_s5_pass2(const Params& p, int gw, int nw, char* smem) {
  typedef float f32x2 __attribute__((ext_vector_type(2)));
  const int lane = threadIdx.x & 63, wid = threadIdx.x >> 6;
  constexpr int HP = 130;
  float* Hs = (float*)smem + wid * (16 * HP + 512);
  u16* Us = (u16*)(Hs + 16 * HP);
  const u16* P = (const u16*)(p.ws + OFF_BIG + B0_P);
  const float* E = (const float*)(p.ws + OFF_S5E);
  u16* YG = (u16*)(p.ws + OFF_BIG + B0_YG);
  const int mi = lane & 15, mk = lane >> 4;
  for (int task = gw; task < NB * 64 * 68; task += nw) {
    const int cu = task % 68, g = (task / 68) & 63, b = task / (68 * 64);
    f32x4 Y[4];
#pragma unroll
    for (int q = 0; q < 4; ++q) Y[q] = (f32x4){0.f, 0.f, 0.f, 0.f};
    {
      const u16* up = P + (size_t)(b * LT + cu * 64 + lane) * AB_INP + RCOLS + g * 16;
      uint4 u0 = *(const uint4*)up, u1 = *(const uint4*)(up + 8);
      wave_lds_fence();
      *(uint4*)(Us + lane * 16) = u0;
      *(uint4*)(Us + lane * 16 + 8) = u1;
      wave_lds_fence();
    }
    for (int d = 0; d < 2; ++d) {
      S5C c;
      s5_consts(p, d, g, lane, c);
      float cm[32];
#pragma unroll
      for (int kk = 0; kk < 32; ++kk) {
        int k = 4 * kk + mk, n = k >> 1;
        size_t ci = ((size_t)(d * 64 + g) * 16 + mi) * 64 + n;
        cm[kk] = (k & 1) ? -p.s5_C_im[ci] : p.s5_C_re[ci];
      }
      const int q = s5_q(d, cu);
      const float2 e0 = *(const float2*)(E + ((((size_t)(b * 64 + g) * 2 + d) * 68 + q) * 64 + lane) * 2);
      float hr = e0.x, hi = e0.y;
      for (int sb = 0; sb < 4; ++sb) {
        const int blk = d == 0 ? sb : 3 - sb;
        for (int i = 0; i < 16; ++i) {
          const int tl = d == 0 ? i : 15 - i;
          float u[16];
          load_u16x16(Us + (blk * 16 + tl) * 16, u);
          f32x2 bu = (f32x2){0.f, 0.f};
#pragma unroll
          for (int k = 0; k < 16; ++k) bu += (f32x2){c.bb_re[k], c.bb_im[k]} * u[k];
          float nr = c.ab_re * hr - c.ab_im * hi + bu.x;
          float ni = c.ab_re * hi + c.ab_im * hr + bu.y;
          hr = nr; hi = ni;
          *(float2*)(Hs + tl * HP + 2 * lane) = make_float2(hr, hi);
        }
        wave_lds_fence();
        f32x4 acc = Y[blk];
#pragma unroll
        for (int kk = 0; kk < 32; ++kk) {
          float a = Hs[mi * HP + 4 * kk + mk];
          acc = __builtin_amdgcn_mfma_f32_16x16x4f32(a, cm[kk], acc, 0, 0, 0);
        }
        Y[blk] = acc;
        wave_lds_fence();
      }
    }
    const float dsk = p.s5_D[g * 16 + mi];
#pragma unroll
    for (int blk = 0; blk < 4; ++blk)
#pragma unroll
      for (int r = 0; r < 4; ++r) {
        const int row = b * LT + cu * 64 + blk * 16 + 4 * mk + r;
        float uu = bf2f(Us[(blk * 16 + 4 * mk + r) * 16 + mi]);
        float y0 = Y[blk][r] + dsk * uu;
        y0 = 0.5f * y0 * (1.f + tanhf(0.7978845608f * (y0 + 0.044715f * y0 * y0 * y0)));
        YG[(size_t)row * 1024 + g * 16 + mi] = f2bf(y0);
      }
  }
}

DEVI void ph_lora_in(const Params& p, int bid, int nb) {
  const u16* P = (const u16*)(p.ws + OFF_BIG + B0_P);
  u16* LIN = (u16*)(p.ws + OFF_BIG + B0_LIN);
  const size_t total = (size_t)T * 256;
  for (size_t it = (size_t)bid * NTH + threadIdx.x; it < total; it += (size_t)nb * NTH) {
    int row = (int)(it >> 8), jp = (int)(it & 255);
    if (jp >= 224) { *(unsigned*)(LIN + (size_t)row * 512 + jp * 2) = 0u; continue; }
    int pos = row % LT;
    bool first = (pos == 0 || pos == CL), last = (pos == CL - 1 || pos == LT - 1);
    int col = 3072 + jp * 2;
    unsigned cu = *(const unsigned*)(P + (size_t)row * AB_INP + col);
    unsigned pv = first ? 0u : *(const unsigned*)(P + (size_t)(row - 1) * AB_INP + col);
    unsigned nx = last ? 0u : *(const unsigned*)(P + (size_t)(row + 1) * AB_INP + col);
    float o[2];
#pragma unroll
    for (int e = 0; e < 2; ++e) {
      float c = e ? __uint_as_float(cu & 0xFFFF0000u) : __uint_as_float(cu << 16);
      float pr = e ? __uint_as_float(pv & 0xFFFF0000u) : __uint_as_float(pv << 16);
      float nn = e ? __uint_as_float(nx & 0xFFFF0000u) : __uint_as_float(nx << 16);
      float m0 = p.rwkv_mu[col + e], m1 = p.rwkv_mu[RCOLS + col + e];
      float s = c + m0 * (pr - c) + m1 * (nn - c);
      int j = jp * 2 + e;
      o[e] = j < 96 ? tanhf(s) : (j < 192 ? s : sigmoidf(s));
    }
    *(unsigned*)(LIN + (size_t)row * 512 + jp * 2) = pack2(o[0], o[1]);
  }
}

DEVI void ph_rwkv_scan(const Params& p, int blk, char* smem) {
  const int d = blk & 1, h = (blk >> 1) & 15, b = blk >> 5;
  const int tid = threadIdx.x, wid = __builtin_amdgcn_readfirstlane(tid >> 6), lane = tid & 63;
  constexpr int NCH = LT / 8;
  constexpr int BW = 6 * 8 * 64;
  float* bufs = (float*)smem;
  float* ybuf = bufs + 2 * BW;
  const u16* P = (const u16*)(p.ws + OFF_BIG + B0_P);
  const u16* WL = (const u16*)(p.ws + OFF_BIG + B0_WL) + (size_t)d * T * 1024;
  const u16* AL = (const u16*)(p.ws + OFF_BIG + B0_AL) + (size_t)d * T * 1024;
  u16* YR = (u16*)(p.ws + OFF_BIG + B0_YR) + (size_t)d * T * 1024;
  float* RK = (float*)(p.ws + OFF_RK) + (size_t)d * T * 16;
  if (wid >= 4) {
    const int sw = wid - 4;
    const int c = h * 64 + lane;
    const float mr0 = p.rwkv_mu[c], mr1 = p.rwkv_mu[RCOLS + c];
    const float mk0 = p.rwkv_mu[1024 + c], mk1 = p.rwkv_mu[RCOLS + 1024 + c];
    const float mv0 = p.rwkv_mu[2048 + c], mv1 = p.rwkv_mu[RCOLS + 2048 + c];
    const float w0 = p.rwkv_w0[d * 1024 + c], a0 = p.rwkv_a0[d * 1024 + c];
    const float kkc = p.rwkv_k_k[c], kac = p.rwkv_k_a[c], rkc = p.rwkv_r_k[c];
    u16 R0[2][11], R1[2][11], R2[2][11], R3[2][11];
    auto load_raw = [&](int ch, u16 (&raw)[2][11]) {
      ch = ch < NCH ? ch : NCH - 1;
#pragma unroll
      for (int i = 0; i < 2; ++i) {
        int pos = dirpos(d, ch * 8 + sw * 2 + i);
        int row = b * LT + pos;
        bool first = (pos == 0 || pos == CL), last = (pos == CL - 1 || pos == LT - 1);
        const u16* pr = P + (size_t)row * AB_INP + c;
        const u16* pp = first ? pr : pr - AB_INP;
        const u16* pn = last ? pr : pr + AB_INP;
#pragma unroll
        for (int s3 = 0; s3 < 3; ++s3) {
          raw[i][s3 * 3 + 0] = pr[s3 * 1024];
          raw[i][s3 * 3 + 1] = pp[s3 * 1024];
          raw[i][s3 * 3 + 2] = pn[s3 * 1024];
        }
        raw[i][9] = WL[(size_t)row * 1024 + c];
        raw[i][10] = AL[(size_t)row * 1024 + c];
      }
    };
    auto process = [&](int ch, const u16 (&raw)[2][11], float* buf) {
      ch = ch < NCH ? ch : NCH - 1;
#pragma unroll
      for (int i = 0; i < 2; ++i) {
        int tt = sw * 2 + i;
        int pos = dirpos(d, ch * 8 + tt);
        int row = b * LT + pos;
        float fm = (pos == 0 || pos == CL) ? 0.f : 1.f, lm = (pos == CL - 1 || pos == LT - 1) ? 0.f : 1.f;
        float rc = bf2f(raw[i][0]), rp = bf2f(raw[i][1]) * fm, rn = bf2f(raw[i][2]) * lm;
        float kc = bf2f(raw[i][3]), kp = bf2f(raw[i][4]) * fm, kn = bf2f(raw[i][5]) * lm;
        float vc = bf2f(raw[i][6]), vp = bf2f(raw[i][7]) * fm, vn = bf2f(raw[i][8]) * lm;
        float r = rc + mr0 * (rp - rc) + mr1 * (rn - rc);
        float k = kc + mk0 * (kp - kc) + mk1 * (kn - kc);
        float v = vc + mv0 * (vp - vc) + mv1 * (vn - vc);
        float kkraw = k * kkc;
        float nrm = sqrtf(wave_sum(kkraw * kkraw));
        float kk = kkraw / fmaxf(nrm, 1e-12f);
        float z = w0 + bf2f(raw[i][9]);
        float sg = 1.f / (1.f + expf(-z));
        float decay = expf(-0.60653065971f * sg);
        float a = 1.f / (1.f + expf(-(a0 + bf2f(raw[i][10]))));
        float kd = k * (1.f + (a - 1.f) * kac);
        float rk = wave_sum(r * kd * rkc);
        if (lane == 0) RK[(size_t)row * 16 + h] = rk;
        buf[(0 * 8 + tt) * 64 + lane] = r;
        buf[(1 * 8 + tt) * 64 + lane] = decay;
        buf[(2 * 8 + tt) * 64 + lane] = kd;
        buf[(3 * 8 + tt) * 64 + lane] = kk;
        buf[(4 * 8 + tt) * 64 + lane] = kk * a;
        buf[(5 * 8 + tt) * 64 + lane] = v;
      }
    };
    auto bulk = [&](int ch) {
#pragma unroll
      for (int i = 0; i < 2; ++i) {
        const int tt = sw * 2 + i;
        const float4* yp = (const float4*)(ybuf + ((((ch & 1) * 8 + tt) * 32 + (lane >> 1)) * 8) * 2);
        float4 q0 = yp[0], q1 = yp[1], q2 = yp[2], q3 = yp[3];
        float ya = (q0.x + q0.z) + (q1.x + q1.z) + (q2.x + q2.z) + (q3.x + q3.z);
        float yb = (q0.y + q0.w) + (q1.y + q1.w) + (q2.y + q2.w) + (q3.y + q3.w);
        int row = b * LT + dirpos(d, ch * 8 + tt);
        YR[(size_t)row * 1024 + h * 64 + lane] = f2bf((lane & 1) ? yb : ya);
      }
    };
    load_raw(0, R0);
    process(0, R0, bufs);
    load_raw(1, R1);
    load_raw(2, R2);
    load_raw(3, R3);
    load_raw(4, R0);
    lds_barrier();
    for (int ch = 0; ch < NCH; ch += 4) {
      if (ch > 0) bulk(ch - 1);
      process(ch + 1, R1, bufs + BW);
      load_raw(ch + 5, R1);
      lds_barrier();
      bulk(ch);
      process(ch + 2, R2, bufs);
      load_raw(ch + 6, R2);
      lds_barrier();
      bulk(ch + 1);
      process(ch + 3, R3, bufs + BW);
      load_raw(ch + 7, R3);
      lds_barrier();
      bulk(ch + 2);
      process(ch + 4, R0, bufs);
      load_raw(ch + 8, R0);
      lds_barrier();
    }
    lds_barrier();
    bulk(NCH - 1);
  } else {
    const int rp = tid >> 3, ks = tid & 7;
    float S[16];
#pragma unroll
    for (int i = 0; i < 16; ++i) S[i] = 0.f;
    lds_barrier();
    for (int ch = 0; ch < NCH; ++ch) {
      const float* buf = bufs + (ch & 1) * BW;
      struct Ops { float4 r4[2], w4[2], kd4[2], kk4[2], bb4[2]; float2 vv; };
      auto fetch = [&](Ops& o, int tt) {
        const float* bs = buf + tt * 64 + ks * 8;
#pragma unroll
        for (int i = 0; i < 2; ++i) {
          o.r4[i] = *(const float4*)(bs + 0 * 512 + i * 4);
          o.w4[i] = *(const float4*)(bs + 1 * 512 + i * 4);
          o.kd4[i] = *(const float4*)(bs + 2 * 512 + i * 4);
          o.kk4[i] = *(const float4*)(bs + 3 * 512 + i * 4);
          o.bb4[i] = *(const float4*)(bs + 4 * 512 + i * 4);
        }
        o.vv = *(const float2*)(buf + 5 * 512 + tt * 64 + rp * 2);
      };
      auto compute = [&](const Ops& o, int tt) {
        float dotA = 0.f, dotB = 0.f;
#pragma unroll
        for (int i = 0; i < 2; ++i) {
          dotA = fmaf(S[i * 4 + 0], o.kk4[i].x, dotA); dotA = fmaf(S[i * 4 + 1], o.kk4[i].y, dotA);
          dotA = fmaf(S[i * 4 + 2], o.kk4[i].z, dotA); dotA = fmaf(S[i * 4 + 3], o.kk4[i].w, dotA);
          dotB = fmaf(S[8 + i * 4 + 0], o.kk4[i].x, dotB); dotB = fmaf(S[8 + i * 4 + 1], o.kk4[i].y, dotB);
          dotB = fmaf(S[8 + i * 4 + 2], o.kk4[i].z, dotB); dotB = fmaf(S[8 + i * 4 + 3], o.kk4[i].w, dotB);
        }
        dotA = sum8(dotA);
        dotB = sum8(dotB);
        float yA = 0.f, yB = 0.f;
#pragma unroll
        for (int i = 0; i < 2; ++i) {
          S[i * 4 + 0] = S[i * 4 + 0] * o.w4[i].x + (o.vv.x * o.kd4[i].x - dotA * o.bb4[i].x);
          S[i * 4 + 1] = S[i * 4 + 1] * o.w4[i].y + (o.vv.x * o.kd4[i].y - dotA * o.bb4[i].y);
          S[i * 4 + 2] = S[i * 4 + 2] * o.w4[i].z + (o.vv.x * o.kd4[i].z - dotA * o.bb4[i].z);
          S[i * 4 + 3] = S[i * 4 + 3] * o.w4[i].w + (o.vv.x * o.kd4[i].w - dotA * o.bb4[i].w);
          S[8 + i * 4 + 0] = S[8 + i * 4 + 0] * o.w4[i].x + (o.vv.y * o.kd4[i].x - dotB * o.bb4[i].x);
          S[8 + i * 4 + 1] = S[8 + i * 4 + 1] * o.w4[i].y + (o.vv.y * o.kd4[i].y - dotB * o.bb4[i].y);
          S[8 + i * 4 + 2] = S[8 + i * 4 + 2] * o.w4[i].z + (o.vv.y * o.kd4[i].z - dotB * o.bb4[i].z);
          S[8 + i * 4 + 3] = S[8 + i * 4 + 3] * o.w4[i].w + (o.vv.y * o.kd4[i].w - dotB * o.bb4[i].w);
          yA = fmaf(S[i * 4 + 0], o.r4[i].x, yA); yA = fmaf(S[i * 4 + 1], o.r4[i].y, yA);
          yA = fmaf(S[i * 4 + 2], o.r4[i].z, yA); yA = fmaf(S[i * 4 + 3], o.r4[i].w, yA);
          yB = fmaf(S[8 + i * 4 + 0], o.r4[i].x, yB); yB = fmaf(S[8 + i * 4 + 1], o.r4[i].y, yB);
          yB = fmaf(S[8 + i * 4 + 2], o.r4[i].z, yB); yB = fmaf(S[8 + i * 4 + 3], o.r4[i].w, yB);
        }
        *(float2*)(ybuf + ((((ch & 1) * 8 + tt) * 32 + rp) * 8 + ks) * 2) = make_float2(yA, yB);
      };
      Ops o0, o1;
      fetch(o0, 0);
#pragma unroll 2
      for (int tt = 0; tt < 8; tt += 2) {
        fetch(o1, tt + 1);
        compute(o0, tt);
        fetch(o0, tt + 2 < 8 ? tt + 2 : 7);
        compute(o1, tt + 1);
      }
      lds_barrier();
    }
    lds_barrier();
  }
  lds_barrier();
}

DEVI void unpack8(uint4 v, float* f) {
  unsigned w[4] = {v.x, v.y, v.z, v.w};
#pragma unroll
  for (int i = 0; i < 4; ++i) { f[2 * i] = __uint_as_float(w[i] << 16); f[2 * i + 1] = __uint_as_float(w[i] & 0xFFFF0000u); }
}
DEVI void ph_rwkv_post(const Params& p, int gw, int nw) {
  const int lane = threadIdx.x & 63;
  const u16* P = (const u16*)(p.ws + OFF_BIG + B0_P);
  const u16* YR = (const u16*)(p.ws + OFF_BIG + B0_YR);
  const u16* G = (const u16*)(p.ws + OFF_BIG + B0_G);
  const float* RK = (const float*)(p.ws + OFF_RK);
  u16* CAT = (u16*)(p.ws + OFF_H);
  const int c0 = lane * 16, h = lane >> 2;
  for (int row = gw; row < T; row += nw) {
    int pos = row % LT;
    bool first = (pos == 0 || pos == CL), last = (pos == CL - 1 || pos == LT - 1);
    const u16* y0p = YR + (size_t)row * 1024 + c0;
    const u16* y1p = YR + (size_t)(T + row) * 1024 + c0;
    const u16* vp = P + (size_t)row * AB_INP + 2048 + c0;
    const u16* vpp = first ? vp : vp - AB_INP;
    const u16* vnp = last ? vp : vp + AB_INP;
    const u16* gp = G + (size_t)row * 1024 + c0;
    uint4 ra[2], rb[2], rv[2], rvp[2], rvn[2], rg[2];
#pragma unroll
    for (int i = 0; i < 2; ++i) {
      ra[i] = *(const uint4*)(y0p + i * 8); rb[i] = *(const uint4*)(y1p + i * 8);
      rv[i] = *(const uint4*)(vp + i * 8); rvp[i] = *(const uint4*)(vpp + i * 8); rvn[i] = *(const uint4*)(vnp + i * 8);
      rg[i] = *(const uint4*)(gp + i * 8);
    }
    const float rk = RK[(size_t)row * 16 + h] + RK[(size_t)(T + row) * 16 + h];
    const float fm = first ? 0.f : 1.f, lm = last ? 0.f : 1.f;
    float y[16], s1 = 0.f;
#pragma unroll
    for (int i = 0; i < 2; ++i) {
      float a[8], bq[8];
      unpack8(ra[i], a); unpack8(rb[i], bq);
#pragma unroll
      for (int e = 0; e < 8; ++e) { y[i * 8 + e] = a[e] + bq[e]; s1 += y[i * 8 + e]; }
    }
    s1 += dpp_xor1(s1); s1 += dpp_xor2(s1);
    const float mean = s1 * (1.f / 64.f);
    float s2 = 0.f;
#pragma unroll
    for (int e = 0; e < 16; ++e) { y[e] -= mean; s2 += y[e] * y[e]; }
    s2 += dpp_xor1(s2); s2 += dpp_xor2(s2);
    const float rs = rsqrtf(s2 * (1.f / 64.f) + 64e-5f);
#pragma unroll
    for (int i = 0; i < 2; ++i) {
      float vc[8], vq[8], vn[8], gg[8];
      unpack8(rv[i], vc); unpack8(rvp[i], vq); unpack8(rvn[i], vn); unpack8(rg[i], gg);
      unsigned o[4];
      const int cb = c0 + i * 8;
      float m0[8], m1[8], lg[8], lb[8];
      *(float4*)m0 = *(const float4*)(p.rwkv_mu + 2048 + cb); *(float4*)(m0 + 4) = *(const float4*)(p.rwkv_mu + 2048 + cb + 4);
      *(float4*)m1 = *(const float4*)(p.rwkv_mu + RCOLS + 2048 + cb); *(float4*)(m1 + 4) = *(const float4*)(p.rwkv_mu + RCOLS + 2048 + cb + 4);
      *(float4*)lg = *(const float4*)(p.rwkv_ln_g + cb); *(float4*)(lg + 4) = *(const float4*)(p.rwkv_ln_g + cb + 4);
      *(float4*)lb = *(const float4*)(p.rwkv_ln_b + cb); *(float4*)(lb + 4) = *(const float4*)(p.rwkv_ln_b + cb + 4);
#pragma unroll
      for (int e2 = 0; e2 < 4; ++e2) {
        float r2[2];
#pragma unroll
        for (int q = 0; q < 2; ++q) {
          int e = e2 * 2 + q;
          float v = vc[e] + m0[e] * (vq[e] * fm - vc[e]) + m1[e] * (vn[e] * lm - vc[e]);
          r2[q] = (y[i * 8 + e] * rs * lg[e] + lb[e] + rk * v) * gg[e];
        }
        o[e2] = pack2(r2[0], r2[1]);
      }
      *(uint4*)(CAT + (size_t)row * D + c0 + i * 8) = make_uint4(o[0], o[1], o[2], o[3]);
    }
  }
}

DEVI void ph_cd_prep(const Params& p, int bid, int nb, char* smem) {
  u16* P = (u16*)(p.ws + OFF_BIG + B1_P);
  u16* XBC = (u16*)(p.ws + OFF_BIG + B1_XBC);
  float* DT = (float*)(p.ws + OFF_DT);
  const size_t gtid = (size_t)bid * NTH + threadIdx.x, gstride = (size_t)nb * NTH;
  float2* tab = (float2*)smem;
  for (int i = threadIdx.x; i < 64 * 16; i += NTH) {
    int v = i >> 4, f = i & 15;
    float inv = exp2f(-(float)f * (13.287712379549449f / 16.f));
    float sn, cs;
    sincosf((float)v * inv, &sn, &cs);
    tab[i] = make_float2(cs, sn);
  }
  __syncthreads();
  for (size_t it = gtid; it < (size_t)T * 384; it += gstride) {
    int row = (int)(it / 384), c = (int)(it % 384) * 8;
    int pos = row % LT;
    int lo = pos < CL ? 0 : CL, hi = pos < CL ? CL : LT;
    float acc[8];
    {
      float4 b0 = *(const float4*)(p.ssd_conv_b + c), b1 = *(const float4*)(p.ssd_conv_b + c + 4);
      acc[0] = b0.x; acc[1] = b0.y; acc[2] = b0.z; acc[3] = b0.w; acc[4] = b1.x; acc[5] = b1.y; acc[6] = b1.z; acc[7] = b1.w;
    }
    uint4 xv[5];
#pragma unroll
    for (int j = 0; j < 5; ++j) {
      int pp = pos + j - 2;
      bool ok = (pp >= lo && pp < hi);
      xv[j] = *(const uint4*)(P + (size_t)(ok ? row + j - 2 : row) * CD_INP + 2048 + c);
    }
#pragma unroll
    for (int j = 0; j < 5; ++j) {
      int pp = pos + j - 2;
      float m = (pp >= lo && pp < hi) ? 1.f : 0.f;
      float x[8];
      unpack8(xv[j], x);
      float4 w0 = *(const float4*)(p.ssd_conv_w + j * 3072 + c), w1 = *(const float4*)(p.ssd_conv_w + j * 3072 + c + 4);
      acc[0] += m * w0.x * x[0]; acc[1] += m * w0.y * x[1]; acc[2] += m * w0.z * x[2]; acc[3] += m * w0.w * x[3];
      acc[4] += m * w1.x * x[4]; acc[5] += m * w1.y * x[5]; acc[6] += m * w1.z * x[6]; acc[7] += m * w1.w * x[7];
    }
    unsigned o[4];
#pragma unroll
    for (int e = 0; e < 4; ++e) {
      float a0 = acc[2 * e], a1 = acc[2 * e + 1];
      o[e] = pack2(a0 * sigmoidf(a0), a1 * sigmoidf(a1));
    }
    *(uint4*)(XBC + (size_t)row * 3072 + c) = make_uint4(o[0], o[1], o[2], o[3]);
  }
  for (size_t it = gtid; it < (size_t)T * 64; it += gstride) {
    int row = (int)(it >> 6), dh = (int)(it & 63);
    float x = bf2f(P[(size_t)row * CD_INP + 5120 + dh]) + p.ssd_dt_bias[dh];
    float sp = x > 20.f ? x : log1pf(expf(x));
    DT[((size_t)(dh >> 5) * T + row) * 32 + (dh & 31)] = sp;
  }
  for (size_t it = gtid; it < (size_t)NB * SEQ * 40; it += gstride) {
    int a = (int)(it & 1), hh = (int)((it >> 1) % 20);
    int tok = (int)(it / 40);
    int b = tok / SEQ, xp = tok % SEQ;
    int row = b * LT + CL + xp;
    int colbase = (hh < 16 ? 5184 + hh * 64 : 6208 + (hh - 16) * 64) + a * 32;
    const float2* tb = tab + (a == 0 ? (xp >> 6) : (xp & 63)) * 16;
    u16* q1 = P + (size_t)row * CD_INP + colbase;
    uint4 l0 = *(const uint4*)q1, l1 = *(const uint4*)(q1 + 8), h0 = *(const uint4*)(q1 + 16), h1 = *(const uint4*)(q1 + 24);
    float x1[16], x2[16];
    unpack8(l0, x1); unpack8(l1, x1 + 8); unpack8(h0, x2); unpack8(h1, x2 + 8);
    unsigned o1[8], o2[8];
#pragma unroll
    for (int e = 0; e < 8; ++e) {
      float2 t0 = tb[2 * e], t1 = tb[2 * e + 1];
      o1[e] = pack2(x1[2 * e] * t0.x - x2[2 * e] * t0.y, x1[2 * e + 1] * t1.x - x2[2 * e + 1] * t1.y);
      o2[e] = pack2(x1[2 * e] * t0.y + x2[2 * e] * t0.x, x1[2 * e + 1] * t1.y + x2[2 * e + 1] * t1.x);
    }
    *(uint4*)q1 = make_uint4(o1[0], o1[1], o1[2], o1[3]);
    *(uint4*)(q1 + 8) = make_uint4(o1[4], o1[5], o1[6], o1[7]);
    *(uint4*)(q1 + 16) = make_uint4(o2[0], o2[1], o2[2], o2[3]);
    *(uint4*)(q1 + 24) = make_uint4(o2[4], o2[5], o2[6], o2[7]);
  }
}

DEVI void ph_ssd_scan(const Params& p, int blk, char* smem) {
  const int d = blk & 1, h = (blk >> 1) & 31, b = blk >> 6;
  const int g = h >> 3;
  const int tid = threadIdx.x, wid = __builtin_amdgcn_readfirstlane(tid >> 6), lane = tid & 63, fr = lane & 15, fq = lane >> 4;
  const int lt = wid & 3, ph = wid >> 2;
  const int spt = wid & 3, snt0 = (wid >> 2) * 4;
  u16* Cs = (u16*)smem;
  u16* Bs = Cs + 64 * 136;
  u16* BTs = Bs + 64 * 136;
  u16* XT0 = BTs + 128 * 72;
  u16* XT1 = XT0 + 64 * 72;
  u16* Hb = XT1 + 64 * 72;
  float* cumt = (float*)(Hb + 64 * 136);
  const u16* XBC = (const u16*)(p.ws + OFF_BIG + B1_XBC);
  const float* DT = (const float*)(p.ws + OFF_DT) + (size_t)d * T * 32;
  u16* Y = d == 0 ? (u16*)(p.ws + OFF_H) : (u16*)(p.ws + OFF_BIG + B1_YB);
  const float A = -expf(p.ssd_A_log[d * 32 + h]);
  for (int i = tid; i < 64 * 136; i += NTH) Hb[i] = 0;
  f32x4 hst[4];
#pragma unroll
  for (int i = 0; i < 4; ++i) hst[i] = (f32x4){0.f, 0.f, 0.f, 0.f};
  const int ss = tid >> 3, sg = tid & 7;
  uint4 rB0, rB1, rC0, rC1, rX;
  float rdt;
  auto load_raw = [&](int ch) {
    int row = b * LT + dirpos(d, ch * 64 + ss);
    const u16* base = XBC + (size_t)row * 3072;
    rB0 = *(const uint4*)(base + 2048 + g * 128 + sg * 16);
    rB1 = *(const uint4*)(base + 2048 + g * 128 + sg * 16 + 8);
    rC0 = *(const uint4*)(base + 2560 + g * 128 + sg * 16);
    rC1 = *(const uint4*)(base + 2560 + g * 128 + sg * 16 + 8);
    rX = *(const uint4*)(base + h * 64 + sg * 8);
    int rowl = b * LT + dirpos(d, ch * 64 + lane);
    rdt = DT[(size_t)rowl * 32 + h];
  };
  constexpr int NCH = LT / 64;
  load_raw(0);
  for (int ch = 0; ch < NCH; ++ch) {
    float cum = rdt * A;
#pragma unroll
    for (int off = 1; off < 64; off <<= 1) {
      float t = __shfl_up(cum, off);
      if (lane >= off) cum += t;
    }
    const float cum63 = __shfl(cum, 63);
    const float my_cum = __shfl(cum, ss), my_dt = __shfl(rdt, ss);
    __syncthreads();
    {
      *(uint4*)(Bs + ss * 136 + sg * 16) = rB0;
      *(uint4*)(Bs + ss * 136 + sg * 16 + 8) = rB1;
      *(uint4*)(Cs + ss * 136 + sg * 16) = rC0;
      *(uint4*)(Cs + ss * 136 + sg * 16 + 8) = rC1;
      unsigned wb[8] = {rB0.x, rB0.y, rB0.z, rB0.w, rB1.x, rB1.y, rB1.z, rB1.w};
#pragma unroll
      for (int e = 0; e < 8; ++e) {
        BTs[(sg * 16 + 2 * e) * 72 + ss] = (u16)(wb[e] & 0xFFFFu);
        BTs[(sg * 16 + 2 * e + 1) * 72 + ss] = (u16)(wb[e] >> 16);
      }
      unsigned wx[4] = {rX.x, rX.y, rX.z, rX.w};
      const float s0 = my_dt, s1 = my_dt * __expf(cum63 - my_cum);
#pragma unroll
      for (int e = 0; e < 4; ++e) {
        float x0 = __uint_as_float(wx[e] << 16), x1 = __uint_as_float(wx[e] & 0xFFFF0000u);
        XT0[(sg * 8 + 2 * e) * 72 + ss] = f2bf(x0 * s0);
        XT0[(sg * 8 + 2 * e + 1) * 72 + ss] = f2bf(x1 * s0);
        XT1[(sg * 8 + 2 * e) * 72 + ss] = f2bf(x0 * s1);
        XT1[(sg * 8 + 2 * e + 1) * 72 + ss] = f2bf(x1 * s1);
      }
      if (wid == 0) cumt[lane] = cum;
#pragma unroll
      for (int i = 0; i < 4; ++i)
#pragma unroll
        for (int j = 0; j < 4; ++j) Hb[(spt * 16 + fq * 4 + j) * 136 + (snt0 + i) * 16 + fr] = f2bf(hst[i][j]);
    }
    __syncthreads();
    load_raw(ch + 1 < NCH ? ch + 1 : ch);
    if (ch >= CL / 64) {
      bf16x8 cf[4];
#pragma unroll
      for (int kn = 0; kn < 4; ++kn) cf[kn] = *(const bf16x8*)(Cs + (lt * 16 + fr) * 136 + kn * 32 + fq * 8);
      const float cl = cumt[lt * 16 + fr];
      float pv[4][4];
#pragma unroll
      for (int st = 0; st < 4; ++st) {
        if (st <= lt) {
          f32x4 acc = (f32x4){0.f, 0.f, 0.f, 0.f};
#pragma unroll
          for (int kn = 0; kn < 4; ++kn) {
            bf16x8 a = *(const bf16x8*)(Bs + (st * 16 + fr) * 136 + kn * 32 + fq * 8);
            acc = __builtin_amdgcn_mfma_f32_16x16x32_bf16(a, cf[kn], acc, 0, 0, 0);
          }
          const float4 cs4 = *(const float4*)(cumt + st * 16 + fq * 4);
          const float csv[4] = {cs4.x, cs4.y, cs4.z, cs4.w};
#pragma unroll
          for (int j = 0; j < 4; ++j) {
            const int sidx = st * 16 + fq * 4 + j, lidx = lt * 16 + fr;
            float w = acc[j] * __expf(fminf(cl - csv[j], 0.f));
            pv[st][j] = (sidx <= lidx) ? w : 0.f;
          }
        } else {
#pragma unroll
          for (int j = 0; j < 4; ++j) pv[st][j] = 0.f;
        }
      }
      bf16x8 pb[2];
#pragma unroll
      for (int ks = 0; ks < 2; ++ks) {
        pb[ks] = mk_bf16x8(pack2(pv[ks * 2][0], pv[ks * 2][1]), pack2(pv[ks * 2][2], pv[ks * 2][3]),
                           pack2(pv[ks * 2 + 1][0], pv[ks * 2 + 1][1]), pack2(pv[ks * 2 + 1][2], pv[ks * 2 + 1][3]));
      }
      const float ecl = __expf(cl);
      const int orow = b * LT + dirpos(d, ch * 64 + lt * 16 + fr);
#pragma unroll
      for (int pi = 0; pi < 2; ++pi) {
        const int pt = ph * 2 + pi;
        f32x4 ya = (f32x4){0.f, 0.f, 0.f, 0.f};
#pragma unroll
        for (int kn = 0; kn < 4; ++kn) {
          bf16x8 a = *(const bf16x8*)(Hb + (pt * 16 + fr) * 136 + kn * 32 + fq * 8);
          ya = __builtin_amdgcn_mfma_f32_16x16x32_bf16(a, cf[kn], ya, 0, 0, 0);
        }
        ya *= ecl;
#pragma unroll
        for (int ks = 0; ks < 2; ++ks) {
          if (ks * 2 <= lt) {
            const u16* xp = XT0 + (pt * 16 + fr) * 72 + ks * 32 + fq * 4;
            uint2 lo = *(const uint2*)xp, hi = *(const uint2*)(xp + 16);
            ya = __builtin_amdgcn_mfma_f32_16x16x32_bf16(mk_bf16x8(lo.x, lo.y, hi.x, hi.y), pb[ks], ya, 0, 0, 0);
          }
        }
        *(uint2*)(Y + (size_t)orow * 2048 + h * 64 + pt * 16 + fq * 4) = make_uint2(pack2(ya[0], ya[1]), pack2(ya[2], ya[3]));
      }
    }
    {
      const float e63 = __expf(cum63);
      bf16x8 xa[2];
#pragma unroll
      for (int ks = 0; ks < 2; ++ks) xa[ks] = *(const bf16x8*)(XT1 + (spt * 16 + fr) * 72 + ks * 32 + fq * 8);
#pragma unroll
      for (int i = 0; i < 4; ++i) {
        f32x4 acc = hst[i] * e63;
#pragma unroll
        for (int ks = 0; ks < 2; ++ks) {
          bf16x8 bq = *(const bf16x8*)(BTs + ((snt0 + i) * 16 + fr) * 72 + ks * 32 + fq * 8);
          acc = __builtin_amdgcn_mfma_f32_16x16x32_bf16(xa[ks], bq, acc, 0, 0, 0);
        }
        hst[i] = acc;
      }
    }
  }
  __syncthreads();
}

DEVI void ph_attn(const Params& p, int first_blk, int nblk, char* smem) {
  const int tid = threadIdx.x, wid = tid >> 6, lane = tid & 63;
  const int fr = lane & 15, fq = lane >> 4;
  const int hr = wid & 3, qsub = wid >> 2;
  u16* Ks = (u16*)smem;
  u16* VTs = Ks + 64 * 72;
  const u16* P = (const u16*)(p.ws + OFF_BIG + B1_P);
  u16* CAT = (u16*)(p.ws + OFF_BIG + B1_CAT);
  for (int task = first_blk; task < NB * 4 * 64; task += nblk) {
    const int qt = task & 63, hkv = (task >> 6) & 3, b = task >> 8;
    const int hq = hkv * 4 + hr;
    const int q0 = qt * 64;
    const int qw0 = q0 + qsub * 32;
    bf16x8 qf[2][2];
#pragma unroll
    for (int nt = 0; nt < 2; ++nt) {
      const u16* qp = P + (size_t)(b * LT + CL + qw0 + nt * 16 + fr) * CD_INP + 5184 + hq * 64 + fq * 8;
#pragma unroll
      for (int ks = 0; ks < 2; ++ks) {
        uint4 v = *(const uint4*)(qp + ks * 32);
        unsigned w[4] = {v.x, v.y, v.z, v.w};
        unsigned o[4];
#pragma unroll
        for (int e = 0; e < 4; ++e)
          o[e] = pack2(__uint_as_float(w[e] << 16) * 0.125f, __uint_as_float(w[e] & 0xFFFF0000u) * 0.125f);
        qf[nt][ks] = mk_bf16x8(o[0], o[1], o[2], o[3]);
      }
    }
    f32x4 O[4][2];
#pragma unroll
    for (int dt = 0; dt < 4; ++dt)
#pragma unroll
      for (int nt = 0; nt < 2; ++nt) O[dt][nt] = (f32x4){0.f, 0.f, 0.f, 0.f};
    float mrun[2], lrun[2];
    const float sink = p.attn_sink[hq];
#pragma unroll
    for (int nt = 0; nt < 2; ++nt) { mrun[nt] = sink; lrun[nt] = fq == 0 ? 1.f : 0.f; }
    const int kb0 = max(0, q0 - 128), kb1 = min(SEQ, q0 + 64 + 128);
    const int nband = (kb1 - kb0) >> 6;
    for (int tile = 0; tile < 4 + nband; ++tile) {
      const bool isctx = tile < 4;
      const int kbase = isctx ? tile * 64 : kb0 + (tile - 4) * 64;
      const int krow0 = b * LT + (isctx ? kbase : CL + kbase);
      __syncthreads();
      {
        int key = tid >> 3, seg = tid & 7;
        uint4 kv = *(const uint4*)(P + (size_t)(krow0 + key) * CD_INP + 6208 + hkv * 64 + seg * 8);
        *(uint4*)(Ks + key * 72 + seg * 8) = kv;
        int key2 = tid & 63, seg2 = tid >> 6;
        uint4 vv = *(const uint4*)(P + (size_t)(krow0 + key2) * CD_INP + 6464 + hkv * 64 + seg2 * 8);
        unsigned w[4] = {vv.x, vv.y, vv.z, vv.w};
#pragma unroll
        for (int e = 0; e < 4; ++e) {
          VTs[(seg2 * 8 + 2 * e) * 72 + key2] = (u16)(w[e] & 0xFFFFu);
          VTs[(seg2 * 8 + 2 * e + 1) * 72 + key2] = (u16)(w[e] >> 16);
        }
      }
      __syncthreads();
      f32x4 ST[4][2];
#pragma unroll
      for (int mt = 0; mt < 4; ++mt) {
        bf16x8 a0 = *(const bf16x8*)(Ks + (mt * 16 + fr) * 72 + fq * 8);
        bf16x8 a1 = *(const bf16x8*)(Ks + (mt * 16 + fr) * 72 + 32 + fq * 8);
#pragma unroll
        for (int nt = 0; nt < 2; ++nt) {
          f32x4 z = (f32x4){0.f, 0.f, 0.f, 0.f};
          z = __builtin_amdgcn_mfma_f32_16x16x32_bf16(a0, qf[nt][0], z, 0, 0, 0);
          ST[mt][nt] = __builtin_amdgcn_mfma_f32_16x16x32_bf16(a1, qf[nt][1], z, 0, 0, 0);
        }
      }
      if (!isctx) {
#pragma unroll
        for (int mt = 0; mt < 4; ++mt)
#pragma unroll
          for (int nt = 0; nt < 2; ++nt)
#pragma unroll
            for (int j = 0; j < 4; ++j) {
              int dlt = (qw0 + nt * 16 + fr) - (kbase + mt * 16 + fq * 4 + j);
              if (dlt > 128 || dlt < -128) ST[mt][nt][j] = -INFINITY;
            }
      }
      bf16x8 pb[2][2];
#pragma unroll
      for (int nt = 0; nt < 2; ++nt) {
        float mx = -INFINITY;
#pragma unroll
        for (int mt = 0; mt < 4; ++mt)
#pragma unroll
          for (int j = 0; j < 4; ++j) mx = fmaxf(mx, ST[mt][nt][j]);
        mx = fmaxf(mx, __shfl_xor(mx, 16));
        mx = fmaxf(mx, __shfl_xor(mx, 32));
        float mn = fmaxf(mrun[nt], mx);
        float alpha = __expf(mrun[nt] - mn);
        mrun[nt] = mn;
        float ls = 0.f;
        float pv[4][4];
#pragma unroll
        for (int mt = 0; mt < 4; ++mt)
#pragma unroll
          for (int j = 0; j < 4; ++j) { pv[mt][j] = __expf(ST[mt][nt][j] - mn); ls += pv[mt][j]; }
        lrun[nt] = lrun[nt] * alpha + ls;
#pragma unroll
        for (int dt = 0; dt < 4; ++dt) O[dt][nt] *= alpha;
#pragma unroll
        for (int ks = 0; ks < 2; ++ks) {
          pb[nt][ks] = mk_bf16x8(pack2(pv[ks * 2][0], pv[ks * 2][1]), pack2(pv[ks * 2][2], pv[ks * 2][3]),
                                 pack2(pv[ks * 2 + 1][0], pv[ks * 2 + 1][1]), pack2(pv[ks * 2 + 1][2], pv[ks * 2 + 1][3]));
        }
      }
#pragma unroll
      for (int dt = 0; dt < 4; ++dt)
#pragma unroll
        for (int ks = 0; ks < 2; ++ks) {
          const u16* vp = VTs + (dt * 16 + fr) * 72 + ks * 32 + fq * 4;
          uint2 lo = *(const uint2*)vp, hi = *(const uint2*)(vp + 16);
          bf16x8 a = mk_bf16x8(lo.x, lo.y, hi.x, hi.y);
#pragma unroll
          for (int nt = 0; nt < 2; ++nt) O[dt][nt] = __builtin_amdgcn_mfma_f32_16x16x32_bf16(a, pb[nt][ks], O[dt][nt], 0, 0, 0);
        }
    }
#pragma unroll
    for (int nt = 0; nt < 2; ++nt) {
      float l = lrun[nt];
      l += __shfl_xor(l, 16);
      l += __shfl_xor(l, 32);
      float inv = 1.f / l;
      u16* op = CAT + (size_t)(b * LT + CL + qw0 + nt * 16 + fr) * 3072 + 2048 + hq * 64 + fq * 4;
#pragma unroll
      for (int dt = 0; dt < 4; ++dt)
        *(uint2*)(op + dt * 16) = make_uint2(cvt_pk_bf16(O[dt][nt][0] * inv, O[dt][nt][1] * inv), cvt_pk_bf16(O[dt][nt][2] * inv, O[dt][nt][3] * inv));
    }
  }
}

DEVI void ph_ssd_combine(const Params& p, int gw, int nw) {
  int lane = threadIdx.x & 63;
  const u16* P = (const u16*)(p.ws + OFF_BIG + B1_P);
  const u16* XBC = (const u16*)(p.ws + OFF_BIG + B1_XBC);
  const u16* YF = (const u16*)(p.ws + OFF_H);
  const u16* YB = (const u16*)(p.ws + OFF_BIG + B1_YB);
  u16* CAT = (u16*)(p.ws + OFF_BIG + B1_CAT);
  for (int it = gw; it < NB * SEQ * 4; it += nw) {
    int grp = it & 3, tok = it >> 2;
    int row = (tok / SEQ) * LT + CL + (tok % SEQ);
    int ch = grp * 512 + lane * 8;
    float dsk = p.ssd_D[ch >> 6];
    uint4 yf = *(const uint4*)(YF + (size_t)row * 2048 + ch), yb = *(const uint4*)(YB + (size_t)row * 2048 + ch);
    uint4 xv = *(const uint4*)(XBC + (size_t)row * 3072 + ch), zv = *(const uint4*)(P + (size_t)row * CD_INP + ch);
    unsigned a[4] = {yf.x, yf.y, yf.z, yf.w}, bq[4] = {yb.x, yb.y, yb.z, yb.w}, xq[4] = {xv.x, xv.y, xv.z, xv.w},
             zq[4] = {zv.x, zv.y, zv.z, zv.w};
    float y[8];
    float ss = 0.f;
#pragma unroll
    for (int i = 0; i < 4; ++i) {
#pragma unroll
      for (int e = 0; e < 2; ++e) {
        float f = e ? __uint_as_float(a[i] & 0xFFFF0000u) : __uint_as_float(a[i] << 16);
        float bb = e ? __uint_as_float(bq[i] & 0xFFFF0000u) : __uint_as_float(bq[i] << 16);
        float xx = e ? __uint_as_float(xq[i] & 0xFFFF0000u) : __uint_as_float(xq[i] << 16);
        float zz = e ? __uint_as_float(zq[i] & 0xFFFF0000u) : __uint_as_float(zq[i] << 16);
        float v = (f + bb + dsk * xx) * (zz * sigmoidf(zz));
        y[i * 2 + e] = v;
        ss += v * v;
      }
    }
    ss = wave_sum(ss);
    float sc = rsqrtf(ss * (1.f / 512.f) + 1e-6f);
    float4 g0 = *(const float4*)(p.ssd_norm_g + ch), g1 = *(const float4*)(p.ssd_norm_g + ch + 4);
    *(uint4*)(CAT + (size_t)row * 3072 + ch) =
        make_uint4(pack2(y[0] * sc * g0.x, y[1] * sc * g0.y), pack2(y[2] * sc * g0.z, y[3] * sc * g0.w),
                   pack2(y[4] * sc * g1.x, y[5] * sc * g1.y), pack2(y[6] * sc * g1.z, y[7] * sc * g1.w));
  }
}

DEVI void ph_final(const Params& p, int gw, int nw) {
  int lane = threadIdx.x & 63;
  for (int it = gw; it < NB * SEQ; it += nw) {
    float* row = p.out + (size_t)it * D;
    float4 v[8];
    float ss = 0.f;
#pragma unroll
    for (int i = 0; i < 8; ++i) {
      v[i] = *(const float4*)(row + (i * 64 + lane) * 4);
      ss += v[i].x * v[i].x + v[i].y * v[i].y + v[i].z * v[i].z + v[i].w * v[i].w;
    }
    ss = wave_sum(ss);
    float rs = rsqrtf(ss * (1.f / D) + 1e-6f);
#pragma unroll
    for (int i = 0; i < 8; ++i) {
      int c = (i * 64 + lane) * 4;
      float4 g = *(const float4*)(p.final_g + c);
      *(float4*)(row + c) = make_float4(v[i].x * rs * g.x, v[i].y * rs * g.y, v[i].z * rs * g.z, v[i].w * rs * g.w);
    }
  }
}

#include <vector>

#define XB_TMO      128
#define XB_XCNT(j)  (256  + 64 * (j))
#define XB_XSUB(j)  (1280 + 64 * (j))
#define XB_XGEN(j)  (2304 + 64 * (j))
#define XB_TOP      3328
#define XB_TOPGEN   3392
#define XCD_BAR_WORDS 3456
#define XB_SPIN_CAP (1u << 21)

__device__ __forceinline__ unsigned xb_ld(unsigned* p)              { return __hip_atomic_load(p, __ATOMIC_RELAXED, __HIP_MEMORY_SCOPE_AGENT); }
__device__ __forceinline__ unsigned xb_add(unsigned* p, unsigned v) { return __hip_atomic_fetch_add(p, v, __ATOMIC_RELAXED, __HIP_MEMORY_SCOPE_AGENT); }
__device__ __forceinline__ unsigned xb_xcc_id() { return (unsigned)__builtin_amdgcn_s_getreg((3 << 11) | 20) & 0xFu; }
#define XB_SPIN(cond, bar) do { unsigned _sp = 0; while (cond) { __builtin_amdgcn_s_sleep(1); \
    if ((++_sp & 255u) == 0u) { if (xb_ld(&(bar)[XB_TMO])) break; if (_sp > XB_SPIN_CAP) { atomicAdd(&(bar)[XB_TMO], 1u); break; } } } } while (0)

struct XcdBarrier {
    unsigned* bar; unsigned x;
    volatile LAS unsigned* st;
};

__device__ __forceinline__ XcdBarrier xcd_barrier_post(unsigned* bar, volatile LAS unsigned* st) {
    XcdBarrier b; b.bar = bar; b.x = xb_xcc_id(); b.st = st;
    if (threadIdx.x == 0) (void)xb_add(&bar[XB_XCNT(b.x)], 1u);
    return b;
}
__device__ __forceinline__ void xcd_barrier_complete(unsigned* bar, unsigned x, unsigned& nloc, unsigned& nx) {
    const unsigned G = gridDim.x * gridDim.y * gridDim.z;
    unsigned sum, cnt, mine, sp = 0u;
    for (;;) {
        sum = 0u; cnt = 0u; mine = 0u;
#pragma unroll
        for (unsigned j = 0; j < 16; ++j) { const unsigned c = xb_ld(&bar[XB_XCNT(j)]); sum += c; cnt += (c > 0u) ? 1u : 0u; mine = (j == x) ? c : mine; }
        if (sum == G) break;
        __builtin_amdgcn_s_sleep(1);
        if ((++sp & 255u) == 0u) { if (xb_ld(&bar[XB_TMO])) break; if (sp > XB_SPIN_CAP) { atomicAdd(&bar[XB_TMO], 1u); break; } }
    }
    nloc = mine > 0u ? mine : 1u; nx = cnt > 0u ? cnt : 1u;
}

__device__ __forceinline__ void xcd_barrier(const XcdBarrier& b) {
    asm volatile("s_waitcnt vmcnt(0)" ::: "memory");
    __syncthreads();
    if (threadIdx.x == 0) {
        unsigned* bar = b.bar;
        __builtin_amdgcn_s_waitcnt(0);
        unsigned nloc = b.st[0], nx = b.st[1];
        if (nloc == 0u) { xcd_barrier_complete(bar, b.x, nloc, nx); b.st[0] = nloc; b.st[1] = nx; }
        const unsigned old = xb_add(&bar[XB_XSUB(b.x)], 1u);
        const unsigned gen = old / nloc;
        if (old + 1u == (gen + 1u) * nloc) {
            __builtin_amdgcn_fence(__ATOMIC_RELEASE, "agent");
            asm volatile("s_waitcnt vmcnt(0)" ::: "memory");
            const unsigned og = xb_add(&bar[XB_TOP], 1u);
            const unsigned tg = og / nx;
            if (og + 1u == (tg + 1u) * nx) xb_add(&bar[XB_TOPGEN], 1u);
            else XB_SPIN(xb_ld(&bar[XB_TOPGEN]) == tg, bar);
            __builtin_amdgcn_fence(__ATOMIC_ACQUIRE, "agent");
            xb_add(&bar[XB_XGEN(b.x)], 1u);
            asm volatile("s_waitcnt vmcnt(0)" ::: "memory");
        } else {
            XB_SPIN(xb_ld(&bar[XB_XGEN(b.x)]) == gen, bar);
            __builtin_amdgcn_fence(__ATOMIC_ACQUIRE, "agent");
            asm volatile("s_waitcnt vmcnt(0)" ::: "memory");
        }
    }
    __syncthreads();
}


DEVI void sub_barrier(unsigned* ctr, unsigned nblocks) {
  asm volatile("s_waitcnt vmcnt(0)" ::: "memory");
  __syncthreads();
  if (threadIdx.x == 0) {
    __builtin_amdgcn_fence(__ATOMIC_RELEASE, "agent");
    asm volatile("s_waitcnt vmcnt(0)" ::: "memory");
    __hip_atomic_fetch_add(ctr, 1u, __ATOMIC_RELAXED, __HIP_MEMORY_SCOPE_AGENT);
    unsigned sp = 0;
    while (__hip_atomic_load(ctr, __ATOMIC_RELAXED, __HIP_MEMORY_SCOPE_AGENT) < nblocks) {
      __builtin_amdgcn_s_sleep(1);
      if (++sp > (1u << 24)) break;
    }
    __builtin_amdgcn_fence(__ATOMIC_ACQUIRE, "agent");
    asm volatile("s_waitcnt vmcnt(0)" ::: "memory");
  }
  __syncthreads();
}

#ifndef REPEAT_MASK
#define REPEAT_MASK 0
#endif
#ifndef PROBE_K
#define PROBE_K -1
#define PROBE_ID 0
#endif
constexpr int NPH = 21;
constexpr int SMEM_BYTES = STAGE_BYTES + 16;

template <class Epi>
DEVI void run_gemm(const Params& p, LAS unsigned char* lds, const u16* A, const u16* Bt, int K, int nN, int xonly, int bid, int nb,
                   const Epi& E) {
  Order S;
  S.init(xonly ? 64 : 68, nN, nb, bid, xonly);
  Gemm g{A, Bt, K};
  gemm_phase(lds, g, S, E);
}

DEVI void run_phase(const Params& p, int ph, int bid, int nb, char* smem, LAS unsigned char* lds) {
  char* ws = p.ws;
  u16* H = (u16*)(ws + OFF_H);
  const int gw = bid * NWV + (threadIdx.x >> 6), nw = nb * NWV;
#ifdef ONLY_PHASE
  ph = ONLY_PHASE;
#endif
  switch (ph) {
    case 0:
      ph_mod(p, bid, nb, smem);
      __syncthreads();
      ph_convert(p, 0, bid, nb, smem);
      break;
    case 1: ph_norm(p, 0, 0, true, false, bid, nb); break;
    case 2:
      run_gemm(p, lds, H, (const u16*)(ws + OFF_W16 + W0_IN), D, AB_INP / 256, 0, bid, nb,
               EpiBf16<0>{(u16*)(ws + OFF_BIG + B0_P), AB_INP, 0, 0});
      break;
    case 3:
      ph_lora_in(p, bid, nb);
      ph_s5_pass1(p, gw, nw, smem);
      break;
    case 4:
      run_gemm(p, lds, (const u16*)(ws + OFF_BIG + B0_LIN), (const u16*)(ws + OFF_W16 + W0_LORA), 512, 20, 0, bid, nb,
               EpiBf16<0>{(u16*)(ws + OFF_BIG + B0_WL), 1024, 1024, (size_t)T * 1024});
      ph_s5_prefix(p, nw - 1 - gw, nw);
      break;
    case 5:
      if (bid < 128) ph_rwkv_scan(p, bid, smem);
      else {
        ph_s5_pass2(p, (bid - 128) * NWV + (threadIdx.x >> 6), (nb - 128) * NWV, smem);
        sub_barrier((unsigned*)(ws + OFF_BAR), (unsigned)(nb - 128));
        run_gemm(p, lds, (const u16*)(ws + OFF_BIG + B0_YG), (const u16*)(ws + OFF_W16 + W0_GLU), 1024, 4, 0, bid - 128, nb - 128,
                 EpiGlu{(const u16*)(ws + OFF_BIG + B0_YG), H, p.s5_glu_b});
      }
      break;
    case 6:
      ph_rwkv_post(p, gw, nw);
      break;
    case 7:
      run_gemm(p, lds, H, (const u16*)(ws + OFF_W16 + W0_OUT), D, 8, 0, bid, nb, EpiResid{p, 0, 2, 1});
      break;
    case 8: ph_norm(p, 0, 1, false, false, bid, nb); break;
    case 9:
      run_gemm(p, lds, H, (const u16*)(ws + OFF_W16 + W_W1), D, 32, 0, bid, nb, EpiBf16<1>{(u16*)(ws + OFF_BIG), DFF, 0, 0});
      break;
    case 10:
      run_gemm(p, lds, (const u16*)(ws + OFF_BIG), (const u16*)(ws + OFF_W16 + W_W2), DFF, 8, 0, bid, nb, EpiResid{p, 0, 5, 0});
      break;
    case 11:
      ph_convert(p, 1, bid, nb, smem);
      ph_norm(p, 1, 0, false, false, bid, nb);
      break;
    case 12:
      run_gemm(p, lds, H, (const u16*)(ws + OFF_W16 + W1_IN), D, CD_INP / 256, 0, bid, nb,
               EpiBf16<0>{(u16*)(ws + OFF_BIG + B1_P), CD_INP, 0, 0});
      break;
    case 13: ph_cd_prep(p, bid, nb, smem); break;
    case 14:
      ph_ssd_scan(p, bid, smem);
      __syncthreads();
      ph_attn(p, bid, nb, smem);
      break;
    case 15: ph_ssd_combine(p, gw, nw); break;
    case 16:
      run_gemm(p, lds, (const u16*)(ws + OFF_BIG + B1_CAT), (const u16*)(ws + OFF_W16 + W1_OUT), 3072, 8, 1, bid, nb,
               EpiResid{p, 1, 2, 0});
      break;
    case 17: ph_norm(p, 1, 1, false, true, bid, nb); break;
    case 18:
      run_gemm(p, lds, H, (const u16*)(ws + OFF_W16 + W_W1), D, 32, 1, bid, nb, EpiBf16<1>{(u16*)(ws + OFF_BIG), DFF, 0, 0});
      break;
    case 19:
      run_gemm(p, lds, (const u16*)(ws + OFF_BIG), (const u16*)(ws + OFF_W16 + W_W2), DFF, 8, 1, bid, nb, EpiResid{p, 1, 5, 0});
      break;
    case 20: ph_final(p, gw, nw); break;
    case 105:
      if (bid >= 128) ph_s5_pass2(p, (bid - 128) * NWV + (threadIdx.x >> 6), (nb - 128) * NWV, smem);
      break;
    case 205:
      if (bid < 128) ph_rwkv_scan(p, bid, smem);
      break;
    case 114: ph_ssd_scan(p, bid, smem); break;
    case 214: ph_attn(p, bid, nb, smem); break;
    default: break;
  }
}

__global__ void __launch_bounds__(512, 2) fwd_megakernel(Params p) {
  extern __shared__ __attribute__((aligned(16))) unsigned char shm[];
  char* smem = (char*)shm;
  LAS unsigned char* lds = (LAS unsigned char*)shm;
  cg::grid_group grid = cg::this_grid();
  volatile LAS unsigned* bst = (volatile LAS unsigned*)(lds + STAGE_BYTES);
  if (threadIdx.x < 4) bst[threadIdx.x] = 0u;
  __syncthreads();
  const XcdBarrier xb = xcd_barrier_post((unsigned*)(p.ws + OFF_BAR), bst);
#define GSYNC(k) do { if ((k) == 0) grid.sync(); else xcd_barrier(xb); } while (0)
#define PHASE(k)                                                    \
  if (p.ph_lo <= (k) && (k) < p.ph_hi) {                            \
    run_phase(p, (k), blockIdx.x, gridDim.x, smem, lds);            \
    if ((REPEAT_MASK >> (k)) & 1) {                                 \
      GSYNC(k);                                                     \
      run_phase(p, (k), blockIdx.x, gridDim.x, smem, lds);          \
    }                                                               \
    if ((k) == PROBE_K) {                                           \
      GSYNC(k);                                                     \
      run_phase(p, PROBE_ID, blockIdx.x, gridDim.x, smem, lds);     \
    }                                                               \
    if ((k) + 1 < p.ph_hi) GSYNC(k);                                \
  }
  PHASE(0) PHASE(1) PHASE(2) PHASE(3) PHASE(4) PHASE(5) PHASE(6) PHASE(7) PHASE(8) PHASE(9) PHASE(10)
  PHASE(11) PHASE(12) PHASE(13) PHASE(14) PHASE(15) PHASE(16) PHASE(17) PHASE(18) PHASE(19) PHASE(20)
#undef PHASE
}

#ifndef SINGLE_LAUNCH
#define SINGLE_LAUNCH 1
#endif

extern "C" void kernel_launch(void* const* d_in, const int* in_sizes, int n_in, void* d_out, int out_size, void* d_ws,
                              size_t ws_size, hipStream_t stream) {
  if (ws_size < WS_NEEDED) {
    fprintf(stderr, "workspace too small: %zu < %zu\n", ws_size, (size_t)WS_NEEDED);
    return;
  }
  Params p{};
  const float** fp = (const float**)&p;
  for (int i = 0; i < 43; ++i) fp[i] = (const float*)d_in[i];
  p.out = (float*)d_out;
  p.ws = (char*)d_ws;
  static int grid_blocks = 0;
  if (!grid_blocks) {
    int dev = 0, cus = 0, per_cu = 0;
    hipGetDevice(&dev);
    hipDeviceGetAttribute(&cus, hipDeviceAttributeMultiprocessorCount, dev);
    hipFuncSetAttribute((const void*)fwd_megakernel, hipFuncAttributeMaxDynamicSharedMemorySize, SMEM_BYTES);
    hipOccupancyMaxActiveBlocksPerMultiprocessor(&per_cu, fwd_megakernel, NTH, SMEM_BYTES);
    if (per_cu > 1) per_cu = 1;
    grid_blocks = cus * per_cu;
  }
  hipMemsetAsync((char*)d_ws + OFF_BAR, 0, BAR_BYTES, stream);
#if SINGLE_LAUNCH
  p.ph_lo = 0;
  p.ph_hi = NPH;
  void* args[] = {&p};
  hipError_t e = hipLaunchCooperativeKernel((void*)fwd_megakernel, dim3(grid_blocks), dim3(NTH), args, SMEM_BYTES, stream);
  if (e != hipSuccess) fprintf(stderr, "cooperative launch failed: %s (grid %d)\n", hipGetErrorString(e), grid_blocks);
#else
  for (int ph = 0; ph < NPH; ++ph) {
    p.ph_lo = ph;
    p.ph_hi = ph + 1;
    fwd_megakernel<<<256, NTH, SMEM_BYTES, stream>>>(p);
  }
#endif
}
```

```cpp
#include <hip/hip_runtime.h>
#include <hip/hip_cooperative_groups.h>
#include <cstdio>
namespace cg = cooperative_groups;

typedef unsigned short u16;
using bf16x8 = __attribute__((ext_vector_type(8))) short;
using f32x4 = __attribute__((ext_vector_type(4))) float;
#define DEVI __device__ __forceinline__

constexpr int NB = 4, SEQ = 4096, CL = 256, LT = SEQ + CL, T = NB * LT, D = 2048, DFF = 8192;
constexpr int AB_IN = 4544, AB_INP = 4608, CD_IN = 6720, CD_INP = 6912;
constexpr int NTH = 512, NWV = 8;
constexpr int RCOLS = 3520;

constexpr size_t al256(size_t x) { return (x + 255) & ~(size_t)255; }
constexpr size_t OFF_MOD = 0;
constexpr size_t OFF_CX = al256(OFF_MOD + 2 * 5 * 12288 * 4);
constexpr size_t OFF_RK = al256(OFF_CX + (size_t)NB * CL * D * 4);
constexpr size_t OFF_DT = al256(OFF_RK + (size_t)2 * T * 16 * 4);
constexpr size_t OFF_S5E = al256(OFF_DT + (size_t)2 * T * 32 * 4);
constexpr size_t OFF_W16 = al256(OFF_S5E + (size_t)NB * 64 * 2 * 68 * 128 * 4);
constexpr size_t W_W1 = 0, W_W2 = 33554432, W_L = 67108864;
constexpr size_t W0_IN = W_L, W0_OUT = W0_IN + (size_t)AB_INP * D * 2, W0_LORA = W0_OUT + (size_t)D * D * 2,
                 W0_GLU = W0_LORA + (size_t)5120 * 512 * 2;
constexpr size_t W1_IN = W_L, W1_OUT = W1_IN + (size_t)CD_INP * D * 2;
constexpr size_t W16_SIZE = W1_OUT + (size_t)D * 3072 * 2;
constexpr size_t OFF_H = al256(OFF_W16 + W16_SIZE);
constexpr size_t OFF_BIG = al256(OFF_H + (size_t)T * D * 2);
constexpr size_t B0_P = 0, B0_LIN = B0_P + (size_t)T * AB_INP * 2, B0_WL = B0_LIN + (size_t)T * 512 * 2,
                 B0_AL = B0_WL + (size_t)2 * T * 1024 * 2, B0_G = B0_AL + (size_t)2 * T * 1024 * 2,
                 B0_YR = B0_G + (size_t)T * 1024 * 2, B0_YG = B0_YR + (size_t)2 * T * 1024 * 2,
                 B0_END = B0_YG + (size_t)T * 1024 * 2;
constexpr size_t B1_P = 0, B1_XBC = B1_P + (size_t)T * CD_INP * 2, B1_YB = B1_XBC + (size_t)T * 3072 * 2,
                 B1_CAT = B1_YB + (size_t)T * 2048 * 2, B1_END = B1_CAT + (size_t)T * 3072 * 2;
constexpr size_t BIG_SIZE = B1_END > B0_END ? B1_END : B0_END;
constexpr size_t OFF_BAR = al256(OFF_BIG + BIG_SIZE);
constexpr size_t BAR_BYTES = 16384;
constexpr size_t WS_NEEDED = OFF_BAR + BAR_BYTES;

struct Params {
  const float *x, *c, *ctx, *c_ctx, *ada_w, *ada_b, *norm1_g, *norm2_g, *mlp_w1, *mlp_w2, *final_g;
  const float *ab_w_in, *ab_w_out, *rwkv_mu, *rwkv_w0, *rwkv_w_up, *rwkv_a0, *rwkv_a_up, *rwkv_g_up;
  const float *rwkv_k_k, *rwkv_k_a, *rwkv_r_k, *rwkv_ln_g, *rwkv_ln_b;
  const float *s5_A_re, *s5_A_im, *s5_log_dt, *s5_B_re, *s5_B_im, *s5_C_re, *s5_C_im, *s5_D, *s5_glu_w, *s5_glu_b;
  const float *cd_w_in, *cd_w_out, *ssd_conv_w, *ssd_conv_b, *ssd_A_log, *ssd_dt_bias, *ssd_D, *ssd_norm_g, *attn_sink;
  float* out;
  char* ws;
  int ph_lo, ph_hi;
};

DEVI u16 f2bf(float f) {
  unsigned u = __float_as_uint(f);
  u += 0x7FFFu + ((u >> 16) & 1u);
  return (u16)(u >> 16);
}
DEVI float bf2f(u16 h) { return __uint_as_float(((unsigned)h) << 16); }
DEVI unsigned pack2(float a, float b) { return (unsigned)f2bf(a) | ((unsigned)f2bf(b) << 16); }
DEVI float sigmoidf(float x) { return 1.f / (1.f + __expf(-x)); }
DEVI float dpp_xor1(float v) {
  return __int_as_float(__builtin_amdgcn_update_dpp(0, __float_as_int(v), 0xB1, 0xF, 0xF, true));
}
DEVI float dpp_xor2(float v) {
  return __int_as_float(__builtin_amdgcn_update_dpp(0, __float_as_int(v), 0x4E, 0xF, 0xF, true));
}
DEVI float dpp_half_mirror(float v) {
  return __int_as_float(__builtin_amdgcn_update_dpp(0, __float_as_int(v), 0x141, 0xF, 0xF, true));
}
DEVI float dpp_ror4(float v) {
  return __int_as_float(__builtin_amdgcn_update_dpp(0, __float_as_int(v), 0x124, 0xF, 0xF, true));
}
DEVI float dpp_ror8(float v) {
  return __int_as_float(__builtin_amdgcn_update_dpp(0, __float_as_int(v), 0x128, 0xF, 0xF, true));
}
DEVI float sum16(float v) {
  v += dpp_xor1(v);
  v += dpp_xor2(v);
  v += dpp_ror4(v);
  v += dpp_ror8(v);
  return v;
}
DEVI float sum8(float v) {
  v += dpp_xor1(v);
  v += dpp_xor2(v);
  v += dpp_half_mirror(v);
  return v;
}
DEVI float wave_sum(float v) {
  v += dpp_xor1(v);
  v += dpp_xor2(v);
  v += __shfl_xor(v, 4);
  v += __shfl_xor(v, 8);
  v += __shfl_xor(v, 16);
  v += __shfl_xor(v, 32);
  return v;
}
DEVI void lds_barrier() { asm volatile("s_waitcnt lgkmcnt(0)\n\ts_barrier" ::: "memory"); }
DEVI void wave_lds_fence() { asm volatile("s_waitcnt lgkmcnt(0)" ::: "memory"); }

DEVI float* xrow_ptr(const Params& p, int row) {
  int b = row / LT, pos = row - b * LT;
  return pos < CL ? (float*)(p.ws + OFF_CX) + (size_t)(b * CL + pos) * D : p.out + (size_t)(b * SEQ + pos - CL) * D;
}
DEVI const float* inrow_ptr(const Params& p, int row) {
  int b = row / LT, pos = row - b * LT;
  return pos < CL ? p.ctx + (size_t)(b * CL + pos) * D : p.x + (size_t)(b * SEQ + pos - CL) * D;
}
DEVI int dirpos(int d, int j) { return d == 0 ? j : (j < CL ? CL - 1 - j : LT + CL - 1 - j); }
DEVI const float* mod_ptr(const Params& p, int layer, int row, int idx) {
  int b = row / LT, pos = row - b * LT;
  int r = pos < CL ? 4 : b;
  return (const float*)(p.ws + OFF_MOD) + (size_t)(layer * 5 + r) * 12288 + idx * 2048;
}

DEVI void tjob(const float* __restrict__ src, u16* __restrict__ dst, int K, int N, int Npad, int& t, int& off, int nb,
               char* smem) {
  float* sm = (float*)smem;
  int kt = (K + 63) / 64, nt = Npad / 256, ntiles = kt * nt;
  int tid = threadIdx.x;
  while (t < off + ntiles) {
    int lt = t - off;
    int tk = lt % kt, tn = lt / kt;
    int k0 = tk * 64, n0 = tn * 256;
    float4 v[8];
#pragma unroll
    for (int i = 0; i < 8; ++i) {
      int idx = i * 512 + tid;
      int kk = idx >> 6, c4 = idx & 63;
      v[i] = make_float4(0.f, 0.f, 0.f, 0.f);
      if (k0 + kk < K && n0 + c4 * 4 < N) v[i] = *(const float4*)(src + (size_t)(k0 + kk) * N + n0 + c4 * 4);
    }
    __syncthreads();
#pragma unroll
    for (int i = 0; i < 8; ++i) {
      int idx = i * 512 + tid;
      int kk = idx >> 6, c4 = idx & 63;
      float* d = sm + kk * 257 + c4 * 4;
      d[0] = v[i].x; d[1] = v[i].y; d[2] = v[i].z; d[3] = v[i].w;
    }
    __syncthreads();
#pragma unroll
    for (int i = 0; i < 4; ++i) {
      int gidx = i * 512 + tid;
      int nl = gidx >> 3, kg = gidx & 7;
      if (k0 + kg * 8 < K) {
        unsigned w[4];
#pragma unroll
        for (int j = 0; j < 4; ++j) w[j] = pack2(sm[(kg * 8 + 2 * j) * 257 + nl], sm[(kg * 8 + 2 * j + 1) * 257 + nl]);
        *(uint4*)(dst + (size_t)(n0 + nl) * K + k0 + kg * 8) = make_uint4(w[0], w[1], w[2], w[3]);
      }
    }
    t += nb;
  }
  off += ntiles;
}

DEVI void lora_w_job(const Params& p, u16* dst, int bid, int nb) {
  for (int it = bid * NTH + threadIdx.x; it < 5120 * 64; it += nb * NTH) {
    int n = it % 5120, kg = it / 5120;
    int blk = n >> 10, nn = n & 1023;
    unsigned w[4];
#pragma unroll
    for (int j = 0; j < 4; ++j) {
      float v[2];
#pragma unroll
      for (int e = 0; e < 2; ++e) {
        int k = kg * 8 + j * 2 + e;
        float x = 0.f;
        if (blk < 2) { if (k < 96) x = p.rwkv_w_up[((size_t)blk * 96 + k) * 1024 + nn]; }
        else if (blk < 4) { if (k >= 96 && k < 192) x = p.rwkv_a_up[((size_t)(blk - 2) * 96 + (k - 96)) * 1024 + nn]; }
        else { if (k >= 192 && k < 448) x = p.rwkv_g_up[(size_t)(k - 192) * 1024 + nn]; }
        v[e] = x;
      }
      w[j] = pack2(v[0], v[1]);
    }
    *(uint4*)(dst + (size_t)n * 512 + kg * 8) = make_uint4(w[0], w[1], w[2], w[3]);
  }
}

DEVI void ph_convert(const Params& p, int layer, int bid, int nb, char* smem) {
  char* w16 = p.ws + OFF_W16;
  int t = bid, off = 0;
  tjob(p.mlp_w1 + (size_t)layer * D * DFF, (u16*)(w16 + W_W1), D, DFF, DFF, t, off, nb, smem);
  tjob(p.mlp_w2 + (size_t)layer * D * DFF, (u16*)(w16 + W_W2), DFF, D, D, t, off, nb, smem);
  if (layer == 0) {
    tjob(p.ab_w_in, (u16*)(w16 + W0_IN), D, AB_IN, AB_INP, t, off, nb, smem);
    tjob(p.ab_w_out, (u16*)(w16 + W0_OUT), D, D, D, t, off, nb, smem);
    tjob(p.s5_glu_w, (u16*)(w16 + W0_GLU), 1024, 1024, 1024, t, off, nb, smem);
    lora_w_job(p, (u16*)(w16 + W0_LORA), bid, nb);
  } else {
    tjob(p.cd_w_in, (u16*)(w16 + W1_IN), D, CD_IN, CD_INP, t, off, nb, smem);
    tjob(p.cd_w_out, (u16*)(w16 + W1_OUT), 3072, D, D, t, off, nb, smem);
  }
  __syncthreads();
}

DEVI void ph_mod(const Params& p, int bid, int nb, char* smem) {
  if (bid >= 384) return;
  float* cond = (float*)smem;
  float* red = cond + 5 * 2048;
  int tid = threadIdx.x;
  for (int i = tid; i < 5 * 2048; i += NTH) {
    int r = i >> 11, k = i & 2047;
    float c = r < 4 ? p.c[r * 2048 + k] : p.c_ctx[k];
    cond[i] = c / (1.f + expf(-c));
  }
  __syncthreads();
  int cgp = tid & 15, ks = tid >> 4, lane = tid & 63, wid = tid >> 6;
  float* MOD = (float*)(p.ws + OFF_MOD);
  for (int item = bid; item < 384; item += nb) {
    int l = item / 192, n0 = (item % 192) * 64;
    const float* W = p.ada_w + (size_t)l * 2048 * 12288 + n0 + cgp * 4;
    float acc[5][4];
#pragma unroll
    for (int r = 0; r < 5; ++r)
#pragma unroll
      for (int j = 0; j < 4; ++j) acc[r][j] = 0.f;
#pragma unroll 8
    for (int i = 0; i < 64; ++i) {
      int k = ks + 32 * i;
      float4 w = *(const float4*)(W + (size_t)k * 12288);
#pragma unroll
      for (int r = 0; r < 5; ++r) {
        float c = cond[r * 2048 + k];
        acc[r][0] += c * w.x; acc[r][1] += c * w.y; acc[r][2] += c * w.z; acc[r][3] += c * w.w;
      }
    }
#pragma unroll
    for (int r = 0; r < 5; ++r)
#pragma unroll
      for (int j = 0; j < 4; ++j) {
        float v = acc[r][j];
        v += __shfl_xor(v, 16);
        v += __shfl_xor(v, 32);
        acc[r][j] = v;
      }
    if (lane < 16) {
#pragma unroll
      for (int r = 0; r < 5; ++r)
#pragma unroll
        for (int j = 0; j < 4; ++j) red[(wid * 16 + cgp) * 20 + r * 4 + j] = acc[r][j];
    }
    __syncthreads();
    for (int o = tid; o < 320; o += NTH) {
      int r = o >> 6, col = o & 63;
      int ci = col >> 2, j = col & 3;
      float sacc = 0.f;
#pragma unroll
      for (int w = 0; w < 8; ++w) sacc += red[(w * 16 + ci) * 20 + r * 4 + j];
      MOD[(size_t)(l * 5 + r) * 12288 + n0 + col] = sacc + p.ada_b[l * 12288 + n0 + col];
    }
    __syncthreads();
  }
}

DEVI void ph_norm(const Params& p, int layer, int which, bool src_in, bool xonly, int bid, int nb) {
  int wid = threadIdx.x >> 6, lane = threadIdx.x & 63;
  const float* gam = (which == 0 ? p.norm1_g : p.norm2_g) + layer * D;
  u16* H = (u16*)(p.ws + OFF_H);
  int nrows = xonly ? NB * SEQ : T;
  for (int it = bid * NWV + wid; it < nrows; it += nb * NWV) {
    int row = xonly ? (it / SEQ) * LT + CL + (it % SEQ) : it;
    const float* src = src_in ? inrow_ptr(p, row) : xrow_ptr(p, row);
    const float* sh = mod_ptr(p, layer, row, which * 3 + 0);
    const float* sc = mod_ptr(p, layer, row, which * 3 + 1);
    float4 v[8];
    float ss = 0.f;
#pragma unroll
    for (int i = 0; i < 8; ++i) {
      v[i] = *(const float4*)(src + (i * 64 + lane) * 4);
      ss += v[i].x * v[i].x + v[i].y * v[i].y + v[i].z * v[i].z + v[i].w * v[i].w;
    }
    ss = wave_sum(ss);
    float rs = rsqrtf(ss * (1.f / D) + 1e-6f);
#pragma unroll
    for (int i = 0; i < 8; ++i) {
      int c = (i * 64 + lane) * 4;
      float4 g = *(const float4*)(gam + c);
      float4 s1 = *(const float4*)(sc + c);
      float4 s0 = *(const float4*)(sh + c);
      float a0 = v[i].x * rs * g.x * (1.f + s1.x) + s0.x;
      float a1 = v[i].y * rs * g.y * (1.f + s1.y) + s0.y;
      float a2 = v[i].z * rs * g.z * (1.f + s1.z) + s0.z;
      float a3 = v[i].w * rs * g.w * (1.f + s1.w) + s0.w;
      *(uint2*)(H + (size_t)row * D + c) = make_uint2(pack2(a0, a1), pack2(a2, a3));
    }
  }
}

#define LAS __attribute__((address_space(3)))
typedef unsigned u32x4 __attribute__((ext_vector_type(4)));
constexpr int BM = 256, BK = 64, HALF = 128, HTB = HALF * BK * 2, STAGE_BYTES = 8 * HTB, NXCD = 8, WGM = 8;
DEVI int lds_byte(int r, int c) {
  const int st = (r >> 4) * 2 + (c >> 5), rr = r & 15, cc = c & 31, ob = rr * 64 + cc * 2;
  return st * 1024 + (ob ^ (((ob >> 9) & 1) << 5));
}
DEVI void stage_rc(int b, int& R, int& C) {
  const int st = b / 1024, sb = b % 1024, swz = sb ^ (((sb >> 9) & 1) << 5);
  R = (st >> 1) * 16 + swz / 64;
  C = (st & 1) * 32 + (swz % 64) / 2;
}
DEVI int perm32(int rho) { const int n = rho >> 4, i = rho & 15; return 8 * (i >> 2) + 4 * n + (i & 3); }
struct Unit { int pm, pn; };
struct Gemm { const u16* A; const u16* Bt; int K; };
struct Order {
  int nM, nN, nwg, G, c, xonly;
  DEVI void init(int nM_, int nN_, int G_, int c_, int xonly_) { nM = nM_; nN = nN_; nwg = nM * nN; G = G_; c = c_; xonly = xonly_; }
  DEVI bool next(int i, Unit& u) const {
    const long L = (long)i * G + c;
    if (L >= nwg) return false;
    int wgid = (int)L;
    { const int q = nwg / NXCD, r = nwg % NXCD, xcd = wgid % NXCD, off = wgid / NXCD; wgid = (xcd < r ? xcd * (q + 1) : r * (q + 1) + (xcd - r) * q) + off; }
    const int nig = WGM * nN, gid = wgid / nig, fm = gid * WGM, gsz = (nM - fm) < WGM ? (nM - fm) : WGM;
    int pm = fm + ((wgid % nig) % gsz);
    u.pn = (wgid % nig) / gsz;
    u.pm = xonly ? (pm >> 4) * 17 + 1 + (pm & 15) : pm;
    return true;
  }
};
DEVI bf16x8 mk_bf16x8(unsigned a, unsigned b, unsigned c, unsigned d) {
  u32x4 v = {a, b, c, d};
  return __builtin_bit_cast(bf16x8, v);
}
DEVI unsigned cvt_pk_bf16(float lo, float hi) { unsigned r; asm volatile("v_cvt_pk_bf16_f32 %0, %1, %2" : "=v"(r) : "v"(lo), "v"(hi)); return r; }

template <int ACT>
struct EpiBf16 {
  static constexpr bool PERM = true;
  u16* O; int ldc; int split_cols; size_t split_stride;
  DEVI void operator()(const f32x4 (&acc)[2][2][4][2], const Unit& u, int wr, int wc, int fr, int fq) const {
    const int row0 = u.pm * BM + wr * 64 + fr;
    int colt = u.pn * BM;
    u16* base = O;
    if (split_cols) { const int t = colt / split_cols; base += (size_t)t * split_stride; colt -= t * split_cols; }
    const int col0 = colt + wc * 32 + 8 * fq;
#pragma unroll
    for (int ai = 0; ai < 2; ++ai)
#pragma unroll
      for (int m = 0; m < 4; ++m) {
        u16* rowp = base + (size_t)(row0 + ai * HALF + m * 16) * ldc + col0;
#pragma unroll
        for (int bj = 0; bj < 2; ++bj) {
          f32x4 v0 = acc[ai][bj][m][0], v1 = acc[ai][bj][m][1];
          if (ACT == 1) {
#pragma unroll
            for (int j = 0; j < 4; ++j) { float a = fmaxf(v0[j], 0.f), b = fmaxf(v1[j], 0.f); v0[j] = a * a; v1[j] = b * b; }
          }
          u32x4 w;
          w.x = cvt_pk_bf16(v0[0], v0[1]); w.y = cvt_pk_bf16(v0[2], v0[3]); w.z = cvt_pk_bf16(v1[0], v1[1]); w.w = cvt_pk_bf16(v1[2], v1[3]);
          *(u32x4*)(rowp + bj * HALF) = w;
        }
      }
  }
};
struct EpiGlu {
  static constexpr bool PERM = true;
  const u16* YG; u16* CAT; const float* bias;
  DEVI void operator()(const f32x4 (&acc)[2][2][4][2], const Unit& u, int wr, int wc, int fr, int fq) const {
    const int row0 = u.pm * BM + wr * 64 + fr;
    const int col0 = u.pn * BM + wc * 32 + 8 * fq;
#pragma unroll
    for (int ai = 0; ai < 2; ++ai)
#pragma unroll
      for (int m = 0; m < 4; ++m) {
        const size_t row = (size_t)(row0 + ai * HALF + m * 16);
#pragma unroll
        for (int bj = 0; bj < 2; ++bj) {
          const int col = col0 + bj * HALF;
          u32x4 yv = *(const u32x4*)(YG + row * 1024 + col);
          f32x4 b0 = *(const f32x4*)(bias + col), b1 = *(const f32x4*)(bias + col + 4);
          f32x4 v0 = acc[ai][bj][m][0] + b0, v1 = acc[ai][bj][m][1] + b1;
          float y[8];
          unsigned yw[4] = {yv.x, yv.y, yv.z, yv.w};
#pragma unroll
          for (int j = 0; j < 4; ++j) { y[2 * j] = __uint_as_float(yw[j] << 16); y[2 * j + 1] = __uint_as_float(yw[j] & 0xFFFF0000u); }
          u32x4 w;
          w.x = cvt_pk_bf16(y[0] * sigmoidf(v0[0]), y[1] * sigmoidf(v0[1]));
          w.y = cvt_pk_bf16(y[2] * sigmoidf(v0[2]), y[3] * sigmoidf(v0[3]));
          w.z = cvt_pk_bf16(y[4] * sigmoidf(v1[0]), y[5] * sigmoidf(v1[1]));
          w.w = cvt_pk_bf16(y[6] * sigmoidf(v1[2]), y[7] * sigmoidf(v1[3]));
          *(u32x4*)(CAT + row * D + 1024 + col) = w;
        }
      }
  }
};
struct EpiResid {
  static constexpr bool PERM = false;
  Params p; int layer, gidx, from_in;
  DEVI void operator()(const f32x4 (&acc)[2][2][4][2], const Unit& u, int wr, int wc, int fr, int fq) const {
    const int row0 = u.pm * BM + wr * 64 + fr, col0 = u.pn * BM + wc * 32 + 4 * fq;
    const float* gate = mod_ptr(p, layer, row0, gidx);
    f32x4 gv[2][2];
#pragma unroll
    for (int bj = 0; bj < 2; ++bj)
#pragma unroll
      for (int n = 0; n < 2; ++n) gv[bj][n] = *(const f32x4*)(gate + col0 + bj * HALF + n * 16);
#pragma unroll
    for (int ai = 0; ai < 2; ++ai)
#pragma unroll
      for (int m = 0; m < 4; ++m) {
        const int row = row0 + ai * HALF + m * 16;
        float* dst = xrow_ptr(p, row) + col0;
        const float* src = from_in ? inrow_ptr(p, row) + col0 : dst;
#pragma unroll
        for (int bj = 0; bj < 2; ++bj)
#pragma unroll
          for (int n = 0; n < 2; ++n) {
            f32x4 sv = *(const f32x4*)(src + bj * HALF + n * 16);
            *(f32x4*)(dst + bj * HALF + n * 16) = sv + gv[bj][n] * acc[ai][bj][m][n];
          }
      }
  }
};

template <class Epi>
DEVI void gemm_phase(LAS unsigned char* lds, const Gemm g, const Order& S, const Epi& E) {
  const int tid = threadIdx.x, wid = __builtin_amdgcn_readfirstlane(tid >> 6), lane = tid & 63, wr = wid >> 2, wc = wid & 3, fr = lane & 15, fq = lane >> 4;
  const int K = g.K, nt = K / BK;
  unsigned voffA[2], voffB[2];
#pragma unroll
  for (int i = 0; i < 2; ++i) {
    int R, C;
    stage_rc(tid * 16 + i * 8192, R, C);
    const int Rb = Epi::PERM ? ((R & ~31) + perm32(R & 31)) : R;
    voffA[i] = (unsigned)(R * K + C) * 2u;
    voffB[i] = (unsigned)(Rb * K + C) * 2u;
  }
  const size_t kstep = (size_t)(BK * 2);
  const size_t hstep = (size_t)HALF * K * 2;
  const size_t tstep = 2 * hstep;
  const unsigned ldsw = (unsigned)wid * 1024u;
  const int aoff = lds_byte(wr * 64 + fr, fq * 8), boff = lds_byte(wc * 32 + fr, fq * 8);
#define PG8_SA(b, h) (((b) * 2 + (h)) * HTB)
#define PG8_SB(b, h) ((4 + (b) * 2 + (h)) * HTB)
#define PG8_STAGE(bufoff, gbase, voff) do { _Pragma("unroll") for (int _i = 0; _i < 2; ++_i) \
        __builtin_amdgcn_global_load_lds((const unsigned*)((const char*)(gbase) + (voff)[_i]), (LAS unsigned*)(lds + (bufoff) + ldsw + _i * 8192), 16, 0, 0); } while (0)
#define PG8_LDA(dst, b, h) do { _Pragma("unroll") for (int m = 0; m < 4; ++m) _Pragma("unroll") for (int k = 0; k < 2; ++k) dst[m][k] = *(const LAS bf16x8*)(lds + PG8_SA(b, h) + aoff + m * 2048 + k * 1024); } while (0)
#define PG8_LDB(dst, b, h) do { _Pragma("unroll") for (int n = 0; n < 2; ++n) _Pragma("unroll") for (int k = 0; k < 2; ++k) dst[n][k] = *(const LAS bf16x8*)(lds + PG8_SB(b, h) + boff + n * 2048 + k * 1024); } while (0)
#define PG8_MMA(ai, bj, At, Bt) do { __builtin_amdgcn_s_setprio(1); _Pragma("unroll") for (int m = 0; m < 4; ++m) _Pragma("unroll") for (int n = 0; n < 2; ++n) _Pragma("unroll") for (int k = 0; k < 2; ++k) \
        acc[ai][bj][m][n] = __builtin_amdgcn_mfma_f32_16x16x32_bf16(Bt[n][k], At[m][k], acc[ai][bj][m][n], 0, 0, 0); __builtin_amdgcn_s_setprio(0); } while (0)
#define PG8_WAIT_V(n) asm volatile("s_waitcnt vmcnt(" #n ")" ::: "memory")
#define PG8_WAIT_L(n) asm volatile("s_waitcnt lgkmcnt(" #n ")" ::: "memory")
#define PG8_BAR __builtin_amdgcn_s_barrier()
#define PG8_SCHED __builtin_amdgcn_sched_barrier(0)
  Unit cur, nxt;
  int ui = 0;
  if (!S.next(0, cur)) return;
  f32x4 acc[2][2][4][2];
#pragma unroll
  for (int a = 0; a < 2; ++a)
#pragma unroll
    for (int b = 0; b < 2; ++b)
#pragma unroll
      for (int m = 0; m < 4; ++m)
#pragma unroll
        for (int n = 0; n < 2; ++n) acc[a][b][m][n] = (f32x4){0.f, 0.f, 0.f, 0.f};
  bf16x8 At[4][2], B0[2][2], B1[2][2];
  const char* cA = (const char*)g.A + (size_t)cur.pm * tstep;
  const char* cB = (const char*)g.Bt + (size_t)cur.pn * tstep;
  PG8_STAGE(PG8_SB(0, 0), cB, voffB); PG8_STAGE(PG8_SA(0, 0), cA, voffA); PG8_STAGE(PG8_SB(0, 1), cB + hstep, voffB); PG8_STAGE(PG8_SA(0, 1), cA + hstep, voffA);
  if (wr == 1) PG8_BAR;
  PG8_WAIT_V(4); PG8_BAR;
  PG8_STAGE(PG8_SB(1, 0), cB + kstep, voffB); PG8_STAGE(PG8_SA(1, 0), cA + kstep, voffA); PG8_STAGE(PG8_SB(1, 1), cB + hstep + kstep, voffB);
  PG8_WAIT_V(6); PG8_BAR;
  for (;;) {
    const bool has_next = S.next(ui + 1, nxt);
    const char* nA = has_next ? (const char*)g.A + (size_t)nxt.pm * tstep : cA;
    const char* nB = has_next ? (const char*)g.Bt + (size_t)nxt.pn * tstep : cB;
    for (int t = 0; t < nt; t += 2) {
      const bool last = (t == nt - 2);
      const char* a1 = cA + (size_t)(t + 1) * kstep;
      const char* a2 = last ? nA : cA + (size_t)(t + 2) * kstep;
      const char* b2 = last ? nB : cB + (size_t)(t + 2) * kstep;
      const char* a3 = a2 + kstep;
      const char* b3 = b2 + kstep;
      PG8_LDB(B0, 0, 0); PG8_SCHED; PG8_LDA(At, 0, 0); PG8_STAGE(PG8_SA(1, 1), a1 + hstep, voffA);
      PG8_WAIT_L(8); PG8_BAR; PG8_WAIT_L(0); PG8_MMA(0, 0, At, B0); PG8_BAR; PG8_SCHED;
      PG8_LDB(B1, 0, 1); PG8_STAGE(PG8_SB(0, 0), b2, voffB);
      PG8_BAR; PG8_WAIT_L(0); PG8_MMA(0, 1, At, B1); PG8_BAR;
      PG8_LDA(At, 0, 1); PG8_STAGE(PG8_SA(0, 0), a2, voffA);
      PG8_BAR; PG8_WAIT_L(0); PG8_MMA(1, 0, At, B0); PG8_BAR; PG8_SCHED;
      PG8_STAGE(PG8_SB(0, 1), b2 + hstep, voffB);
      PG8_WAIT_V(6); PG8_BAR; PG8_MMA(1, 1, At, B1); PG8_BAR;
      PG8_LDB(B0, 1, 0); PG8_SCHED; PG8_LDA(At, 1, 0); PG8_STAGE(PG8_SA(0, 1), a2 + hstep, voffA);
      PG8_WAIT_L(8); PG8_BAR; PG8_WAIT_L(0); PG8_MMA(0, 0, At, B0); PG8_BAR; PG8_SCHED;
      PG8_LDB(B1, 1, 1); PG8_STAGE(PG8_SB(1, 0), b3, voffB);
      PG8_BAR; PG8_WAIT_L(0); PG8_MMA(0, 1, At, B1); PG8_BAR;
      PG8_LDA(At, 1, 1); PG8_STAGE(PG8_SA(1, 0), a3, voffA);
      PG8_BAR; PG8_WAIT_L(0); PG8_MMA(1, 0, At, B0); PG8_BAR; PG8_SCHED;
      PG8_STAGE(PG8_SB(1, 1), b3 + hstep, voffB);
      PG8_WAIT_V(6); PG8_BAR; PG8_MMA(1, 1, At, B1); PG8_BAR;
    }
    E(acc, cur, wr, wc, fr, fq);
    if (!has_next) break;
#pragma unroll
    for (int a = 0; a < 2; ++a)
#pragma unroll
      for (int b = 0; b < 2; ++b)
#pragma unroll
        for (int m = 0; m < 4; ++m)
#pragma unroll
          for (int n = 0; n < 2; ++n) acc[a][b][m][n] = (f32x4){0.f, 0.f, 0.f, 0.f};
    cur = nxt; cA = nA; cB = nB; ++ui;
  }
  PG8_WAIT_V(0);
  if (wr == 0) PG8_BAR;
  PG8_BAR;
#undef PG8_SA
#undef PG8_SB
#undef PG8_STAGE
#undef PG8_LDA
#undef PG8_LDB
#undef PG8_MMA
#undef PG8_WAIT_V
#undef PG8_WAIT_L
#undef PG8_BAR
#undef PG8_SCHED
}

struct S5C {
  float ab_re, ab_im;
  float bb_re[16], bb_im[16];
};
DEVI void s5_consts(const Params& p, int d, int g, int n, S5C& c) {
  int ix = (d * 64 + g) * 64 + n;
  float lam = fminf(p.s5_A_re[ix], -1e-4f), aim = p.s5_A_im[ix];
  float dt = expf(p.s5_log_dt[d * 64 + g]);
  float mag = expf(lam * dt), sn, cs;
  sincosf(aim * dt, &sn, &cs);
  c.ab_re = mag * cs;
  c.ab_im = mag * sn;
  float den = lam * lam + aim * aim;
  float f_re = ((c.ab_re - 1.f) * lam + c.ab_im * aim) / den;
  float f_im = (c.ab_im * lam - (c.ab_re - 1.f) * aim) / den;
  const float4* br = (const float4*)(p.s5_B_re + (size_t)ix * 16);
  const float4* bi = (const float4*)(p.s5_B_im + (size_t)ix * 16);
#pragma unroll
  for (int q = 0; q < 4; ++q) {
    float4 r = br[q], i = bi[q];
    c.bb_re[q * 4 + 0] = f_re * r.x - f_im * i.x; c.bb_im[q * 4 + 0] = f_re * i.x + f_im * r.x;
    c.bb_re[q * 4 + 1] = f_re * r.y - f_im * i.y; c.bb_im[q * 4 + 1] = f_re * i.y + f_im * r.y;
    c.bb_re[q * 4 + 2] = f_re * r.z - f_im * i.z; c.bb_im[q * 4 + 2] = f_re * i.z + f_im * r.z;
    c.bb_re[q * 4 + 3] = f_re * r.w - f_im * i.w; c.bb_im[q * 4 + 3] = f_re * i.w + f_im * r.w;
  }
}
DEVI void load_u16x16(const u16* ptr, float* u) {
  uint4 a = *(const uint4*)ptr, b = *(const uint4*)(ptr + 8);
  unsigned w[8] = {a.x, a.y, a.z, a.w, b.x, b.y, b.z, b.w};
#pragma unroll
  for (int i = 0; i < 8; ++i) {
    u[2 * i] = __uint_as_float(w[i] << 16);
    u[2 * i + 1] = __uint_as_float(w[i] & 0xFFFF0000u);
  }
}
DEVI int s5_cu(int d, int q) { return d == 0 ? q : (q < 4 ? 3 - q : 71 - q); }
DEVI int s5_q(int d, int cu) { return d == 0 ? cu : (cu < 4 ? 3 - cu : 71 - cu); }

DEVI void ph_s5_pass1(const Params& p, int gw, int nw, char* smem) {
  int lane = threadIdx.x & 63;
  u16* Us = (u16*)smem + (threadIdx.x >> 6) * 1024;
  const u16* P = (const u16*)(p.ws + OFF_BIG + B0_P);
  float* E = (float*)(p.ws + OFF_S5E);
  for (int task = gw; task < NB * 64 * 2 * 68; task += nw) {
    int q = task % 68, d = (task / 68) & 1, g = (task / 136) & 63, b = task / (136 * 64);
    S5C c;
    s5_consts(p, d, g, lane, c);
    int cu = s5_cu(d, q);
    {
      const u16* up = P + (size_t)(b * LT + cu * 64 + lane) * AB_INP + RCOLS + g * 16;
      uint4 u0 = *(const uint4*)up, u1 = *(const uint4*)(up + 8);
      wave_lds_fence();
      *(uint4*)(Us + lane * 16) = u0;
      *(uint4*)(Us + lane * 16 + 8) = u1;
      wave_lds_fence();
    }
    float hr = 0.f, hi = 0.f;
    for (int i = 0; i < 64; ++i) {
      int tl = d == 0 ? i : 63 - i;
      float u[16];
      load_u16x16(Us + tl * 16, u);
      float br = 0.f, bi = 0.f;
#pragma unroll
      for (int k = 0; k < 16; ++k) { br += c.bb_re[k] * u[k]; bi += c.bb_im[k] * u[k]; }
      float nr = c.ab_re * hr - c.ab_im * hi + br;
      float ni = c.ab_re * hi + c.ab_im * hr + bi;
      hr = nr; hi = ni;
    }
    size_t ei = ((((size_t)(b * 64 + g) * 2 + d) * 68 + q) * 64 + lane) * 2;
    *(float2*)(E + ei) = make_float2(hr, hi);
  }
}

DEVI void ph_s5_prefix(const Params& p, int gw, int nw) {
  const int lane = threadIdx.x & 63;
  float* E = (float*)(p.ws + OFF_S5E);
  for (int task = gw; task < NB * 64 * 2; task += nw) {
    const int d = task & 1, g = (task >> 1) & 63, b = task >> 7;
    const int ix = (d * 64 + g) * 64 + lane;
    const float lam = fminf(p.s5_A_re[ix], -1e-4f), aim = p.s5_A_im[ix];
    const float dt = expf(p.s5_log_dt[d * 64 + g]);
    const float mag = expf(lam * dt);
    float sn, cs;
    sincosf(aim * dt, &sn, &cs);
    float qr = mag * cs, qi = mag * sn;
#pragma unroll
    for (int sq = 0; sq < 6; ++sq) { float t0 = qr * qr - qi * qi, t1 = 2.f * qr * qi; qr = t0; qi = t1; }
    float* Eb = E + (((size_t)(b * 64 + g) * 2 + d) * 68) * 128 + lane * 2;
    float sr = 0.f, si = 0.f;
#pragma unroll 4
    for (int q = 0; q < 68; ++q) {
      float2 e = *(const float2*)(Eb + (size_t)q * 128);
      *(float2*)(Eb + (size_t)q * 128) = make_float2(sr, si);
      float nr = qr * sr - qi * si + e.x, ni = qr * si + qi * sr + e.y;
      sr = nr; si = ni;
    }
  }
}

DEVI void ph_s5_pass2(const Params& p, int gw, int nw, char* smem) {
  typedef float f32x2 __attribute__((ext_vector_type(2)));
  const int lane = threadIdx.x & 63, wid = threadIdx.x >> 6;
  constexpr int HP = 130;
  float* Hs = (float*)smem + wid * (16 * HP + 512);
  u16* Us = (u16*)(Hs + 16 * HP);
  const u16* P = (const u16*)(p.ws + OFF_BIG + B0_P);
  const float* E = (const float*)(p.ws + OFF_S5E);
  u16* YG = (u16*)(p.ws + OFF_BIG + B0_YG);
  const int mi = lane & 15, mk = lane >> 4;
  for (int task = gw; task < NB * 64 * 68; task += nw) {
    const int cu = task % 68, g = (task / 68) & 63, b = task / (68 * 64);
    f32x4 Y[4];
#pragma unroll
    for (int q = 0; q < 4; ++q) Y[q] = (f32x4){0.f, 0.f, 0.f, 0.f};
    {
      const u16* up = P + (size_t)(b * LT + cu * 64 + lane) * AB_INP + RCOLS + g * 16;
      uint4 u0 = *(const uint4*)up, u1 = *(const uint4*)(up + 8);
      wave_lds_fence();
      *(uint4*)(Us + lane * 16) = u0;
      *(uint4*)(Us + lane * 16 + 8) = u1;
      wave_lds_fence();
    }
    for (int d = 0; d < 2; ++d) {
      S5C c;
      s5_consts(p, d, g, lane, c);
      float cm[32];
#pragma unroll
      for (int kk = 0; kk < 32; ++kk) {
        int k = 4 * kk + mk, n = k >> 1;
        size_t ci = ((size_t)(d * 64 + g) * 16 + mi) * 64 + n;
        cm[kk] = (k & 1) ? -p.s5_C_im[ci] : p.s5_C_re[ci];
      }
      const int q = s5_q(d, cu);
      const float2 e0 = *(const float2*)(E + ((((size_t)(b * 64 + g) * 2 + d) * 68 + q) * 64 + lane) * 2);
      float hr = e0.x, hi = e0.y;
      for (int sb = 0; sb < 4; ++sb) {
        const int blk = d == 0 ? sb : 3 - sb;
        for (int i = 0; i < 16; ++i) {
          const int tl = d == 0 ? i : 15 - i;
          float u[16];
          load_u16x16(Us + (blk * 16 + tl) * 16, u);
          f32x2 bu = (f32x2){0.f, 0.f};
#pragma unroll
          for (int k = 0; k < 16; ++k) bu += (f32x2){c.bb_re[k], c.bb_im[k]} * u[k];
          float nr = c.ab_re * hr - c.ab_im * hi + bu.x;
          float ni = c.ab_re * hi + c.ab_im * hr + bu.y;
          hr = nr; hi = ni;
          *(float2*)(Hs + tl * HP + 2 * lane) = make_float2(hr, hi);
        }
        wave_lds_fence();
        f32x4 acc = Y[blk];
#pragma unroll
        for (int kk = 0; kk < 32; ++kk) {
          float a = Hs[mi * HP + 4 * kk + mk];
          acc = __builtin_amdgcn_mfma_f32_16x16x4f32(a, cm[kk], acc, 0, 0, 0);
        }
        Y[blk] = acc;
        wave_lds_fence();
      }
    }
    const float dsk = p.s5_D[g * 16 + mi];
#pragma unroll
    for (int blk = 0; blk < 4; ++blk)
#pragma unroll
      for (int r = 0; r < 4; ++r) {
        const int row = b * LT + cu * 64 + blk * 16 + 4 * mk + r;
        float uu = bf2f(Us[(blk * 16 + 4 * mk + r) * 16 + mi]);
        float y0 = Y[blk][r] + dsk * uu;
        y0 = 0.5f * y0 * (1.f + tanhf(0.7978845608f * (y0 + 0.044715f * y0 * y0 * y0)));
        YG[(size_t)row * 1024 + g * 16 + mi] = f2bf(y0);
      }
  }
}

DEVI void ph_lora_in(const Params& p, int bid, int nb) {
  const u16* P = (const u16*)(p.ws + OFF_BIG + B0_P);
  u16* LIN = (u16*)(p.ws + OFF_BIG + B0_LIN);
  const size_t total = (size_t)T * 256;
  for (size_t it = (size_t)bid * NTH + threadIdx.x; it < total; it += (size_t)nb * NTH) {
    int row = (int)(it >> 8), jp = (int)(it & 255);
    if (jp >= 224) { *(unsigned*)(LIN + (size_t)row * 512 + jp * 2) = 0u; continue; }
    int pos = row % LT;
    bool first = (pos == 0 || pos == CL), last = (pos == CL - 1 || pos == LT - 1);
    int col = 3072 + jp * 2;
    unsigned cu = *(const unsigned*)(P + (size_t)row * AB_INP + col);
    unsigned pv = first ? 0u : *(const unsigned*)(P + (size_t)(row - 1) * AB_INP + col);
    unsigned nx = last ? 0u : *(const unsigned*)(P + (size_t)(row + 1) * AB_INP + col);
    float o[2];
#pragma unroll
    for (int e = 0; e < 2; ++e) {
      float c = e ? __uint_as_float(cu & 0xFFFF0000u) : __uint_as_float(cu << 16);
      float pr = e ? __uint_as_float(pv & 0xFFFF0000u) : __uint_as_float(pv << 16);
      float nn = e ? __uint_as_float(nx & 0xFFFF0000u) : __uint_as_float(nx << 16);
      float m0 = p.rwkv_mu[col + e], m1 = p.rwkv_mu[RCOLS + col + e];
      float s = c + m0 * (pr - c) + m1 * (nn - c);
      int j = jp * 2 + e;
      o[e] = j < 96 ? tanhf(s) : (j < 192 ? s : sigmoidf(s));
    }
    *(unsigned*)(LIN + (size_t)row * 512 + jp * 2) = pack2(o[0], o[1]);
  }
}

DEVI void ph_rwkv_scan(const Params& p, int blk, char* smem) {
  const int d = blk & 1, h = (blk >> 1) & 15, b = blk >> 5;
  const int tid = threadIdx.x, wid = __builtin_amdgcn_readfirstlane(tid >> 6), lane = tid & 63;
  constexpr int NCH = LT / 8;
  constexpr int BW = 6 * 8 * 64;
  float* bufs = (float*)smem;
  float* ybuf = bufs + 2 * BW;
  const u16* P = (const u16*)(p.ws + OFF_BIG + B0_P);
  const u16* WL = (const u16*)(p.ws + OFF_BIG + B0_WL) + (size_t)d * T * 1024;
  const u16* AL = (const u16*)(p.ws + OFF_BIG + B0_AL) + (size_t)d * T * 1024;
  u16* YR = (u16*)(p.ws + OFF_BIG + B0_YR) + (size_t)d * T * 1024;
  float* RK = (float*)(p.ws + OFF_RK) + (size_t)d * T * 16;
  if (wid >= 4) {
    const int sw = wid - 4;
    const int c = h * 64 + lane;
    const float mr0 = p.rwkv_mu[c], mr1 = p.rwkv_mu[RCOLS + c];
    const float mk0 = p.rwkv_mu[1024 + c], mk1 = p.rwkv_mu[RCOLS + 1024 + c];
    const float mv0 = p.rwkv_mu[2048 + c], mv1 = p.rwkv_mu[RCOLS + 2048 + c];
    const float w0 = p.rwkv_w0[d * 1024 + c], a0 = p.rwkv_a0[d * 1024 + c];
    const float kkc = p.rwkv_k_k[c], kac = p.rwkv_k_a[c], rkc = p.rwkv_r_k[c];
    u16 R0[2][11], R1[2][11], R2[2][11], R3[2][11];
    auto load_raw = [&](int ch, u16 (&raw)[2][11]) {
      ch = ch < NCH ? ch : NCH - 1;
#pragma unroll
      for (int i = 0; i < 2; ++i) {
        int pos = dirpos(d, ch * 8 + sw * 2 + i);
        int row = b * LT + pos;
        bool first = (pos == 0 || pos == CL), last = (pos == CL - 1 || pos == LT - 1);
        const u16* pr = P + (size_t)row * AB_INP + c;
        const u16* pp = first ? pr : pr - AB_INP;
        const u16* pn = last ? pr : pr + AB_INP;
#pragma unroll
        for (int s3 = 0; s3 < 3; ++s3) {
          raw[i][s3 * 3 + 0] = pr[s3 * 1024];
          raw[i][s3 * 3 + 1] = pp[s3 * 1024];
          raw[i][s3 * 3 + 2] = pn[s3 * 1024];
        }
        raw[i][9] = WL[(size_t)row * 1024 + c];
        raw[i][10] = AL[(size_t)row * 1024 + c];
      }
    };
    auto process = [&](int ch, const u16 (&raw)[2][11], float* buf) {
      ch = ch < NCH ? ch : NCH - 1;
#pragma unroll
      for (int i = 0; i < 2; ++i) {
        int tt = sw * 2 + i;
        int pos = dirpos(d, ch * 8 + tt);
        int row = b * LT + pos;
        float fm = (pos == 0 || pos == CL) ? 0.f : 1.f, lm = (pos == CL - 1 || pos == LT - 1) ? 0.f : 1.f;
        float rc = bf2f(raw[i][0]), rp = bf2f(raw[i][1]) * fm, rn = bf2f(raw[i][2]) * lm;
        float kc = bf2f(raw[i][3]), kp = bf2f(raw[i][4]) * fm, kn = bf2f(raw[i][5]) * lm;
        float vc = bf2f(raw[i][6]), vp = bf2f(raw[i][7]) * fm, vn = bf2f(raw[i][8]) * lm;
        float r = rc + mr0 * (rp - rc) + mr1 * (rn - rc);
        float k = kc + mk0 * (kp - kc) + mk1 * (kn - kc);
        float v = vc + mv0 * (vp - vc) + mv1 * (vn - vc);
        float kkraw = k * kkc;
        float nrm = sqrtf(wave_sum(kkraw * kkraw));
        float kk = kkraw / fmaxf(nrm, 1e-12f);
        float z = w0 + bf2f(raw[i][9]);
        float sg = 1.f / (1.f + expf(-z));
        float decay = expf(-0.60653065971f * sg);
        float a = 1.f / (1.f + expf(-(a0 + bf2f(raw[i][10]))));
        float kd = k * (1.f + (a - 1.f) * kac);
        float rk = wave_sum(r * kd * rkc);
        if (lane == 0) RK[(size_t)row * 16 + h] = rk;
        buf[(0 * 8 + tt) * 64 + lane] = r;
        buf[(1 * 8 + tt) * 64 + lane] = decay;
        buf[(2 * 8 + tt) * 64 + lane] = kd;
        buf[(3 * 8 + tt) * 64 + lane] = kk;
        buf[(4 * 8 + tt) * 64 + lane] = kk * a;
        buf[(5 * 8 + tt) * 64 + lane] = v;
      }
    };
    auto bulk = [&](int ch) {
#pragma unroll
      for (int i = 0; i < 2; ++i) {
        const int tt = sw * 2 + i;
        const float4* yp = (const float4*)(ybuf + ((((ch & 1) * 8 + tt) * 32 + (lane >> 1)) * 8) * 2);
        float4 q0 = yp[0], q1 = yp[1], q2 = yp[2], q3 = yp[3];
        float ya = (q0.x + q0.z) + (q1.x + q1.z) + (q2.x + q2.z) + (q3.x + q3.z);
        float yb = (q0.y + q0.w) + (q1.y + q1.w) + (q2.y + q2.w) + (q3.y + q3.w);
        int row = b * LT + dirpos(d, ch * 8 + tt);
        YR[(size_t)row * 1024 + h * 64 + lane] = f2bf((lane & 1) ? yb : ya);
      }
    };
    load_raw(0, R0);
    process(0, R0, bufs);
    load_raw(1, R1);
    load_raw(2, R2);
    load_raw(3, R3);
    load_raw(4, R0);
    lds_barrier();
    for (int ch = 0; ch < NCH; ch += 4) {
      if (ch > 0) bulk(ch - 1);
      process(ch + 1, R1, bufs + BW);
      load_raw(ch + 5, R1);
      lds_barrier();
      bulk(ch);
      process(ch + 2, R2, bufs);
      load_raw(ch + 6, R2);
      lds_barrier();
      bulk(ch + 1);
      process(ch + 3, R3, bufs + BW);
      load_raw(ch + 7, R3);
      lds_barrier();
      bulk(ch + 2);
      process(ch + 4, R0, bufs);
      load_raw(ch + 8, R0);
      lds_barrier();
    }
    lds_barrier();
    bulk(NCH - 1);
  } else {
    const int rp = tid >> 3, ks = tid & 7;
    float S[16];
#pragma unroll
    for (int i = 0; i < 16; ++i) S[i] = 0.f;
    lds_barrier();
    for (int ch = 0; ch < NCH; ++ch) {
      const float* buf = bufs + (ch & 1) * BW;
      struct Ops { float4 r4[2], w4[2], kd4[2], kk4[2], bb4[2]; float2 vv; };
      auto fetch = [&](Ops& o, int tt) {
        const float* bs = buf + tt * 64 + ks * 8;
#pragma unroll
        for (int i = 0; i < 2; ++i) {
          o.r4[i] = *(const float4*)(bs + 0 * 512 + i * 4);
          o.w4[i] = *(const float4*)(bs + 1 * 512 + i * 4);
          o.kd4[i] = *(const float4*)(bs + 2 * 512 + i * 4);
          o.kk4[i] = *(const float4*)(bs + 3 * 512 + i * 4);
          o.bb4[i] = *(const float4*)(bs + 4 * 512 + i * 4);
        }
        o.vv = *(const float2*)(buf + 5 * 512 + tt * 64 + rp * 2);
      };
      auto compute = [&](const Ops& o, int tt) {
        float dotA = 0.f, dotB = 0.f;
#pragma unroll
        for (int i = 0; i < 2; ++i) {
          dotA = fmaf(S[i * 4 + 0], o.kk4[i].x, dotA); dotA = fmaf(S[i * 4 + 1], o.kk4[i].y, dotA);
          dotA = fmaf(S[i * 4 + 2], o.kk4[i].z, dotA); dotA = fmaf(S[i * 4 + 3], o.kk4[i].w, dotA);
          dotB = fmaf(S[8 + i * 4 + 0], o.kk4[i].x, dotB); dotB = fmaf(S[8 + i * 4 + 1], o.kk4[i].y, dotB);
          dotB = fmaf(S[8 + i * 4 + 2], o.kk4[i].z, dotB); dotB = fmaf(S[8 + i * 4 + 3], o.kk4[i].w, dotB);
        }
        dotA = sum8(dotA);
        dotB = sum8(dotB);
        float yA = 0.f, yB = 0.f;
#pragma unroll
        for (int i = 0; i < 2; ++i) {
          S[i * 4 + 0] = S[i * 4 + 0] * o.w4[i].x + (o.vv.x * o.kd4[i].x - dotA * o.bb4[i].x);
          S[i * 4 + 1] = S[i * 4 + 1] * o.w4[i].y + (o.vv.x * o.kd4[i].y - dotA * o.bb4[i].y);
          S[i * 4 + 2] = S[i * 4 + 2] * o.w4[i].z + (o.vv.x * o.kd4[i].z - dotA * o.bb4[i].z);
          S[i * 4 + 3] = S[i * 4 + 3] * o.w4[i].w + (o.vv.x * o.kd4[i].w - dotA * o.bb4[i].w);
          S[8 + i * 4 + 0] = S[8 + i * 4 + 0] * o.w4[i].x + (o.vv.y * o.kd4[i].x - dotB * o.bb4[i].x);
          S[8 + i * 4 + 1] = S[8 + i * 4 + 1] * o.w4[i].y + (o.vv.y * o.kd4[i].y - dotB * o.bb4[i].y);
          S[8 + i * 4 + 2] = S[8 + i * 4 + 2] * o.w4[i].z + (o.vv.y * o.kd4[i].z - dotB * o.bb4[i].z);
          S[8 + i * 4 + 3] = S[8 + i * 4 + 3] * o.w4[i].w + (o.vv.y * o.kd4[i].w - dotB * o.bb4[i].w);
          yA = fmaf(S[i * 4 + 0], o.r4[i].x, yA); yA = fmaf(S[i * 4 + 1], o.r4[i].y, yA);
          yA = fmaf(S[i * 4 + 2], o.r4[i].z, yA); yA = fmaf(S[i * 4 + 3], o.r4[i].w, yA);
          yB = fmaf(S[8 + i * 4 + 0], o.r4[i].x, yB); yB = fmaf(S[8 + i * 4 + 1], o.r4[i].y, yB);
          yB = fmaf(S[8 + i * 4 + 2], o.r4[i].z, yB); yB = fmaf(S[8 + i * 4 + 3], o.r4[i].w, yB);
        }
        *(float2*)(ybuf + ((((ch & 1) * 8 + tt) * 32 + rp) * 8 + ks) * 2) = make_float2(yA, yB);
      };
      Ops o0, o1;
      fetch(o0, 0);
#pragma unroll 2
      for (int tt = 0; tt < 8; tt += 2) {
        fetch(o1, tt + 1);
        compute(o0, tt);
        fetch(o0, tt + 2 < 8 ? tt + 2 : 7);
        compute(o1, tt + 1);
      }
      lds_barrier();
    }
    lds_barrier();
  }
  lds_barrier();
}

DEVI void unpack8(uint4 v, float* f) {
  unsigned w[4] = {v.x, v.y, v.z, v.w};
#pragma unroll
  for (int i = 0; i < 4; ++i) { f[2 * i] = __uint_as_float(w[i] << 16); f[2 * i + 1] = __uint_as_float(w[i] & 0xFFFF0000u); }
}
DEVI void ph_rwkv_post(const Params& p, int gw, int nw) {
  const int lane = threadIdx.x & 63;
  const u16* P = (const u16*)(p.ws + OFF_BIG + B0_P);
  const u16* YR = (const u16*)(p.ws + OFF_BIG + B0_YR);
  const u16* G = (const u16*)(p.ws + OFF_BIG + B0_G);
  const float* RK = (const float*)(p.ws + OFF_RK);
  u16* CAT = (u16*)(p.ws + OFF_H);
  const int c0 = lane * 16, h = lane >> 2;
  for (int row = gw; row < T; row += nw) {
    int pos = row % LT;
    bool first = (pos == 0 || pos == CL), last = (pos == CL - 1 || pos == LT - 1);
    const u16* y0p = YR + (size_t)row * 1024 + c0;
    const u16* y1p = YR + (size_t)(T + row) * 1024 + c0;
    const u16* vp = P + (size_t)row * AB_INP + 2048 + c0;
    const u16* vpp = first ? vp : vp - AB_INP;
    const u16* vnp = last ? vp : vp + AB_INP;
    const u16* gp = G + (size_t)row * 1024 + c0;
    uint4 ra[2], rb[2], rv[2], rvp[2], rvn[2], rg[2];
#pragma unroll
    for (int i = 0; i < 2; ++i) {
      ra[i] = *(const uint4*)(y0p + i * 8); rb[i] = *(const uint4*)(y1p + i * 8);
      rv[i] = *(const uint4*)(vp + i * 8); rvp[i] = *(const uint4*)(vpp + i * 8); rvn[i] = *(const uint4*)(vnp + i * 8);
      rg[i] = *(const uint4*)(gp + i * 8);
    }
    const float rk = RK[(size_t)row * 16 + h] + RK[(size_t)(T + row) * 16 + h];
    const float fm = first ? 0.f : 1.f, lm = last ? 0.f : 1.f;
    float y[16], s1 = 0.f;
#pragma unroll
    for (int i = 0; i < 2; ++i) {
      float a[8], bq[8];
      unpack8(ra[i], a); unpack8(rb[i], bq);
#pragma unroll
      for (int e = 0; e < 8; ++e) { y[i * 8 + e] = a[e] + bq[e]; s1 += y[i * 8 + e]; }
    }
    s1 += dpp_xor1(s1); s1 += dpp_xor2(s1);
    const float mean = s1 * (1.f / 64.f);
    float s2 = 0.f;
#pragma unroll
    for (int e = 0; e < 16; ++e) { y[e] -= mean; s2 += y[e] * y[e]; }
    s2 += dpp_xor1(s2); s2 += dpp_xor2(s2);
    const float rs = rsqrtf(s2 * (1.f / 64.f) + 64e-5f);
#pragma unroll
    for (int i = 0; i < 2; ++i) {
      float vc[8], vq[8], vn[8], gg[8];
      unpack8(rv[i], vc); unpack8(rvp[i], vq); unpack8(rvn[i], vn); unpack8(rg[i], gg);
      unsigned o[4];
      const int cb = c0 + i * 8;
      float m0[8], m1[8], lg[8], lb[8];
      *(float4*)m0 = *(const float4*)(p.rwkv_mu + 2048 + cb); *(float4*)(m0 + 4) = *(const float4*)(p.rwkv_mu + 2048 + cb + 4);
      *(float4*)m1 = *(const float4*)(p.rwkv_mu + RCOLS + 2048 + cb); *(float4*)(m1 + 4) = *(const float4*)(p.rwkv_mu + RCOLS + 2048 + cb + 4);
      *(float4*)lg = *(const float4*)(p.rwkv_ln_g + cb); *(float4*)(lg + 4) = *(const float4*)(p.rwkv_ln_g + cb + 4);
      *(float4*)lb = *(const float4*)(p.rwkv_ln_b + cb); *(float4*)(lb + 4) = *(const float4*)(p.rwkv_ln_b + cb + 4);
#pragma unroll
      for (int e2 = 0; e2 < 4; ++e2) {
        float r2[2];
#pragma unroll
        for (int q = 0; q < 2; ++q) {
          int e = e2 * 2 + q;
          float v = vc[e] + m0[e] * (vq[e] * fm - vc[e]) + m1[e] * (vn[e] * lm - vc[e]);
          r2[q] = (y[i * 8 + e] * rs * lg[e] + lb[e] + rk * v) * gg[e];
        }
        o[e2] = pack2(r2[0], r2[1]);
      }
      *(uint4*)(CAT + (size_t)row * D + c0 + i * 8) = make_uint4(o[0], o[1], o[2], o[3]);
    }
  }
}

DEVI void ph_cd_prep(const Params& p, int bid, int nb, char* smem) {
  u16* P = (u16*)(p.ws + OFF_BIG + B1_P);
  u16* XBC = (u16*)(p.ws + OFF_BIG + B1_XBC);
  float* DT = (float*)(p.ws + OFF_DT);
  const size_t gtid = (size_t)bid * NTH + threadIdx.x, gstride = (size_t)nb * NTH;
  float2* tab = (float2*)smem;
  for (int i = threadIdx.x; i < 64 * 16; i += NTH) {
    int v = i >> 4, f = i & 15;
    float inv = exp2f(-(float)f * (13.287712379549449f / 16.f));
    float sn, cs;
    sincosf((float)v * inv, &sn, &cs);
    tab[i] = make_float2(cs, sn);
  }
  __syncthreads();
  for (size_t it = gtid; it < (size_t)T * 384; it += gstride) {
    int row = (int)(it / 384), c = (int)(it % 384) * 8;
    int pos = row % LT;
    int lo = pos < CL ? 0 : CL, hi = pos < CL ? CL : LT;
    float acc[8];
    {
      float4 b0 = *(const float4*)(p.ssd_conv_b + c), b1 = *(const float4*)(p.ssd_conv_b + c + 4);
      acc[0] = b0.x; acc[1] = b0.y; acc[2] = b0.z; acc[3] = b0.w; acc[4] = b1.x; acc[5] = b1.y; acc[6] = b1.z; acc[7] = b1.w;
    }
    uint4 xv[5];
#pragma unroll
    for (int j = 0; j < 5; ++j) {
      int pp = pos + j - 2;
      bool ok = (pp >= lo && pp < hi);
      xv[j] = *(const uint4*)(P + (size_t)(ok ? row + j - 2 : row) * CD_INP + 2048 + c);
    }
#pragma unroll
    for (int j = 0; j < 5; ++j) {
      int pp = pos + j - 2;
      float m = (pp >= lo && pp < hi) ? 1.f : 0.f;
      float x[8];
      unpack8(xv[j], x);
      float4 w0 = *(const float4*)(p.ssd_conv_w + j * 3072 + c), w1 = *(const float4*)(p.ssd_conv_w + j * 3072 + c + 4);
      acc[0] += m * w0.x * x[0]; acc[1] += m * w0.y * x[1]; acc[2] += m * w0.z * x[2]; acc[3] += m * w0.w * x[3];
      acc[4] += m * w1.x * x[4]; acc[5] += m * w1.y * x[5]; acc[6] += m * w1.z * x[6]; acc[7] += m * w1.w * x[7];
    }
    unsigned o[4];
#pragma unroll
    for (int e = 0; e < 4; ++e) {
      float a0 = acc[2 * e], a1 = acc[2 * e + 1];
      o[e] = pack2(a0 * sigmoidf(a0), a1 * sigmoidf(a1));
    }
    *(uint4*)(XBC + (size_t)row * 3072 + c) = make_uint4(o[0], o[1], o[2], o[3]);
  }
  for (size_t it = gtid; it < (size_t)T * 64; it += gstride) {
    int row = (int)(it >> 6), dh = (int)(it & 63);
    float x = bf2f(P[(size_t)row * CD_INP + 5120 + dh]) + p.ssd_dt_bias[dh];
    float sp = x > 20.f ? x : log1pf(expf(x));
    DT[((size_t)(dh >> 5) * T + row) * 32 + (dh & 31)] = sp;
  }
  for (size_t it = gtid; it < (size_t)NB * SEQ * 40; it += gstride) {
    int a = (int)(it & 1), hh = (int)((it >> 1) % 20);
    int tok = (int)(it / 40);
    int b = tok / SEQ, xp = tok % SEQ;
    int row = b * LT + CL + xp;
    int colbase = (hh < 16 ? 5184 + hh * 64 : 6208 + (hh - 16) * 64) + a * 32;
    const float2* tb = tab + (a == 0 ? (xp >> 6) : (xp & 63)) * 16;
    u16* q1 = P + (size_t)row * CD_INP + colbase;
    uint4 l0 = *(const uint4*)q1, l1 = *(const uint4*)(q1 + 8), h0 = *(const uint4*)(q1 + 16), h1 = *(const uint4*)(q1 + 24);
    float x1[16], x2[16];
    unpack8(l0, x1); unpack8(l1, x1 + 8); unpack8(h0, x2); unpack8(h1, x2 + 8);
    unsigned o1[8], o2[8];
#pragma unroll
    for (int e = 0; e < 8; ++e) {
      float2 t0 = tb[2 * e], t1 = tb[2 * e + 1];
      o1[e] = pack2(x1[2 * e] * t0.x - x2[2 * e] * t0.y, x1[2 * e + 1] * t1.x - x2[2 * e + 1] * t1.y);
      o2[e] = pack2(x1[2 * e] * t0.y + x2[2 * e] * t0.x, x1[2 * e + 1] * t1.y + x2[2 * e + 1] * t1.x);
    }
    *(uint4*)q1 = make_uint4(o1[0], o1[1], o1[2], o1[3]);
    *(uint4*)(q1 + 8) = make_uint4(o1[4], o1[5], o1[6], o1[7]);
    *(uint4*)(q1 + 16) = make_uint4(o2[0], o2[1], o2[2], o2[3]);
    *(uint4*)(q1 + 24) = make_uint4(o2[4], o2[5], o2[6], o2[7]);
  }
}

DEVI void ph_ssd_scan(const Params& p, int blk, char* smem) {
  const int d = blk & 1, h = (blk >> 1) & 31, b = blk >> 6;
  const int g = h >> 3;
  const int tid = threadIdx.x, wid = __builtin_amdgcn_readfirstlane(tid >> 6), lane = tid & 63, fr = lane & 15, fq = lane >> 4;
  const int lt = wid & 3, ph = wid >> 2;
  const int spt = wid & 3, snt0 = (wid >> 2) * 4;
  u16* Cs = (u16*)smem;
  u16* Bs = Cs + 64 * 136;
  u16* BTs = Bs + 64 * 136;
  u16* XT0 = BTs + 128 * 72;
  u16* XT1 = XT0 + 64 * 72;
  u16* Hb = XT1 + 64 * 72;
  float* cumt = (float*)(Hb + 64 * 136);
  const u16* XBC = (const u16*)(p.ws + OFF_BIG + B1_XBC);
  const float* DT = (const float*)(p.ws + OFF_DT) + (size_t)d * T * 32;
  u16* Y = d == 0 ? (u16*)(p.ws + OFF_H) : (u16*)(p.ws + OFF_BIG + B1_YB);
  const float A = -expf(p.ssd_A_log[d * 32 + h]);
  for (int i = tid; i < 64 * 136; i += NTH) Hb[i] = 0;
  f32x4 hst[4];
#pragma unroll
  for (int i = 0; i < 4; ++i) hst[i] = (f32x4){0.f, 0.f, 0.f, 0.f};
  const int ss = tid >> 3, sg = tid & 7;
  uint4 rB0, rB1, rC0, rC1, rX;
  float rdt;
  auto load_raw = [&](int ch) {
    int row = b * LT + dirpos(d, ch * 64 + ss);
    const u16* base = XBC + (size_t)row * 3072;
    rB0 = *(const uint4*)(base + 2048 + g * 128 + sg * 16);
    rB1 = *(const uint4*)(base + 2048 + g * 128 + sg * 16 + 8);
    rC0 = *(const uint4*)(base + 2560 + g * 128 + sg * 16);
    rC1 = *(const uint4*)(base + 2560 + g * 128 + sg * 16 + 8);
    rX = *(const uint4*)(base + h * 64 + sg * 8);
    int rowl = b * LT + dirpos(d, ch * 64 + lane);
    rdt = DT[(size_t)rowl * 32 + h];
  };
  constexpr int NCH = LT / 64;
  load_raw(0);
  for (int ch = 0; ch < NCH; ++ch) {
    float cum = rdt * A;
    cum += __int_as_float(__builtin_amdgcn_update_dpp(0, __float_as_int(cum), 0x111, 0xF, 0xF, true));
    cum += __int_as_float(__builtin_amdgcn_update_dpp(0, __float_as_int(cum), 0x112, 0xF, 0xF, true));
    cum += __int_as_float(__builtin_amdgcn_update_dpp(0, __float_as_int(cum), 0x114, 0xF, 0xF, true));
    cum += __int_as_float(__builtin_amdgcn_update_dpp(0, __float_as_int(cum), 0x118, 0xF, 0xF, true));
    {
      const float t0 = __int_as_float(__builtin_amdgcn_readlane(__float_as_int(cum), 15));
      const float t1 = __int_as_float(__builtin_amdgcn_readlane(__float_as_int(cum), 31));
      const float t2 = __int_as_float(__builtin_amdgcn_readlane(__float_as_int(cum), 47));
      cum += (lane >= 16 ? t0 : 0.f) + (lane >= 32 ? t1 : 0.f) + (lane >= 48 ? t2 : 0.f);
    }
    const float cum63 = __int_as_float(__builtin_amdgcn_readlane(__float_as_int(cum), 63));
    const float my_cum = __shfl(cum, ss), my_dt = __shfl(rdt, ss);
    __syncthreads();
    {
      *(uint4*)(Bs + ss * 136 + sg * 16) = rB0;
      *(uint4*)(Bs + ss * 136 + sg * 16 + 8) = rB1;
      *(uint4*)(Cs + ss * 136 + sg * 16) = rC0;
      *(uint4*)(Cs + ss * 136 + sg * 16 + 8) = rC1;
      unsigned wb[8] = {rB0.x, rB0.y, rB0.z, rB0.w, rB1.x, rB1.y, rB1.z, rB1.w};
#pragma unroll
      for (int e = 0; e < 8; ++e) {
        BTs[(sg * 16 + 2 * e) * 72 + ss] = (u16)(wb[e] & 0xFFFFu);
        BTs[(sg * 16 + 2 * e + 1) * 72 + ss] = (u16)(wb[e] >> 16);
      }
      unsigned wx[4] = {rX.x, rX.y, rX.z, rX.w};
      const float s0 = my_dt, s1 = my_dt * __expf(cum63 - my_cum);
#pragma unroll
      for (int e = 0; e < 4; ++e) {
        float x0 = __uint_as_float(wx[e] << 16), x1 = __uint_as_float(wx[e] & 0xFFFF0000u);
        XT0[(sg * 8 + 2 * e) * 72 + ss] = f2bf(x0 * s0);
        XT0[(sg * 8 + 2 * e + 1) * 72 + ss] = f2bf(x1 * s0);
        XT1[(sg * 8 + 2 * e) * 72 + ss] = f2bf(x0 * s1);
        XT1[(sg * 8 + 2 * e + 1) * 72 + ss] = f2bf(x1 * s1);
      }
      if (wid == 0) cumt[lane] = cum;
#pragma unroll
      for (int i = 0; i < 4; ++i)
#pragma unroll
        for (int j = 0; j < 4; ++j) Hb[(spt * 16 + fq * 4 + j) * 136 + (snt0 + i) * 16 + fr] = f2bf(hst[i][j]);
    }
    __syncthreads();
    load_raw(ch + 1 < NCH ? ch + 1 : ch);
    if (ch >= CL / 64) {
      bf16x8 cf[4];
#pragma unroll
      for (int kn = 0; kn < 4; ++kn) cf[kn] = *(const bf16x8*)(Cs + (lt * 16 + fr) * 136 + kn * 32 + fq * 8);
      const float cl = cumt[lt * 16 + fr];
      float pv[4][4];
#pragma unroll
      for (int st = 0; st < 4; ++st) {
        if (st <= lt) {
          f32x4 acc = (f32x4){0.f, 0.f, 0.f, 0.f};
#pragma unroll
          for (int kn = 0; kn < 4; ++kn) {
            bf16x8 a = *(const bf16x8*)(Bs + (st * 16 + fr) * 136 + kn * 32 + fq * 8);
            acc = __builtin_amdgcn_mfma_f32_16x16x32_bf16(a, cf[kn], acc, 0, 0, 0);
          }
          const float4 cs4 = *(const float4*)(cumt + st * 16 + fq * 4);
          const float csv[4] = {cs4.x, cs4.y, cs4.z, cs4.w};
#pragma unroll
          for (int j = 0; j < 4; ++j) {
            const int sidx = st * 16 + fq * 4 + j, lidx = lt * 16 + fr;
            float w = acc[j] * __expf(fminf(cl - csv[j], 0.f));
            pv[st][j] = (sidx <= lidx) ? w : 0.f;
          }
        } else {
#pragma unroll
          for (int j = 0; j < 4; ++j) pv[st][j] = 0.f;
        }
      }
      bf16x8 pb[2];
#pragma unroll
      for (int ks = 0; ks < 2; ++ks) {
        pb[ks] = mk_bf16x8(pack2(pv[ks * 2][0], pv[ks * 2][1]), pack2(pv[ks * 2][2], pv[ks * 2][3]),
                           pack2(pv[ks * 2 + 1][0], pv[ks * 2 + 1][1]), pack2(pv[ks * 2 + 1][2], pv[ks * 2 + 1][3]));
      }
      const float ecl = __expf(cl);
      const int orow = b * LT + dirpos(d, ch * 64 + lt * 16 + fr);
#pragma unroll
      for (int pi = 0; pi < 2; ++pi) {
        const int pt = ph * 2 + pi;
        f32x4 ya = (f32x4){0.f, 0.f, 0.f, 0.f};
#pragma unroll
        for (int kn = 0; kn < 4; ++kn) {
          bf16x8 a = *(const bf16x8*)(Hb + (pt * 16 + fr) * 136 + kn * 32 + fq * 8);
          ya = __builtin_amdgcn_mfma_f32_16x16x32_bf16(a, cf[kn], ya, 0, 0, 0);
        }
        ya *= ecl;
#pragma unroll
        for (int ks = 0; ks < 2; ++ks) {
          if (ks * 2 <= lt) {
            const u16* xp = XT0 + (pt * 16 + fr) * 72 + ks * 32 + fq * 4;
            uint2 lo = *(const uint2*)xp, hi = *(const uint2*)(xp + 16);
            ya = __builtin_amdgcn_mfma_f32_16x16x32_bf16(mk_bf16x8(lo.x, lo.y, hi.x, hi.y), pb[ks], ya, 0, 0, 0);
          }
        }
        *(uint2*)(Y + (size_t)orow * 2048 + h * 64 + pt * 16 + fq * 4) = make_uint2(pack2(ya[0], ya[1]), pack2(ya[2], ya[3]));
      }
    }
    {
      const float e63 = __expf(cum63);
      bf16x8 xa[2];
#pragma unroll
      for (int ks = 0; ks < 2; ++ks) xa[ks] = *(const bf16x8*)(XT1 + (spt * 16 + fr) * 72 + ks * 32 + fq * 8);
#pragma unroll
      for (int i = 0; i < 4; ++i) {
        f32x4 acc = hst[i] * e63;
#pragma unroll
        for (int ks = 0; ks < 2; ++ks) {
          bf16x8 bq = *(const bf16x8*)(BTs + ((snt0 + i) * 16 + fr) * 72 + ks * 32 + fq * 8);
          acc = __builtin_amdgcn_mfma_f32_16x16x32_bf16(xa[ks], bq, acc, 0, 0, 0);
        }
        hst[i] = acc;
      }
    }
  }
  __syncthreads();
}

DEVI void ph_attn(const Params& p, int first_blk, int nblk, char* smem) {
  const int tid = threadIdx.x, wid = tid >> 6, lane = tid & 63;
  const int fr = lane & 15, fq = lane >> 4;
  const int hr = wid & 3, qsub = wid >> 2;
  u16* Ks = (u16*)smem;
  u16* VTs = Ks + 64 * 72;
  const u16* P = (const u16*)(p.ws + OFF_BIG + B1_P);
  u16* CAT = (u16*)(p.ws + OFF_BIG + B1_CAT);
  for (int task = first_blk; task < NB * 4 * 64; task += nblk) {
    const int qt = task & 63, hkv = (task >> 6) & 3, b = task >> 8;
    const int hq = hkv * 4 + hr;
    const int q0 = qt * 64;
    const int qw0 = q0 + qsub * 32;
    bf16x8 qf[2][2];
#pragma unroll
    for (int nt = 0; nt < 2; ++nt) {
      const u16* qp = P + (size_t)(b * LT + CL + qw0 + nt * 16 + fr) * CD_INP + 5184 + hq * 64 + fq * 8;
#pragma unroll
      for (int ks = 0; ks < 2; ++ks) {
        uint4 v = *(const uint4*)(qp + ks * 32);
        unsigned w[4] = {v.x, v.y, v.z, v.w};
        unsigned o[4];
#pragma unroll
        for (int e = 0; e < 4; ++e)
          o[e] = pack2(__uint_as_float(w[e] << 16) * 0.125f, __uint_as_float(w[e] & 0xFFFF0000u) * 0.125f);
        qf[nt][ks] = mk_bf16x8(o[0], o[1], o[2], o[3]);
      }
    }
    f32x4 O[4][2];
#pragma unroll
    for (int dt = 0; dt < 4; ++dt)
#pragma unroll
      for (int nt = 0; nt < 2; ++nt) O[dt][nt] = (f32x4){0.f, 0.f, 0.f, 0.f};
    float mrun[2], lrun[2];
    const float sink = p.attn_sink[hq];
#pragma unroll
    for (int nt = 0; nt < 2; ++nt) { mrun[nt] = sink; lrun[nt] = fq == 0 ? 1.f : 0.f; }
    const int kb0 = max(0, q0 - 128), kb1 = min(SEQ, q0 + 64 + 128);
    const int nband = (kb1 - kb0) >> 6;
    for (int tile = 0; tile < 4 + nband; ++tile) {
      const bool isctx = tile < 4;
      const int kbase = isctx ? tile * 64 : kb0 + (tile - 4) * 64;
      const int krow0 = b * LT + (isctx ? kbase : CL + kbase);
      __syncthreads();
      {
        int key = tid >> 3, seg = tid & 7;
        uint4 kv = *(const uint4*)(P + (size_t)(krow0 + key) * CD_INP + 6208 + hkv * 64 + seg * 8);
        *(uint4*)(Ks + key * 72 + seg * 8) = kv;
        int key2 = tid & 63, seg2 = tid >> 6;
        uint4 vv = *(const uint4*)(P + (size_t)(krow0 + key2) * CD_INP + 6464 + hkv * 64 + seg2 * 8);
        unsigned w[4] = {vv.x, vv.y, vv.z, vv.w};
#pragma unroll
        for (int e = 0; e < 4; ++e) {
          VTs[(seg2 * 8 + 2 * e) * 72 + key2] = (u16)(w[e] & 0xFFFFu);
          VTs[(seg2 * 8 + 2 * e + 1) * 72 + key2] = (u16)(w[e] >> 16);
        }
      }
      __syncthreads();
      f32x4 ST[4][2];
#pragma unroll
      for (int mt = 0; mt < 4; ++mt) {
        bf16x8 a0 = *(const bf16x8*)(Ks + (mt * 16 + fr) * 72 + fq * 8);
        bf16x8 a1 = *(const bf16x8*)(Ks + (mt * 16 + fr) * 72 + 32 + fq * 8);
#pragma unroll
        for (int nt = 0; nt < 2; ++nt) {
          f32x4 z = (f32x4){0.f, 0.f, 0.f, 0.f};
          z = __builtin_amdgcn_mfma_f32_16x16x32_bf16(a0, qf[nt][0], z, 0, 0, 0);
          ST[mt][nt] = __builtin_amdgcn_mfma_f32_16x16x32_bf16(a1, qf[nt][1], z, 0, 0, 0);
        }
      }
      if (!isctx) {
#pragma unroll
        for (int mt = 0; mt < 4; ++mt)
#pragma unroll
          for (int nt = 0; nt < 2; ++nt)
#pragma unroll
            for (int j = 0; j < 4; ++j) {
              int dlt = (qw0 + nt * 16 + fr) - (kbase + mt * 16 + fq * 4 + j);
              if (dlt > 128 || dlt < -128) ST[mt][nt][j] = -INFINITY;
            }
      }
      bf16x8 pb[2][2];
#pragma unroll
      for (int nt = 0; nt < 2; ++nt) {
        float mx = -INFINITY;
#pragma unroll
        for (int mt = 0; mt < 4; ++mt)
#pragma unroll
          for (int j = 0; j < 4; ++j) mx = fmaxf(mx, ST[mt][nt][j]);
        mx = fmaxf(mx, __shfl_xor(mx, 16));
        mx = fmaxf(mx, __shfl_xor(mx, 32));
        float mn = fmaxf(mrun[nt], mx);
        float alpha = __expf(mrun[nt] - mn);
        mrun[nt] = mn;
        float ls = 0.f;
        float pv[4][4];
#pragma unroll
        for (int mt = 0; mt < 4; ++mt)
#pragma unroll
          for (int j = 0; j < 4; ++j) { pv[mt][j] = __expf(ST[mt][nt][j] - mn); ls += pv[mt][j]; }
        lrun[nt] = lrun[nt] * alpha + ls;
#pragma unroll
        for (int dt = 0; dt < 4; ++dt) O[dt][nt] *= alpha;
#pragma unroll
        for (int ks = 0; ks < 2; ++ks) {
          pb[nt][ks] = mk_bf16x8(pack2(pv[ks * 2][0], pv[ks * 2][1]), pack2(pv[ks * 2][2], pv[ks * 2][3]),
                                 pack2(pv[ks * 2 + 1][0], pv[ks * 2 + 1][1]), pack2(pv[ks * 2 + 1][2], pv[ks * 2 + 1][3]));
        }
      }
#pragma unroll
      for (int dt = 0; dt < 4; ++dt)
#pragma unroll
        for (int ks = 0; ks < 2; ++ks) {
          const u16* vp = VTs + (dt * 16 + fr) * 72 + ks * 32 + fq * 4;
          uint2 lo = *(const uint2*)vp, hi = *(const uint2*)(vp + 16);
          bf16x8 a = mk_bf16x8(lo.x, lo.y, hi.x, hi.y);
#pragma unroll
          for (int nt = 0; nt < 2; ++nt) O[dt][nt] = __builtin_amdgcn_mfma_f32_16x16x32_bf16(a, pb[nt][ks], O[dt][nt], 0, 0, 0);
        }
    }
#pragma unroll
    for (int nt = 0; nt < 2; ++nt) {
      float l = lrun[nt];
      l += __shfl_xor(l, 16);
      l += __shfl_xor(l, 32);
      float inv = 1.f / l;
      u16* op = CAT + (size_t)(b * LT + CL + qw0 + nt * 16 + fr) * 3072 + 2048 + hq * 64 + fq * 4;
#pragma unroll
      for (int dt = 0; dt < 4; ++dt)
        *(uint2*)(op + dt * 16) = make_uint2(cvt_pk_bf16(O[dt][nt][0] * inv, O[dt][nt][1] * inv), cvt_pk_bf16(O[dt][nt][2] * inv, O[dt][nt][3] * inv));
    }
  }
}

DEVI void ph_ssd_combine(const Params& p, int gw, int nw) {
  int lane = threadIdx.x & 63;
  const u16* P = (const u16*)(p.ws + OFF_BIG + B1_P);
  const u16* XBC = (const u16*)(p.ws + OFF_BIG + B1_XBC);
  const u16* YF = (const u16*)(p.ws + OFF_H);
  const u16* YB = (const u16*)(p.ws + OFF_BIG + B1_YB);
  u16* CAT = (u16*)(p.ws + OFF_BIG + B1_CAT);
  for (int it = gw; it < NB * SEQ * 4; it += nw) {
    int grp = it & 3, tok = it >> 2;
    int row = (tok / SEQ) * LT + CL + (tok % SEQ);
    int ch = grp * 512 + lane * 8;
    float dsk = p.ssd_D[ch >> 6];
    uint4 yf = *(const uint4*)(YF + (size_t)row * 2048 + ch), yb = *(const uint4*)(YB + (size_t)row * 2048 + ch);
    uint4 xv = *(const uint4*)(XBC + (size_t)row * 3072 + ch), zv = *(const uint4*)(P + (size_t)row * CD_INP + ch);
    unsigned a[4] = {yf.x, yf.y, yf.z, yf.w}, bq[4] = {yb.x, yb.y, yb.z, yb.w}, xq[4] = {xv.x, xv.y, xv.z, xv.w},
             zq[4] = {zv.x, zv.y, zv.z, zv.w};
    float y[8];
    float ss = 0.f;
#pragma unroll
    for (int i = 0; i < 4; ++i) {
#pragma unroll
      for (int e = 0; e < 2; ++e) {
        float f = e ? __uint_as_float(a[i] & 0xFFFF0000u) : __uint_as_float(a[i] << 16);
        float bb = e ? __uint_as_float(bq[i] & 0xFFFF0000u) : __uint_as_float(bq[i] << 16);
        float xx = e ? __uint_as_float(xq[i] & 0xFFFF0000u) : __uint_as_float(xq[i] << 16);
        float zz = e ? __uint_as_float(zq[i] & 0xFFFF0000u) : __uint_as_float(zq[i] << 16);
        float v = (f + bb + dsk * xx) * (zz * sigmoidf(zz));
        y[i * 2 + e] = v;
        ss += v * v;
      }
    }
    ss = wave_sum(ss);
    float sc = rsqrtf(ss * (1.f / 512.f) + 1e-6f);
    float4 g0 = *(const float4*)(p.ssd_norm_g + ch), g1 = *(const float4*)(p.ssd_norm_g + ch + 4);
    *(uint4*)(CAT + (size_t)row * 3072 + ch) =
        make_uint4(pack2(y[0] * sc * g0.x, y[1] * sc * g0.y), pack2(y[2] * sc * g0.z, y[3] * sc * g0.w),
                   pack2(y[4] * sc * g1.x, y[5] * sc * g1.y), pack2(y[6] * sc * g1.z, y[7] * sc * g1.w));
  }
}

DEVI void ph_final(const Params& p, int gw, int nw) {
  int lane = threadIdx.x & 63;
  for (int it = gw; it < NB * SEQ; it += nw) {
    float* row = p.out + (size_t)it * D;
    float4 v[8];
    float ss = 0.f;
#pragma unroll
    for (int i = 0; i < 8; ++i) {
      v[i] = *(const float4*)(row + (i * 64 + lane) * 4);
      ss += v[i].x * v[i].x + v[i].y * v[i].y + v[i].z * v[i].z + v[i].w * v[i].w;
    }
    ss = wave_sum(ss);
    float rs = rsqrtf(ss * (1.f / D) + 1e-6f);
#pragma unroll
    for (int i = 0; i < 8; ++i) {
      int c = (i * 64 + lane) * 4;
      float4 g = *(const float4*)(p.final_g + c);
      *(float4*)(row + c) = make_float4(v[i].x * rs * g.x, v[i].y * rs * g.y, v[i].z * rs * g.z, v[i].w * rs * g.w);
    }
  }
}

#include <vector>

#define XB_TMO      128
#define XB_XCNT(j)  (256  + 64 * (j))
#define XB_XSUB(j)  (1280 + 64 * (j))
#define XB_XGEN(j)  (2304 + 64 * (j))
#define XB_TOP      3328
#define XB_TOPGEN   3392
#define XCD_BAR_WORDS 3456
#define XB_SPIN_CAP (1u << 21)

__device__ __forceinline__ unsigned xb_ld(unsigned* p)              { return __hip_atomic_load(p, __ATOMIC_RELAXED, __HIP_MEMORY_SCOPE_AGENT); }
__device__ __forceinline__ unsigned xb_add(unsigned* p, unsigned v) { return __hip_atomic_fetch_add(p, v, __ATOMIC_RELAXED, __HIP_MEMORY_SCOPE_AGENT); }
__device__ __forceinline__ unsigned xb_xcc_id() { return (unsigned)__builtin_amdgcn_s_getreg((3 << 11) | 20) & 0xFu; }
#define XB_SPIN(cond, bar) do { unsigned _sp = 0; while (cond) { __builtin_amdgcn_s_sleep(1); \
    if ((++_sp & 255u) == 0u) { if (xb_ld(&(bar)[XB_TMO])) break; if (_sp > XB_SPIN_CAP) { atomicAdd(&(bar)[XB_TMO], 1u); break; } } } } while (0)

struct XcdBarrier {
    unsigned* bar; unsigned x;
    volatile LAS unsigned* st;
};

__device__ __forceinline__ XcdBarrier xcd_barrier_post(unsigned* bar, volatile LAS unsigned* st) {
    XcdBarrier b; b.bar = bar; b.x = xb_xcc_id(); b.st = st;
    if (threadIdx.x == 0) (void)xb_add(&bar[XB_XCNT(b.x)], 1u);
    return b;
}
__device__ __forceinline__ void xcd_barrier_complete(unsigned* bar, unsigned x, unsigned& nloc, unsigned& nx) {
    const unsigned G = gridDim.x * gridDim.y * gridDim.z;
    unsigned sum, cnt, mine, sp = 0u;
    for (;;) {
        sum = 0u; cnt = 0u; mine = 0u;
#pragma unroll
        for (unsigned j = 0; j < 16; ++j) { const unsigned c = xb_ld(&bar[XB_XCNT(j)]); sum += c; cnt += (c > 0u) ? 1u : 0u; mine = (j == x) ? c : mine; }
        if (sum == G) break;
        __builtin_amdgcn_s_sleep(1);
        if ((++sp & 255u) == 0u) { if (xb_ld(&bar[XB_TMO])) break; if (sp > XB_SPIN_CAP) { atomicAdd(&bar[XB_TMO], 1u); break; } }
    }
    nloc = mine > 0u ? mine : 1u; nx = cnt > 0u ? cnt : 1u;
}

__device__ __forceinline__ void xcd_barrier(const XcdBarrier& b) {
    asm volatile("s_waitcnt vmcnt(0)" ::: "memory");
    __syncthreads();
    if (threadIdx.x == 0) {
        unsigned* bar = b.bar;
        __builtin_amdgcn_s_waitcnt(0);
        unsigned nloc = b.st[0], nx = b.st[1];
        if (nloc == 0u) { xcd_barrier_complete(bar, b.x, nloc, nx); b.st[0] = nloc; b.st[1] = nx; }
        const unsigned old = xb_add(&bar[XB_XSUB(b.x)], 1u);
        const unsigned gen = old / nloc;
        if (old + 1u == (gen + 1u) * nloc) {
            __builtin_amdgcn_fence(__ATOMIC_RELEASE, "agent");
            asm volatile("s_waitcnt vmcnt(0)" ::: "memory");
            const unsigned og = xb_add(&bar[XB_TOP], 1u);
            const unsigned tg = og / nx;
            if (og + 1u == (tg + 1u) * nx) xb_add(&bar[XB_TOPGEN], 1u);
            else XB_SPIN(xb_ld(&bar[XB_TOPGEN]) == tg, bar);
            __builtin_amdgcn_fence(__ATOMIC_ACQUIRE, "agent");
            xb_add(&bar[XB_XGEN(b.x)], 1u);
            asm volatile("s_waitcnt vmcnt(0)" ::: "memory");
        } else {
            XB_SPIN(xb_ld(&bar[XB_XGEN(b.x)]) == gen, bar);
            __builtin_amdgcn_fence(__ATOMIC_ACQUIRE, "agent");
            asm volatile("s_waitcnt vmcnt(0)" ::: "memory");
        }
    }
    __syncthreads();
}


#ifndef REPEAT_MASK
#define REPEAT_MASK 0
#endif
#ifndef PROBE_K
#define PROBE_K -1
#define PROBE_ID 0
#endif
constexpr int NPH = 21;
constexpr int SMEM_BYTES = STAGE_BYTES + 16;

template <class Epi>
DEVI void run_gemm(const Params& p, LAS unsigned char* lds, const u16* A, const u16* Bt, int K, int nN, int xonly, int bid, int nb,
                   const Epi& E) {
  Order S;
  S.init(xonly ? 64 : 68, nN, nb, bid, xonly);
  Gemm g{A, Bt, K};
  gemm_phase(lds, g, S, E);
}

DEVI void run_phase(const Params& p, int ph, int bid, int nb, char* smem, LAS unsigned char* lds) {
  char* ws = p.ws;
  u16* H = (u16*)(ws + OFF_H);
  const int gw = bid * NWV + (threadIdx.x >> 6), nw = nb * NWV;
#ifdef ONLY_PHASE
  ph = ONLY_PHASE;
#endif
  switch (ph) {
    case 0:
      ph_mod(p, bid, nb, smem);
      __syncthreads();
      ph_convert(p, 0, bid, nb, smem);
      break;
    case 1: ph_norm(p, 0, 0, true, false, bid, nb); break;
    case 2:
      run_gemm(p, lds, H, (const u16*)(ws + OFF_W16 + W0_IN), D, AB_INP / 256, 0, bid, nb,
               EpiBf16<0>{(u16*)(ws + OFF_BIG + B0_P), AB_INP, 0, 0});
      break;
    case 3:
      ph_lora_in(p, bid, nb);
      ph_s5_pass1(p, gw, nw, smem);
      break;
    case 4:
      run_gemm(p, lds, (const u16*)(ws + OFF_BIG + B0_LIN), (const u16*)(ws + OFF_W16 + W0_LORA), 512, 20, 0, bid, nb,
               EpiBf16<0>{(u16*)(ws + OFF_BIG + B0_WL), 1024, 1024, (size_t)T * 1024});
      ph_s5_prefix(p, nw - 1 - gw, nw);
      break;
    case 5:
      if (bid < 128) ph_rwkv_scan(p, bid, smem);
      else ph_s5_pass2(p, (bid - 128) * NWV + (threadIdx.x >> 6), (nb - 128) * NWV, smem);
      break;
    case 6:
      ph_rwkv_post(p, gw, nw);
      run_gemm(p, lds, (const u16*)(ws + OFF_BIG + B0_YG), (const u16*)(ws + OFF_W16 + W0_GLU), 1024, 4, 0, bid, nb,
               EpiGlu{(const u16*)(ws + OFF_BIG + B0_YG), H, p.s5_glu_b});
      break;
    case 7:
      run_gemm(p, lds, H, (const u16*)(ws + OFF_W16 + W0_OUT), D, 8, 0, bid, nb, EpiResid{p, 0, 2, 1});
      break;
    case 8: ph_norm(p, 0, 1, false, false, bid, nb); break;
    case 9:
      run_gemm(p, lds, H, (const u16*)(ws + OFF_W16 + W_W1), D, 32, 0, bid, nb, EpiBf16<1>{(u16*)(ws + OFF_BIG), DFF, 0, 0});
      break;
    case 10:
      run_gemm(p, lds, (const u16*)(ws + OFF_BIG), (const u16*)(ws + OFF_W16 + W_W2), DFF, 8, 0, bid, nb, EpiResid{p, 0, 5, 0});
      break;
    case 11:
      ph_convert(p, 1, bid, nb, smem);
      ph_norm(p, 1, 0, false, false, bid, nb);
      break;
    case 12:
      run_gemm(p, lds, H, (const u16*)(ws + OFF_W16 + W1_IN), D, CD_INP / 256, 0, bid, nb,
               EpiBf16<0>{(u16*)(ws + OFF_BIG + B1_P), CD_INP, 0, 0});
      break;
    case 13: ph_cd_prep(p, bid, nb, smem); break;
    case 14:
      ph_ssd_scan(p, bid, smem);
      __syncthreads();
      ph_attn(p, bid, nb, smem);
      break;
    case 15: ph_ssd_combine(p, gw, nw); break;
    case 16:
      run_gemm(p, lds, (const u16*)(ws + OFF_BIG + B1_CAT), (const u16*)(ws + OFF_W16 + W1_OUT), 3072, 8, 1, bid, nb,
               EpiResid{p, 1, 2, 0});
      break;
    case 17: ph_norm(p, 1, 1, false, true, bid, nb); break;
    case 18:
      run_gemm(p, lds, H, (const u16*)(ws + OFF_W16 + W_W1), D, 32, 1, bid, nb, EpiBf16<1>{(u16*)(ws + OFF_BIG), DFF, 0, 0});
      break;
    case 19:
      run_gemm(p, lds, (const u16*)(ws + OFF_BIG), (const u16*)(ws + OFF_W16 + W_W2), DFF, 8, 1, bid, nb, EpiResid{p, 1, 5, 0});
      break;
    case 20: ph_final(p, gw, nw); break;
    case 105:
      if (bid >= 128) ph_s5_pass2(p, (bid - 128) * NWV + (threadIdx.x >> 6), (nb - 128) * NWV, smem);
      break;
    case 205:
      if (bid < 128) ph_rwkv_scan(p, bid, smem);
      break;
    case 114: ph_ssd_scan(p, bid, smem); break;
    case 214: ph_attn(p, bid, nb, smem); break;
    default: break;
  }
}

__global__ void __launch_bounds__(512, 2) fwd_megakernel(Params p) {
  extern __shared__ __attribute__((aligned(16))) unsigned char shm[];
  char* smem = (char*)shm;
  LAS unsigned char* lds = (LAS unsigned char*)shm;
  cg::grid_group grid = cg::this_grid();
  volatile LAS unsigned* bst = (volatile LAS unsigned*)(lds + STAGE_BYTES);
  if (threadIdx.x < 4) bst[threadIdx.x] = 0u;
  __syncthreads();
  const XcdBarrier xb = xcd_barrier_post((unsigned*)(p.ws + OFF_BAR), bst);
#define GSYNC(k) do { if ((k) == 0) grid.sync(); else xcd_barrier(xb); } while (0)
#define PHASE(k)                                                    \
  if (p.ph_lo <= (k) && (k) < p.ph_hi) {                            \
    run_phase(p, (k), blockIdx.x, gridDim.x, smem, lds);            \
    if ((REPEAT_MASK >> (k)) & 1) {                                 \
      GSYNC(k);                                                     \
      run_phase(p, (k), blockIdx.x, gridDim.x, smem, lds);          \
    }                                                               \
    if ((k) == PROBE_K) {                                           \
      GSYNC(k);                                                     \
      run_phase(p, PROBE_ID, blockIdx.x, gridDim.x, smem, lds);     \
    }                                                               \
    if ((k) + 1 < p.ph_hi) GSYNC(k);                                \
  }
  PHASE(0) PHASE(1) PHASE(2) PHASE(3) PHASE(4) PHASE(5) PHASE(6) PHASE(7) PHASE(8) PHASE(9) PHASE(10)
  PHASE(11) PHASE(12) PHASE(13) PHASE(14) PHASE(15) PHASE(16) PHASE(17) PHASE(18) PHASE(19) PHASE(20)
#undef PHASE
}

#ifndef SINGLE_LAUNCH
#define SINGLE_LAUNCH 1
#endif

extern "C" void kernel_launch(void* const* d_in, const int* in_sizes, int n_in, void* d_out, int out_size, void* d_ws,
                              size_t ws_size, hipStream_t stream) {
  if (ws_size < WS_NEEDED) {
    fprintf(stderr, "workspace too small: %zu < %zu\n", ws_size, (size_t)WS_NEEDED);
    return;
  }
  Params p{};
  const float** fp = (const float**)&p;
  for (int i = 0; i < 43; ++i) fp[i] = (const float*)d_in[i];
  p.out = (float*)d_out;
  p.ws = (char*)d_ws;
  static int grid_blocks = 0;
  if (!grid_blocks) {
    int dev = 0, cus = 0, per_cu = 0;
    hipGetDevice(&dev);
    hipDeviceGetAttribute(&cus, hipDeviceAttributeMultiprocessorCount, dev);
    hipFuncSetAttribute((const void*)fwd_megakernel, hipFuncAttributeMaxDynamicSharedMemorySize, SMEM_BYTES);
    hipOccupancyMaxActiveBlocksPerMultiprocessor(&per_cu, fwd_megakernel, NTH, SMEM_BYTES);
    if (per_cu > 1) per_cu = 1;
    grid_blocks = cus * per_cu;
  }
  hipMemsetAsync((char*)d_ws + OFF_BAR, 0, BAR_BYTES, stream);
#if SINGLE_LAUNCH
  p.ph_lo = 0;
  p.ph_hi = NPH;
  void* args[] = {&p};
  hipError_t e = hipLaunchCooperativeKernel((void*)fwd_megakernel, dim3(grid_blocks), dim3(NTH), args, SMEM_BYTES, stream);
  if (e != hipSuccess) fprintf(stderr, "cooperative launch failed: %s (grid %d)\n", hipGetErrorString(e), grid_blocks);
#else
  for (int ph = 0; ph < NPH; ++ph) {
    p.ph_lo = ph;
    p.ph_hi = ph + 1;
    fwd_megakernel<<<256, NTH, SMEM_BYTES, stream>>>(p);
  }
#endif
}
```

```cpp
#include <hip/hip_runtime.h>
#include <hip/hip_cooperative_groups.h>
#include <cstdio>
namespace cg = cooperative_groups;

typedef unsigned short u16;
using bf16x8 = __attribute__((ext_vector_type(8))) short;
using f32x4 = __attribute__((ext_vector_type(4))) float;
#define DEVI __device__ __forceinline__

constexpr int NB = 4, SEQ = 4096, CL = 256, LT = SEQ + CL, T = NB * LT, D = 2048, DFF = 8192;
constexpr int AB_IN = 4544, AB_INP = 4608, CD_IN = 6720, CD_INP = 6912;
constexpr int NTH = 512, NWV = 8;
constexpr int RCOLS = 3520;

constexpr size_t al256(size_t x) { return (x + 255) & ~(size_t)255; }
constexpr size_t OFF_MOD = 0;
constexpr size_t OFF_CX = al256(OFF_MOD + 2 * 5 * 12288 * 4);
constexpr size_t OFF_RK = al256(OFF_CX + (size_t)NB * CL * D * 4);
constexpr size_t OFF_DT = al256(OFF_RK + (size_t)2 * T * 16 * 4);
constexpr size_t OFF_S5E = al256(OFF_DT + (size_t)2 * T * 32 * 4);
constexpr size_t OFF_W16 = al256(OFF_S5E + (size_t)NB * 64 * 2 * 68 * 128 * 4);
constexpr size_t W_W1 = 0, W_W2 = 33554432, W_L = 67108864;
constexpr size_t W0_IN = W_L, W0_OUT = W0_IN + (size_t)AB_INP * D * 2, W0_LORA = W0_OUT + (size_t)D * D * 2,
                 W0_GLU = W0_LORA + (size_t)5120 * 512 * 2;
constexpr size_t W1_IN = W_L, W1_OUT = W1_IN + (size_t)CD_INP * D * 2;
constexpr size_t W16_SIZE = W1_OUT + (size_t)D * 3072 * 2;
constexpr size_t OFF_H = al256(OFF_W16 + W16_SIZE);
constexpr size_t OFF_BIG = al256(OFF_H + (size_t)T * D * 2);
constexpr size_t B0_P = 0, B0_LIN = B0_P + (size_t)T * AB_INP * 2, B0_WL = B0_LIN + (size_t)T * 512 * 2,
                 B0_AL = B0_WL + (size_t)2 * T * 1024 * 2, B0_G = B0_AL + (size_t)2 * T * 1024 * 2,
                 B0_YR = B0_G + (size_t)T * 1024 * 2, B0_YG = B0_YR + (size_t)2 * T * 1024 * 2,
                 B0_END = B0_YG + (size_t)T * 1024 * 2;
constexpr size_t B1_P = 0, B1_XBC = B1_P + (size_t)T * CD_INP * 2, B1_YB = B1_XBC + (size_t)T * 3072 * 2,
                 B1_CAT = B1_YB + (size_t)T * 2048 * 2, B1_END = B1_CAT + (size_t)T * 3072 * 2;
constexpr size_t BIG_SIZE = B1_END > B0_END ? B1_END : B0_END;
constexpr size_t OFF_BAR = al256(OFF_BIG + BIG_SIZE);
constexpr size_t BAR_BYTES = 16384;
constexpr size_t WS_NEEDED = OFF_BAR + BAR_BYTES;

struct Params {
  const float *x, *c, *ctx, *c_ctx, *ada_w, *ada_b, *norm1_g, *norm2_g, *mlp_w1, *mlp_w2, *final_g;
  const float *ab_w_in, *ab_w_out, *rwkv_mu, *rwkv_w0, *rwkv_w_up, *rwkv_a0, *rwkv_a_up, *rwkv_g_up;
  const float *rwkv_k_k, *rwkv_k_a, *rwkv_r_k, *rwkv_ln_g, *rwkv_ln_b;
  const float *s5_A_re, *s5_A_im, *s5_log_dt, *s5_B_re, *s5_B_im, *s5_C_re, *s5_C_im, *s5_D, *s5_glu_w, *s5_glu_b;
  const float *cd_w_in, *cd_w_out, *ssd_conv_w, *ssd_conv_b, *ssd_A_log, *ssd_dt_bias, *ssd_D, *ssd_norm_g, *attn_sink;
  float* out;
  char* ws;
  int ph_lo, ph_hi;
};

DEVI u16 f2bf(float f) {
  unsigned u = __float_as_uint(f);
  u += 0x7FFFu + ((u >> 16) & 1u);
  return (u16)(u >> 16);
}
DEVI float bf2f(u16 h) { return __uint_as_float(((unsigned)h) << 16); }
DEVI unsigned pack2(float a, float b) { return (unsigned)f2bf(a) | ((unsigned)f2bf(b) << 16); }
DEVI float sigmoidf(float x) { return 1.f / (1.f + __expf(-x)); }
DEVI float dpp_xor1(float v) {
  return __int_as_float(__builtin_amdgcn_update_dpp(0, __float_as_int(v), 0xB1, 0xF, 0xF, true));
}
DEVI float dpp_xor2(float v) {
  return __int_as_float(__builtin_amdgcn_update_dpp(0, __float_as_int(v), 0x4E, 0xF, 0xF, true));
}
DEVI float dpp_half_mirror(float v) {
  return __int_as_float(__builtin_amdgcn_update_dpp(0, __float_as_int(v), 0x141, 0xF, 0xF, true));
}
DEVI float dpp_ror4(float v) {
  return __int_as_float(__builtin_amdgcn_update_dpp(0, __float_as_int(v), 0x124, 0xF, 0xF, true));
}
DEVI float dpp_ror8(float v) {
  return __int_as_float(__builtin_amdgcn_update_dpp(0, __float_as_int(v), 0x128, 0xF, 0xF, true));
}
DEVI float sum16(float v) {
  v += dpp_xor1(v);
  v += dpp_xor2(v);
  v += dpp_ror4(v);
  v += dpp_ror8(v);
  return v;
}
DEVI float sum8(float v) {
  v += dpp_xor1(v);
  v += dpp_xor2(v);
  v += dpp_half_mirror(v);
  return v;
}
DEVI float wave_sum(float v) {
  v += dpp_xor1(v);
  v += dpp_xor2(v);
  v += __shfl_xor(v, 4);
  v += __shfl_xor(v, 8);
  v += __shfl_xor(v, 16);
  v += __shfl_xor(v, 32);
  return v;
}
DEVI void lds_barrier() { asm volatile("s_waitcnt lgkmcnt(0)\n\ts_barrier" ::: "memory"); }
DEVI void wave_lds_fence() { asm volatile("s_waitcnt lgkmcnt(0)" ::: "memory"); }

DEVI float* xrow_ptr(const Params& p, int row) {
  int b = row / LT, pos = row - b * LT;
  return pos < CL ? (float*)(p.ws + OFF_CX) + (size_t)(b * CL + pos) * D : p.out + (size_t)(b * SEQ + pos - CL) * D;
}
DEVI const float* inrow_ptr(const Params& p, int row) {
  int b = row / LT, pos = row - b * LT;
  return pos < CL ? p.ctx + (size_t)(b * CL + pos) * D : p.x + (size_t)(b * SEQ + pos - CL) * D;
}
DEVI int dirpos(int d, int j) { return d == 0 ? j : (j < CL ? CL - 1 - j : LT + CL - 1 - j); }
DEVI const float* mod_ptr(const Params& p, int layer, int row, int idx) {
  int b = row / LT, pos = row - b * LT;
  int r = pos < CL ? 4 : b;
  return (const float*)(p.ws + OFF_MOD) + (size_t)(layer * 5 + r) * 12288 + idx * 2048;
}

DEVI void tjob(const float* __restrict__ src, u16* __restrict__ dst, int K, int N, int Npad, int& t, int& off, int nb,
               char* smem) {
  float* sm = (float*)smem;
  int kt = (K + 63) / 64, nt = Npad / 256, ntiles = kt * nt;
  int tid = threadIdx.x;
  while (t < off + ntiles) {
    int lt = t - off;
    int tk = lt % kt, tn = lt / kt;
    int k0 = tk * 64, n0 = tn * 256;
    float4 v[8];
#pragma unroll
    for (int i = 0; i < 8; ++i) {
      int idx = i * 512 + tid;
      int kk = idx >> 6, c4 = idx & 63;
      v[i] = make_float4(0.f, 0.f, 0.f, 0.f);
      if (k0 + kk < K && n0 + c4 * 4 < N) v[i] = *(const float4*)(src + (size_t)(k0 + kk) * N + n0 + c4 * 4);
    }
    __syncthreads();
#pragma unroll
    for (int i = 0; i < 8; ++i) {
      int idx = i * 512 + tid;
      int kk = idx >> 6, c4 = idx & 63;
      float* d = sm + kk * 257 + c4 * 4;
      d[0] = v[i].x; d[1] = v[i].y; d[2] = v[i].z; d[3] = v[i].w;
    }
    __syncthreads();
#pragma unroll
    for (int i = 0; i < 4; ++i) {
      int gidx = i * 512 + tid;
      int nl = gidx >> 3, kg = gidx & 7;
      if (k0 + kg * 8 < K) {
        unsigned w[4];
#pragma unroll
        for (int j = 0; j < 4; ++j) w[j] = pack2(sm[(kg * 8 + 2 * j) * 257 + nl], sm[(kg * 8 + 2 * j + 1) * 257 + nl]);
        *(uint4*)(dst + (size_t)(n0 + nl) * K + k0 + kg * 8) = make_uint4(w[0], w[1], w[2], w[3]);
      }
    }
    t += nb;
  }
  off += ntiles;
}

DEVI void lora_w_job(const Params& p, u16* dst, int bid, int nb) {
  for (int it = bid * NTH + threadIdx.x; it < 5120 * 64; it += nb * NTH) {
    int n = it % 5120, kg = it / 5120;
    int blk = n >> 10, nn = n & 1023;
    unsigned w[4];
#pragma unroll
    for (int j = 0; j < 4; ++j) {
      float v[2];
#pragma unroll
      for (int e = 0; e < 2; ++e) {
        int k = kg * 8 + j * 2 + e;
        float x = 0.f;
        if (blk < 2) { if (k < 96) x = p.rwkv_w_up[((size_t)blk * 96 + k) * 1024 + nn]; }
        else if (blk < 4) { if (k >= 96 && k < 192) x = p.rwkv_a_up[((size_t)(blk - 2) * 96 + (k - 96)) * 1024 + nn]; }
        else { if (k >= 192 && k < 448) x = p.rwkv_g_up[(size_t)(k - 192) * 1024 + nn]; }
        v[e] = x;
      }
      w[j] = pack2(v[0], v[1]);
    }
    *(uint4*)(dst + (size_t)n * 512 + kg * 8) = make_uint4(w[0], w[1], w[2], w[3]);
  }
}

DEVI void ph_convert(const Params& p, int layer, int bid, int nb, char* smem) {
  char* w16 = p.ws + OFF_W16;
  int t = bid, off = 0;
  tjob(p.mlp_w1 + (size_t)layer * D * DFF, (u16*)(w16 + W_W1), D, DFF, DFF, t, off, nb, smem);
  tjob(p.mlp_w2 + (size_t)layer * D * DFF, (u16*)(w16 + W_W2), DFF, D, D, t, off, nb, smem);
  if (layer == 0) {
    tjob(p.ab_w_in, (u16*)(w16 + W0_IN), D, AB_IN, AB_INP, t, off, nb, smem);
    tjob(p.ab_w_out, (u16*)(w16 + W0_OUT), D, D, D, t, off, nb, smem);
    tjob(p.s5_glu_w, (u16*)(w16 + W0_GLU), 1024, 1024, 1024, t, off, nb, smem);
    lora_w_job(p, (u16*)(w16 + W0_LORA), bid, nb);
  } else {
    tjob(p.cd_w_in, (u16*)(w16 + W1_IN), D, CD_IN, CD_INP, t, off, nb, smem);
    tjob(p.cd_w_out, (u16*)(w16 + W1_OUT), 3072, D, D, t, off, nb, smem);
  }
  __syncthreads();
}

DEVI void ph_mod(const Params& p, int bid, int nb, char* smem) {
  if (bid >= 384) return;
  float* cond = (float*)smem;
  float* red = cond + 5 * 2048;
  int tid = threadIdx.x;
  for (int i = tid; i < 5 * 2048; i += NTH) {
    int r = i >> 11, k = i & 2047;
    float c = r < 4 ? p.c[r * 2048 + k] : p.c_ctx[k];
    cond[i] = c / (1.f + expf(-c));
  }
  __syncthreads();
  int cgp = tid & 15, ks = tid >> 4, lane = tid & 63, wid = tid >> 6;
  float* MOD = (float*)(p.ws + OFF_MOD);
  for (int item = bid; item < 384; item += nb) {
    int l = item / 192, n0 = (item % 192) * 64;
    const float* W = p.ada_w + (size_t)l * 2048 * 12288 + n0 + cgp * 4;
    float acc[5][4];
#pragma unroll
    for (int r = 0; r < 5; ++r)
#pragma unroll
      for (int j = 0; j < 4; ++j) acc[r][j] = 0.f;
#pragma unroll 8
    for (int i = 0; i < 64; ++i) {
      int k = ks + 32 * i;
      float4 w = *(const float4*)(W + (size_t)k * 12288);
#pragma unroll
      for (int r = 0; r < 5; ++r) {
        float c = cond[r * 2048 + k];
        acc[r][0] += c * w.x; acc[r][1] += c * w.y; acc[r][2] += c * w.z; acc[r][3] += c * w.w;
      }
    }
#pragma unroll
    for (int r = 0; r < 5; ++r)
#pragma unroll
      for (int j = 0; j < 4; ++j) {
        float v = acc[r][j];
        v += __shfl_xor(v, 16);
        v += __shfl_xor(v, 32);
        acc[r][j] = v;
      }
    if (lane < 16) {
#pragma unroll
      for (int r = 0; r < 5; ++r)
#pragma unroll
        for (int j = 0; j < 4; ++j) red[(wid * 16 + cgp) * 20 + r * 4 + j] = acc[r][j];
    }
    __syncthreads();
    for (int o = tid; o < 320; o += NTH) {
      int r = o >> 6, col = o & 63;
      int ci = col >> 2, j = col & 3;
      float sacc = 0.f;
#pragma unroll
      for (int w = 0; w < 8; ++w) sacc += red[(w * 16 + ci) * 20 + r * 4 + j];
      MOD[(size_t)(l * 5 + r) * 12288 + n0 + col] = sacc + p.ada_b[l * 12288 + n0 + col];
    }
    __syncthreads();
  }
}

DEVI void ph_norm(const Params& p, int layer, int which, bool src_in, bool xonly, int bid, int nb) {
  int wid = threadIdx.x >> 6, lane = threadIdx.x & 63;
  const float* gam = (which == 0 ? p.norm1_g : p.norm2_g) + layer * D;
  u16* H = (u16*)(p.ws + OFF_H);
  int nrows = xonly ? NB * SEQ : T;
  for (int it = bid * NWV + wid; it < nrows; it += nb * NWV) {
    int row = xonly ? (it / SEQ) * LT + CL + (it % SEQ) : it;
    const float* src = src_in ? inrow_ptr(p, row) : xrow_ptr(p, row);
    const float* sh = mod_ptr(p, layer, row, which * 3 + 0);
    const float* sc = mod_ptr(p, layer, row, which * 3 + 1);
    float4 v[8];
    float ss = 0.f;
#pragma unroll
    for (int i = 0; i < 8; ++i) {
      v[i] = *(const float4*)(src + (i * 64 + lane) * 4);
      ss += v[i].x * v[i].x + v[i].y * v[i].y + v[i].z * v[i].z + v[i].w * v[i].w;
    }
    ss = wave_sum(ss);
    float rs = rsqrtf(ss * (1.f / D) + 1e-6f);
#pragma unroll
    for (int i = 0; i < 8; ++i) {
      int c = (i * 64 + lane) * 4;
      float4 g = *(const float4*)(gam + c);
      float4 s1 = *(const float4*)(sc + c);
      float4 s0 = *(const float4*)(sh + c);
      float a0 = v[i].x * rs * g.x * (1.f + s1.x) + s0.x;
      float a1 = v[i].y * rs * g.y * (1.f + s1.y) + s0.y;
      float a2 = v[i].z * rs * g.z * (1.f + s1.z) + s0.z;
      float a3 = v[i].w * rs * g.w * (1.f + s1.w) + s0.w;
      *(uint2*)(H + (size_t)row * D + c) = make_uint2(pack2(a0, a1), pack2(a2, a3));
    }
  }
}

#define LAS __attribute__((address_space(3)))
typedef unsigned u32x4 __attribute__((ext_vector_type(4)));
constexpr int BM = 256, BK = 64, HALF = 128, HTB = HALF * BK * 2, STAGE_BYTES = 8 * HTB, NXCD = 8, WGM = 8;
DEVI int lds_byte(int r, int c) {
  const int st = (r >> 4) * 2 + (c >> 5), rr = r & 15, cc = c & 31, ob = rr * 64 + cc * 2;
  return st * 1024 + (ob ^ (((ob >> 9) & 1) << 5));
}
DEVI void stage_rc(int b, int& R, int& C) {
  const int st = b / 1024, sb = b % 1024, swz = sb ^ (((sb >> 9) & 1) << 5);
  R = (st >> 1) * 16 + swz / 64;
  C = (st & 1) * 32 + (swz % 64) / 2;
}
DEVI int perm32(int rho) { const int n = rho >> 4, i = rho & 15; return 8 * (i >> 2) + 4 * n + (i & 3); }
struct Unit { int pm, pn; };
struct Gemm { const u16* A; const u16* Bt; int K; };
struct Order {
  int nM, nN, nwg, G, c, xonly;
  DEVI void init(int nM_, int nN_, int G_, int c_, int xonly_) { nM = nM_; nN = nN_; nwg = nM * nN; G = G_; c = c_; xonly = xonly_; }
  DEVI bool next(int i, Unit& u) const {
    const long L = (long)i * G + c;
    if (xonly == 2 && L >= nwg) {
      const int idx = (int)L - nwg;
      if (idx >= 64) return false;
      const int t = idx >> 2;
      u.pm = (idx & 3) * 17; u.pn = t < 13 ? 8 + t : 11 + t;
      return true;
    }
    if (L >= nwg) return false;
    int wgid = (int)L;
    { const int q = nwg / NXCD, r = nwg % NXCD, xcd = wgid % NXCD, off = wgid / NXCD; wgid = (xcd < r ? xcd * (q + 1) : r * (q + 1) + (xcd - r) * q) + off; }
    const int nig = WGM * nN, gid = wgid / nig, fm = gid * WGM, gsz = (nM - fm) < WGM ? (nM - fm) : WGM;
    int pm = fm + ((wgid % nig) % gsz);
    u.pn = (wgid % nig) / gsz;
    u.pm = xonly ? (pm >> 4) * 17 + 1 + (pm & 15) : pm;
    return true;
  }
};
DEVI bf16x8 mk_bf16x8(unsigned a, unsigned b, unsigned c, unsigned d) {
  u32x4 v = {a, b, c, d};
  return __builtin_bit_cast(bf16x8, v);
}
DEVI unsigned cvt_pk_bf16(float lo, float hi) { unsigned r; asm volatile("v_cvt_pk_bf16_f32 %0, %1, %2" : "=v"(r) : "v"(lo), "v"(hi)); return r; }

template <int ACT>
struct EpiBf16 {
  static constexpr bool PERM = true;
  u16* O; int ldc; int split_cols; size_t split_stride;
  DEVI void operator()(const f32x4 (&acc)[2][2][4][2], const Unit& u, int wr, int wc, int fr, int fq) const {
    const int row0 = u.pm * BM + wr * 64 + fr;
    int colt = u.pn * BM;
    u16* base = O;
    if (split_cols) { const int t = colt / split_cols; base += (size_t)t * split_stride; colt -= t * split_cols; }
    const int col0 = colt + wc * 32 + 8 * fq;
#pragma unroll
    for (int ai = 0; ai < 2; ++ai)
#pragma unroll
      for (int m = 0; m < 4; ++m) {
        u16* rowp = base + (size_t)(row0 + ai * HALF + m * 16) * ldc + col0;
#pragma unroll
        for (int bj = 0; bj < 2; ++bj) {
          f32x4 v0 = acc[ai][bj][m][0], v1 = acc[ai][bj][m][1];
          if (ACT == 1) {
#pragma unroll
            for (int j = 0; j < 4; ++j) { float a = fmaxf(v0[j], 0.f), b = fmaxf(v1[j], 0.f); v0[j] = a * a; v1[j] = b * b; }
          }
          u32x4 w;
          w.x = cvt_pk_bf16(v0[0], v0[1]); w.y = cvt_pk_bf16(v0[2], v0[3]); w.z = cvt_pk_bf16(v1[0], v1[1]); w.w = cvt_pk_bf16(v1[2], v1[3]);
          *(u32x4*)(rowp + bj * HALF) = w;
        }
      }
  }
};
struct EpiGlu {
  static constexpr bool PERM = true;
  const u16* YG; u16* CAT; const float* bias;
  DEVI void operator()(const f32x4 (&acc)[2][2][4][2], const Unit& u, int wr, int wc, int fr, int fq) const {
    const int row0 = u.pm * BM + wr * 64 + fr;
    const int col0 = u.pn * BM + wc * 32 + 8 * fq;
#pragma unroll
    for (int ai = 0; ai < 2; ++ai)
#pragma unroll
      for (int m = 0; m < 4; ++m) {
        const size_t row = (size_t)(row0 + ai * HALF + m * 16);
#pragma unroll
        for (int bj = 0; bj < 2; ++bj) {
          const int col = col0 + bj * HALF;
          u32x4 yv = *(const u32x4*)(YG + row * 1024 + col);
          f32x4 b0 = *(const f32x4*)(bias + col), b1 = *(const f32x4*)(bias + col + 4);
          f32x4 v0 = acc[ai][bj][m][0] + b0, v1 = acc[ai][bj][m][1] + b1;
          float y[8];
          unsigned yw[4] = {yv.x, yv.y, yv.z, yv.w};
#pragma unroll
          for (int j = 0; j < 4; ++j) { y[2 * j] = __uint_as_float(yw[j] << 16); y[2 * j + 1] = __uint_as_float(yw[j] & 0xFFFF0000u); }
          u32x4 w;
          w.x = cvt_pk_bf16(y[0] * sigmoidf(v0[0]), y[1] * sigmoidf(v0[1]));
          w.y = cvt_pk_bf16(y[2] * sigmoidf(v0[2]), y[3] * sigmoidf(v0[3]));
          w.z = cvt_pk_bf16(y[4] * sigmoidf(v1[0]), y[5] * sigmoidf(v1[1]));
          w.w = cvt_pk_bf16(y[6] * sigmoidf(v1[2]), y[7] * sigmoidf(v1[3]));
          *(u32x4*)(CAT + row * D + 1024 + col) = w;
        }
      }
  }
};
struct EpiResid {
  static constexpr bool PERM = false;
  Params p; int layer, gidx, from_in;
  DEVI void operator()(const f32x4 (&acc)[2][2][4][2], const Unit& u, int wr, int wc, int fr, int fq) const {
    const int row0 = u.pm * BM + wr * 64 + fr, col0 = u.pn * BM + wc * 32 + 4 * fq;
    const float* gate = mod_ptr(p, layer, row0, gidx);
    f32x4 gv[2][2];
#pragma unroll
    for (int bj = 0; bj < 2; ++bj)
#pragma unroll
      for (int n = 0; n < 2; ++n) gv[bj][n] = *(const f32x4*)(gate + col0 + bj * HALF + n * 16);
#pragma unroll
    for (int ai = 0; ai < 2; ++ai)
#pragma unroll
      for (int m = 0; m < 4; ++m) {
        const int row = row0 + ai * HALF + m * 16;
        float* dst = xrow_ptr(p, row) + col0;
        const float* src = from_in ? inrow_ptr(p, row) + col0 : dst;
#pragma unroll
        for (int bj = 0; bj < 2; ++bj)
#pragma unroll
          for (int n = 0; n < 2; ++n) {
            f32x4 sv = *(const f32x4*)(src + bj * HALF + n * 16);
            *(f32x4*)(dst + bj * HALF + n * 16) = sv + gv[bj][n] * acc[ai][bj][m][n];
          }
      }
  }
};

template <class Epi>
DEVI void gemm_phase(LAS unsigned char* lds, const Gemm g, const Order& S, const Epi& E) {
  const int tid = threadIdx.x, wid = __builtin_amdgcn_readfirstlane(tid >> 6), lane = tid & 63, wr = wid >> 2, wc = wid & 3, fr = lane & 15, fq = lane >> 4;
  const int K = g.K, nt = K / BK;
  unsigned voffA[2], voffB[2];
#pragma unroll
  for (int i = 0; i < 2; ++i) {
    int R, C;
    stage_rc(tid * 16 + i * 8192, R, C);
    const int Rb = Epi::PERM ? ((R & ~31) + perm32(R & 31)) : R;
    voffA[i] = (unsigned)(R * K + C) * 2u;
    voffB[i] = (unsigned)(Rb * K + C) * 2u;
  }
  const size_t kstep = (size_t)(BK * 2);
  const size_t hstep = (size_t)HALF * K * 2;
  const size_t tstep = 2 * hstep;
  const unsigned ldsw = (unsigned)wid * 1024u;
  const int aoff = lds_byte(wr * 64 + fr, fq * 8), boff = lds_byte(wc * 32 + fr, fq * 8);
#define PG8_SA(b, h) (((b) * 2 + (h)) * HTB)
#define PG8_SB(b, h) ((4 + (b) * 2 + (h)) * HTB)
#define PG8_STAGE(bufoff, gbase, voff) do { _Pragma("unroll") for (int _i = 0; _i < 2; ++_i) \
        __builtin_amdgcn_global_load_lds((const unsigned*)((const char*)(gbase) + (voff)[_i]), (LAS unsigned*)(lds + (bufoff) + ldsw + _i * 8192), 16, 0, 0); } while (0)
#define PG8_LDA(dst, b, h) do { _Pragma("unroll") for (int m = 0; m < 4; ++m) _Pragma("unroll") for (int k = 0; k < 2; ++k) dst[m][k] = *(const LAS bf16x8*)(lds + PG8_SA(b, h) + aoff + m * 2048 + k * 1024); } while (0)
#define PG8_LDB(dst, b, h) do { _Pragma("unroll") for (int n = 0; n < 2; ++n) _Pragma("unroll") for (int k = 0; k < 2; ++k) dst[n][k] = *(const LAS bf16x8*)(lds + PG8_SB(b, h) + boff + n * 2048 + k * 1024); } while (0)
#define PG8_MMA(ai, bj, At, Bt) do { __builtin_amdgcn_s_setprio(1); _Pragma("unroll") for (int m = 0; m < 4; ++m) _Pragma("unroll") for (int n = 0; n < 2; ++n) _Pragma("unroll") for (int k = 0; k < 2; ++k) \
        acc[ai][bj][m][n] = __builtin_amdgcn_mfma_f32_16x16x32_bf16(Bt[n][k], At[m][k], acc[ai][bj][m][n], 0, 0, 0); __builtin_amdgcn_s_setprio(0); } while (0)
#define PG8_WAIT_V(n) asm volatile("s_waitcnt vmcnt(" #n ")" ::: "memory")
#define PG8_WAIT_L(n) asm volatile("s_waitcnt lgkmcnt(" #n ")" ::: "memory")
#define PG8_BAR __builtin_amdgcn_s_barrier()
#define PG8_SCHED __builtin_amdgcn_sched_barrier(0)
  Unit cur, nxt;
  int ui = 0;
  if (!S.next(0, cur)) return;
  f32x4 acc[2][2][4][2];
#pragma unroll
  for (int a = 0; a < 2; ++a)
#pragma unroll
    for (int b = 0; b < 2; ++b)
#pragma unroll
      for (int m = 0; m < 4; ++m)
#pragma unroll
        for (int n = 0; n < 2; ++n) acc[a][b][m][n] = (f32x4){0.f, 0.f, 0.f, 0.f};
  bf16x8 At[4][2], B0[2][2], B1[2][2];
  const char* cA = (const char*)g.A + (size_t)cur.pm * tstep;
  const char* cB = (const char*)g.Bt + (size_t)cur.pn * tstep;
  PG8_STAGE(PG8_SB(0, 0), cB, voffB); PG8_STAGE(PG8_SA(0, 0), cA, voffA); PG8_STAGE(PG8_SB(0, 1), cB + hstep, voffB); PG8_STAGE(PG8_SA(0, 1), cA + hstep, voffA);
  if (wr == 1) PG8_BAR;
  PG8_WAIT_V(4); PG8_BAR;
  PG8_STAGE(PG8_SB(1, 0), cB + kstep, voffB); PG8_STAGE(PG8_SA(1, 0), cA + kstep, voffA); PG8_STAGE(PG8_SB(1, 1), cB + hstep + kstep, voffB);
  PG8_WAIT_V(6); PG8_BAR;
  for (;;) {
    const bool has_next = S.next(ui + 1, nxt);
    const char* nA = has_next ? (const char*)g.A + (size_t)nxt.pm * tstep : cA;
    const char* nB = has_next ? (const char*)g.Bt + (size_t)nxt.pn * tstep : cB;
    for (int t = 0; t < nt; t += 2) {
      const bool last = (t == nt - 2);
      const char* a1 = cA + (size_t)(t + 1) * kstep;
      const char* a2 = last ? nA : cA + (size_t)(t + 2) * kstep;
      const char* b2 = last ? nB : cB + (size_t)(t + 2) * kstep;
      const char* a3 = a2 + kstep;
      const char* b3 = b2 + kstep;
      PG8_LDB(B0, 0, 0); PG8_SCHED; PG8_LDA(At, 0, 0); PG8_STAGE(PG8_SA(1, 1), a1 + hstep, voffA);
      PG8_WAIT_L(8); PG8_BAR; PG8_WAIT_L(0); PG8_MMA(0, 0, At, B0); PG8_BAR; PG8_SCHED;
      PG8_LDB(B1, 0, 1); PG8_STAGE(PG8_SB(0, 0), b2, voffB);
      PG8_BAR; PG8_WAIT_L(0); PG8_MMA(0, 1, At, B1); PG8_BAR;
      PG8_LDA(At, 0, 1); PG8_STAGE(PG8_SA(0, 0), a2, voffA);
      PG8_BAR; PG8_WAIT_L(0); PG8_MMA(1, 0, At, B0); PG8_BAR; PG8_SCHED;
      PG8_STAGE(PG8_SB(0, 1), b2 + hstep, voffB);
      PG8_WAIT_V(6); PG8_BAR; PG8_MMA(1, 1, At, B1); PG8_BAR;
      PG8_LDB(B0, 1, 0); PG8_SCHED; PG8_LDA(At, 1, 0); PG8_STAGE(PG8_SA(0, 1), a2 + hstep, voffA);
      PG8_WAIT_L(8); PG8_BAR; PG8_WAIT_L(0); PG8_MMA(0, 0, At, B0); PG8_BAR; PG8_SCHED;
      PG8_LDB(B1, 1, 1); PG8_STAGE(PG8_SB(1, 0), b3, voffB);
      PG8_BAR; PG8_WAIT_L(0); PG8_MMA(0, 1, At, B1); PG8_BAR;
      PG8_LDA(At, 1, 1); PG8_STAGE(PG8_SA(1, 0), a3, voffA);
      PG8_BAR; PG8_WAIT_L(0); PG8_MMA(1, 0, At, B0); PG8_BAR; PG8_SCHED;
      PG8_STAGE(PG8_SB(1, 1), b3 + hstep, voffB);
      PG8_WAIT_V(6); PG8_BAR; PG8_MMA(1, 1, At, B1); PG8_BAR;
    }
    E(acc, cur, wr, wc, fr, fq);
    if (!has_next) break;
#pragma unroll
    for (int a = 0; a < 2; ++a)
#pragma unroll
      for (int b = 0; b < 2; ++b)
#pragma unroll
        for (int m = 0; m < 4; ++m)
#pragma unroll
          for (int n = 0; n < 2; ++n) acc[a][b][m][n] = (f32x4){0.f, 0.f, 0.f, 0.f};
    cur = nxt; cA = nA; cB = nB; ++ui;
  }
  PG8_WAIT_V(0);
  if (wr == 0) PG8_BAR;
  PG8_BAR;
#undef PG8_SA
#undef PG8_SB
#undef PG8_STAGE
#undef PG8_LDA
#undef PG8_LDB
#undef PG8_MMA
#undef PG8_WAIT_V
#undef PG8_WAIT_L
#undef PG8_BAR
#undef PG8_SCHED
}

struct S5C {
  float ab_re, ab_im;
  float bb_re[16], bb_im[16];
};
DEVI void s5_consts(const Params& p, int d, int g, int n, S5C& c) {
  int ix = (d * 64 + g) * 64 + n;
  float lam = fminf(p.s5_A_re[ix], -1e-4f), aim = p.s5_A_im[ix];
  float dt = expf(p.s5_log_dt[d * 64 + g]);
  float mag = expf(lam * dt), sn, cs;
  sincosf(aim * dt, &sn, &cs);
  c.ab_re = mag * cs;
  c.ab_im = mag * sn;
  float den = lam * lam + aim * aim;
  float f_re = ((c.ab_re - 1.f) * lam + c.ab_im * aim) / den;
  float f_im = (c.ab_im * lam - (c.ab_re - 1.f) * aim) / den;
  const float4* br = (const float4*)(p.s5_B_re + (size_t)ix * 16);
  const float4* bi = (const float4*)(p.s5_B_im + (size_t)ix * 16);
#pragma unroll
  for (int q = 0; q < 4; ++q) {
    float4 r = br[q], i = bi[q];
    c.bb_re[q * 4 + 0] = f_re * r.x - f_im * i.x; c.bb_im[q * 4 + 0] = f_re * i.x + f_im * r.x;
    c.bb_re[q * 4 + 1] = f_re * r.y - f_im * i.y; c.bb_im[q * 4 + 1] = f_re * i.y + f_im * r.y;
    c.bb_re[q * 4 + 2] = f_re * r.z - f_im * i.z; c.bb_im[q * 4 + 2] = f_re * i.z + f_im * r.z;
    c.bb_re[q * 4 + 3] = f_re * r.w - f_im * i.w; c.bb_im[q * 4 + 3] = f_re * i.w + f_im * r.w;
  }
}
DEVI void load_u16x16(const u16* ptr, float* u) {
  uint4 a = *(const uint4*)ptr, b = *(const uint4*)(ptr + 8);
  unsigned w[8] = {a.x, a.y, a.z, a.w, b.x, b.y, b.z, b.w};
#pragma unroll
  for (int i = 0; i < 8; ++i) {
    u[2 * i] = __uint_as_float(w[i] << 16);
    u[2 * i + 1] = __uint_as_float(w[i] & 0xFFFF0000u);
  }
}
DEVI int s5_cu(int d, int q) { return d == 0 ? q : (q < 4 ? 3 - q : 71 - q); }
DEVI int s5_q(int d, int cu) { return d == 0 ? cu : (cu < 4 ? 3 - cu : 71 - cu); }

DEVI void ph_s5_pass1(const Params& p, int gw, int nw, char* smem) {
  int lane = threadIdx.x & 63;
  u16* Us = (u16*)smem + (threadIdx.x >> 6) * 1024;
  const u16* P = (const u16*)(p.ws + OFF_BIG + B0_P);
  float* E = (float*)(p.ws + OFF_S5E);
  for (int task = gw; task < NB * 64 * 2 * 68; task += nw) {
    int q = task % 68, d = (task / 68) & 1, g = (task / 136) & 63, b = task / (136 * 64);
    S5C c;
    s5_consts(p, d, g, lane, c);
    int cu = s5_cu(d, q);
    {
      const u16* up = P + (size_t)(b * LT + cu * 64 + lane) * AB_INP + RCOLS + g * 16;
      uint4 u0 = *(const uint4*)up, u1 = *(const uint4*)(up + 8);
      wave_lds_fence();
      *(uint4*)(Us + lane * 16) = u0;
      *(uint4*)(Us + lane * 16 + 8) = u1;
      wave_lds_fence();
    }
    float hr = 0.f, hi = 0.f;
    for (int i = 0; i < 64; ++i) {
      int tl = d == 0 ? i : 63 - i;
      float u[16];
      load_u16x16(Us + tl * 16, u);
      float br = 0.f, bi = 0.f;
#pragma unroll
      for (int k = 0; k < 16; ++k) { br += c.bb_re[k] * u[k]; bi += c.bb_im[k] * u[k]; }
      float nr = c.ab_re * hr - c.ab_im * hi + br;
      float ni = c.ab_re * hi + c.ab_im * hr + bi;
      hr = nr; hi = ni;
    }
    size_t ei = ((((size_t)(b * 64 + g) * 2 + d) * 68 + q) * 64 + lane) * 2;
    *(float2*)(E + ei) = make_float2(hr, hi);
  }
}

DEVI void ph_s5_prefix(const Params& p, int gw, int nw) {
  const int lane = threadIdx.x & 63;
  float* E = (float*)(p.ws + OFF_S5E);
  for (int task = gw; task < NB * 64 * 2; task += nw) {
    const int d = task & 1, g = (task >> 1) & 63, b = task >> 7;
    const int ix = (d * 64 + g) * 64 + lane;
    const float lam = fminf(p.s5_A_re[ix], -1e-4f), aim = p.s5_A_im[ix];
    const float dt = expf(p.s5_log_dt[d * 64 + g]);
    const float mag = expf(lam * dt);
    float sn, cs;
    sincosf(aim * dt, &sn, &cs);
    float qr = mag * cs, qi = mag * sn;
#pragma unroll
    for (int sq = 0; sq < 6; ++sq) { float t0 = qr * qr - qi * qi, t1 = 2.f * qr * qi; qr = t0; qi = t1; }
    float* Eb = E + (((size_t)(b * 64 + g) * 2 + d) * 68) * 128 + lane * 2;
    float sr = 0.f, si = 0.f;
#pragma unroll 4
    for (int q = 0; q < 68; ++q) {
      float2 e = *(const float2*)(Eb + (size_t)q * 128);
      *(float2*)(Eb + (size_t)q * 128) = make_float2(sr, si);
      float nr = qr * sr - qi * si + e.x, ni = qr * si + qi * sr + e.y;
      sr = nr; si = ni;
    }
  }
}

DEVI void ph_s5_pass2(const Params& p, int gw, int nw, char* smem) {
  typedef float f32x2 __attribute__((ext_vector_type(2)));
  const int lane = threadIdx.x & 63, wid = threadIdx.x >> 6;
  constexpr int HP = 130;
  float* Hs = (float*)smem + wid * (16 * HP + 512);
  u16* Us = (u16*)(Hs + 16 * HP);
  const u16* P = (const u16*)(p.ws + OFF_BIG + B0_P);
  const float* E = (const float*)(p.ws + OFF_S5E);
  u16* YG = (u16*)(p.ws + OFF_BIG + B0_YG);
  const int mi = lane & 15, mk = lane >> 4;
  for (int task = gw; task < NB * 64 * 68; task += nw) {
    const int cu = task % 68, g = (task / 68) & 63, b = task / (68 * 64);
    f32x4 Y[4];
#pragma unroll
    for (int q = 0; q < 4; ++q) Y[q] = (f32x4){0.f, 0.f, 0.f, 0.f};
    {
      const u16* up = P + (size_t)(b * LT + cu * 64 + lane) * AB_INP + RCOLS + g * 16;
      uint4 u0 = *(const uint4*)up, u1 = *(const uint4*)(up + 8);
      wave_lds_fence();
      *(uint4*)(Us + lane * 16) = u0;
      *(uint4*)(Us + lane * 16 + 8) = u1;
      wave_lds_fence();
    }
    for (int d = 0; d < 2; ++d) {
      S5C c;
      s5_consts(p, d, g, lane, c);
      float cm[32];
#pragma unroll
      for (int kk = 0; kk < 32; ++kk) {
        int k = 4 * kk + mk, n = k >> 1;
        size_t ci = ((size_t)(d * 64 + g) * 16 + mi) * 64 + n;
        cm[kk] = (k & 1) ? -p.s5_C_im[ci] : p.s5_C_re[ci];
      }
      const int q = s5_q(d, cu);
      const float2 e0 = *(const float2*)(E + ((((size_t)(b * 64 + g) * 2 + d) * 68 + q) * 64 + lane) * 2);
      float hr = e0.x, hi = e0.y;
      for (int sb = 0; sb < 4; ++sb) {
        const int blk = d == 0 ? sb : 3 - sb;
        for (int i = 0; i < 16; ++i) {
          const int tl = d == 0 ? i : 15 - i;
          float u[16];
          load_u16x16(Us + (blk * 16 + tl) * 16, u);
          f32x2 bu = (f32x2){0.f, 0.f};
#pragma unroll
          for (int k = 0; k < 16; ++k) bu += (f32x2){c.bb_re[k], c.bb_im[k]} * u[k];
          float nr = c.ab_re * hr - c.ab_im * hi + bu.x;
          float ni = c.ab_re * hi + c.ab_im * hr + bu.y;
          hr = nr; hi = ni;
          *(float2*)(Hs + tl * HP + 2 * lane) = make_float2(hr, hi);
        }
        wave_lds_fence();
        f32x4 acc = Y[blk];
#pragma unroll
        for (int kk = 0; kk < 32; ++kk) {
          float a = Hs[mi * HP + 4 * kk + mk];
          acc = __builtin_amdgcn_mfma_f32_16x16x4f32(a, cm[kk], acc, 0, 0, 0);
        }
        Y[blk] = acc;
        wave_lds_fence();
      }
    }
    const float dsk = p.s5_D[g * 16 + mi];
#pragma unroll
    for (int blk = 0; blk < 4; ++blk)
#pragma unroll
      for (int r = 0; r < 4; ++r) {
        const int row = b * LT + cu * 64 + blk * 16 + 4 * mk + r;
        float uu = bf2f(Us[(blk * 16 + 4 * mk + r) * 16 + mi]);
        float y0 = Y[blk][r] + dsk * uu;
        y0 = 0.5f * y0 * (1.f + tanhf(0.7978845608f * (y0 + 0.044715f * y0 * y0 * y0)));
        YG[(size_t)row * 1024 + g * 16 + mi] = f2bf(y0);
      }
  }
}

DEVI void ph_lora_in(const Params& p, int bid, int nb) {
  const u16* P = (const u16*)(p.ws + OFF_BIG + B0_P);
  u16* LIN = (u16*)(p.ws + OFF_BIG + B0_LIN);
  const size_t total = (size_t)T * 256;
  for (size_t it = (size_t)bid * NTH + threadIdx.x; it < total; it += (size_t)nb * NTH) {
    int row = (int)(it >> 8), jp = (int)(it & 255);
    if (jp >= 224) { *(unsigned*)(LIN + (size_t)row * 512 + jp * 2) = 0u; continue; }
    int pos = row % LT;
    bool first = (pos == 0 || pos == CL), last = (pos == CL - 1 || pos == LT - 1);
    int col = 3072 + jp * 2;
    unsigned cu = *(const unsigned*)(P + (size_t)row * AB_INP + col);
    unsigned pv = first ? 0u : *(const unsigned*)(P + (size_t)(row - 1) * AB_INP + col);
    unsigned nx = last ? 0u : *(const unsigned*)(P + (size_t)(row + 1) * AB_INP + col);
    float o[2];
#pragma unroll
    for (int e = 0; e < 2; ++e) {
      float c = e ? __uint_as_float(cu & 0xFFFF0000u) : __uint_as_float(cu << 16);
      float pr = e ? __uint_as_float(pv & 0xFFFF0000u) : __uint_as_float(pv << 16);
      float nn = e ? __uint_as_float(nx & 0xFFFF0000u) : __uint_as_float(nx << 16);
      float m0 = p.rwkv_mu[col + e], m1 = p.rwkv_mu[RCOLS + col + e];
      float s = c + m0 * (pr - c) + m1 * (nn - c);
      int j = jp * 2 + e;
      o[e] = j < 96 ? tanhf(s) : (j < 192 ? s : sigmoidf(s));
    }
    *(unsigned*)(LIN + (size_t)row * 512 + jp * 2) = pack2(o[0], o[1]);
  }
}

DEVI void ph_rwkv_scan(const Params& p, int blk, char* smem) {
  const int d = blk & 1, h = (blk >> 1) & 15, b = blk >> 5;
  const int tid = threadIdx.x, wid = __builtin_amdgcn_readfirstlane(tid >> 6), lane = tid & 63;
  constexpr int NCH = LT / 8;
  constexpr int BW = 6 * 8 * 64;
  float* bufs = (float*)smem;
  float* ybuf = bufs + 2 * BW;
  const u16* P = (const u16*)(p.ws + OFF_BIG + B0_P);
  const u16* WL = (const u16*)(p.ws + OFF_BIG + B0_WL) + (size_t)d * T * 1024;
  const u16* AL = (const u16*)(p.ws + OFF_BIG + B0_AL) + (size_t)d * T * 1024;
  u16* YR = (u16*)(p.ws + OFF_BIG + B0_YR) + (size_t)d * T * 1024;
  float* RK = (float*)(p.ws + OFF_RK) + (size_t)d * T * 16;
  if (wid >= 4) {
    const int sw = wid - 4;
    const int c = h * 64 + lane;
    const float mr0 = p.rwkv_mu[c], mr1 = p.rwkv_mu[RCOLS + c];
    const float mk0 = p.rwkv_mu[1024 + c], mk1 = p.rwkv_mu[RCOLS + 1024 + c];
    const float mv0 = p.rwkv_mu[2048 + c], mv1 = p.rwkv_mu[RCOLS + 2048 + c];
    const float w0 = p.rwkv_w0[d * 1024 + c], a0 = p.rwkv_a0[d * 1024 + c];
    const float kkc = p.rwkv_k_k[c], kac = p.rwkv_k_a[c], rkc = p.rwkv_r_k[c];
    u16 R0[2][11], R1[2][11], R2[2][11], R3[2][11];
    auto load_raw = [&](int ch, u16 (&raw)[2][11]) {
      ch = ch < NCH ? ch : NCH - 1;
#pragma unroll
      for (int i = 0; i < 2; ++i) {
        int pos = dirpos(d, ch * 8 + sw * 2 + i);
        int row = b * LT + pos;
        bool first = (pos == 0 || pos == CL), last = (pos == CL - 1 || pos == LT - 1);
        const u16* pr = P + (size_t)row * AB_INP + c;
        const u16* pp = first ? pr : pr - AB_INP;
        const u16* pn = last ? pr : pr + AB_INP;
#pragma unroll
        for (int s3 = 0; s3 < 3; ++s3) {
          raw[i][s3 * 3 + 0] = pr[s3 * 1024];
          raw[i][s3 * 3 + 1] = pp[s3 * 1024];
          raw[i][s3 * 3 + 2] = pn[s3 * 1024];
        }
        raw[i][9] = WL[(size_t)row * 1024 + c];
        raw[i][10] = AL[(size_t)row * 1024 + c];
      }
    };
    auto process = [&](int ch, const u16 (&raw)[2][11], float* buf) {
      ch = ch < NCH ? ch : NCH - 1;
#pragma unroll
      for (int i = 0; i < 2; ++i) {
        int tt = sw * 2 + i;
        int pos = dirpos(d, ch * 8 + tt);
        int row = b * LT + pos;
        float fm = (pos == 0 || pos == CL) ? 0.f : 1.f, lm = (pos == CL - 1 || pos == LT - 1) ? 0.f : 1.f;
        float rc = bf2f(raw[i][0]), rp = bf2f(raw[i][1]) * fm, rn = bf2f(raw[i][2]) * lm;
        float kc = bf2f(raw[i][3]), kp = bf2f(raw[i][4]) * fm, kn = bf2f(raw[i][5]) * lm;
        float vc = bf2f(raw[i][6]), vp = bf2f(raw[i][7]) * fm, vn = bf2f(raw[i][8]) * lm;
        float r = rc + mr0 * (rp - rc) + mr1 * (rn - rc);
        float k = kc + mk0 * (kp - kc) + mk1 * (kn - kc);
        float v = vc + mv0 * (vp - vc) + mv1 * (vn - vc);
        float kkraw = k * kkc;
        float nrm = sqrtf(wave_sum(kkraw * kkraw));
        float kk = kkraw / fmaxf(nrm, 1e-12f);
        float z = w0 + bf2f(raw[i][9]);
        float sg = 1.f / (1.f + expf(-z));
        float decay = expf(-0.60653065971f * sg);
        float a = 1.f / (1.f + expf(-(a0 + bf2f(raw[i][10]))));
        float kd = k * (1.f + (a - 1.f) * kac);
        float rk = wave_sum(r * kd * rkc);
        if (lane == 0) RK[(size_t)row * 16 + h] = rk;
        buf[(0 * 8 + tt) * 64 + lane] = r;
        buf[(1 * 8 + tt) * 64 + lane] = decay;
        buf[(2 * 8 + tt) * 64 + lane] = kd;
        buf[(3 * 8 + tt) * 64 + lane] = kk;
        buf[(4 * 8 + tt) * 64 + lane] = kk * a;
        buf[(5 * 8 + tt) * 64 + lane] = v;
      }
    };
    auto bulk = [&](int ch) {
#pragma unroll
      for (int i = 0; i < 2; ++i) {
        const int tt = sw * 2 + i;
        const float4* yp = (const float4*)(ybuf + ((((ch & 1) * 8 + tt) * 32 + (lane >> 1)) * 8) * 2);
        float4 q0 = yp[0], q1 = yp[1], q2 = yp[2], q3 = yp[3];
        float ya = (q0.x + q0.z) + (q1.x + q1.z) + (q2.x + q2.z) + (q3.x + q3.z);
        float yb = (q0.y + q0.w) + (q1.y + q1.w) + (q2.y + q2.w) + (q3.y + q3.w);
        int row = b * LT + dirpos(d, ch * 8 + tt);
        YR[(size_t)row * 1024 + h * 64 + lane] = f2bf((lane & 1) ? yb : ya);
      }
    };
    load_raw(0, R0);
    process(0, R0, bufs);
    load_raw(1, R1);
    load_raw(2, R2);
    load_raw(3, R3);
    load_raw(4, R0);
    lds_barrier();
    for (int ch = 0; ch < NCH; ch += 4) {
      if (ch > 0) bulk(ch - 1);
      process(ch + 1, R1, bufs + BW);
      load_raw(ch + 5, R1);
      lds_barrier();
      bulk(ch);
      process(ch + 2, R2, bufs);
      load_raw(ch + 6, R2);
      lds_barrier();
      bulk(ch + 1);
      process(ch + 3, R3, bufs + BW);
      load_raw(ch + 7, R3);
      lds_barrier();
      bulk(ch + 2);
      process(ch + 4, R0, bufs);
      load_raw(ch + 8, R0);
      lds_barrier();
    }
    lds_barrier();
    bulk(NCH - 1);
  } else {
    const int rp = tid >> 3, ks = tid & 7;
    float S[16];
#pragma unroll
    for (int i = 0; i < 16; ++i) S[i] = 0.f;
    lds_barrier();
    for (int ch = 0; ch < NCH; ++ch) {
      const float* buf = bufs + (ch & 1) * BW;
      struct Ops { float4 r4[2], w4[2], kd4[2], kk4[2], bb4[2]; float2 vv; };
      auto fetch = [&](Ops& o, int tt) {
        const float* bs = buf + tt * 64 + ks * 8;
#pragma unroll
        for (int i = 0; i < 2; ++i) {
          o.r4[i] = *(const float4*)(bs + 0 * 512 + i * 4);
          o.w4[i] = *(const float4*)(bs + 1 * 512 + i * 4);
          o.kd4[i] = *(const float4*)(bs + 2 * 512 + i * 4);
          o.kk4[i] = *(const float4*)(bs + 3 * 512 + i * 4);
          o.bb4[i] = *(const float4*)(bs + 4 * 512 + i * 4);
        }
        o.vv = *(const float2*)(buf + 5 * 512 + tt * 64 + rp * 2);
      };
      auto compute = [&](const Ops& o, int tt) {
        float dotA = 0.f, dotB = 0.f;
#pragma unroll
        for (int i = 0; i < 2; ++i) {
          dotA = fmaf(S[i * 4 + 0], o.kk4[i].x, dotA); dotA = fmaf(S[i * 4 + 1], o.kk4[i].y, dotA);
          dotA = fmaf(S[i * 4 + 2], o.kk4[i].z, dotA); dotA = fmaf(S[i * 4 + 3], o.kk4[i].w, dotA);
          dotB = fmaf(S[8 + i * 4 + 0], o.kk4[i].x, dotB); dotB = fmaf(S[8 + i * 4 + 1], o.kk4[i].y, dotB);
          dotB = fmaf(S[8 + i * 4 + 2], o.kk4[i].z, dotB); dotB = fmaf(S[8 + i * 4 + 3], o.kk4[i].w, dotB);
        }
        dotA = sum8(dotA);
        dotB = sum8(dotB);
        float yA = 0.f, yB = 0.f;
#pragma unroll
        for (int i = 0; i < 2; ++i) {
          S[i * 4 + 0] = S[i * 4 + 0] * o.w4[i].x + (o.vv.x * o.kd4[i].x - dotA * o.bb4[i].x);
          S[i * 4 + 1] = S[i * 4 + 1] * o.w4[i].y + (o.vv.x * o.kd4[i].y - dotA * o.bb4[i].y);
          S[i * 4 + 2] = S[i * 4 + 2] * o.w4[i].z + (o.vv.x * o.kd4[i].z - dotA * o.bb4[i].z);
          S[i * 4 + 3] = S[i * 4 + 3] * o.w4[i].w + (o.vv.x * o.kd4[i].w - dotA * o.bb4[i].w);
          S[8 + i * 4 + 0] = S[8 + i * 4 + 0] * o.w4[i].x + (o.vv.y * o.kd4[i].x - dotB * o.bb4[i].x);
          S[8 + i * 4 + 1] = S[8 + i * 4 + 1] * o.w4[i].y + (o.vv.y * o.kd4[i].y - dotB * o.bb4[i].y);
          S[8 + i * 4 + 2] = S[8 + i * 4 + 2] * o.w4[i].z + (o.vv.y * o.kd4[i].z - dotB * o.bb4[i].z);
          S[8 + i * 4 + 3] = S[8 + i * 4 + 3] * o.w4[i].w + (o.vv.y * o.kd4[i].w - dotB * o.bb4[i].w);
          yA = fmaf(S[i * 4 + 0], o.r4[i].x, yA); yA = fmaf(S[i * 4 + 1], o.r4[i].y, yA);
          yA = fmaf(S[i * 4 + 2], o.r4[i].z, yA); yA = fmaf(S[i * 4 + 3], o.r4[i].w, yA);
          yB = fmaf(S[8 + i * 4 + 0], o.r4[i].x, yB); yB = fmaf(S[8 + i * 4 + 1], o.r4[i].y, yB);
          yB = fmaf(S[8 + i * 4 + 2], o.r4[i].z, yB); yB = fmaf(S[8 + i * 4 + 3], o.r4[i].w, yB);
        }
        *(float2*)(ybuf + ((((ch & 1) * 8 + tt) * 32 + rp) * 8 + ks) * 2) = make_float2(yA, yB);
      };
      Ops o0, o1;
      fetch(o0, 0);
#pragma unroll 2
      for (int tt = 0; tt < 8; tt += 2) {
        fetch(o1, tt + 1);
        compute(o0, tt);
        fetch(o0, tt + 2 < 8 ? tt + 2 : 7);
        compute(o1, tt + 1);
      }
      lds_barrier();
    }
    lds_barrier();
  }
  lds_barrier();
}

DEVI void unpack8(uint4 v, float* f) {
  unsigned w[4] = {v.x, v.y, v.z, v.w};
#pragma unroll
  for (int i = 0; i < 4; ++i) { f[2 * i] = __uint_as_float(w[i] << 16); f[2 * i + 1] = __uint_as_float(w[i] & 0xFFFF0000u); }
}
DEVI void ph_rwkv_post(const Params& p, int gw, int nw) {
  const int lane = threadIdx.x & 63;
  const u16* P = (const u16*)(p.ws + OFF_BIG + B0_P);
  const u16* YR = (const u16*)(p.ws + OFF_BIG + B0_YR);
  const u16* G = (const u16*)(p.ws + OFF_BIG + B0_G);
  const float* RK = (const float*)(p.ws + OFF_RK);
  u16* CAT = (u16*)(p.ws + OFF_H);
  const int c0 = lane * 16, h = lane >> 2;
  for (int row = gw; row < T; row += nw) {
    int pos = row % LT;
    bool first = (pos == 0 || pos == CL), last = (pos == CL - 1 || pos == LT - 1);
    const u16* y0p = YR + (size_t)row * 1024 + c0;
    const u16* y1p = YR + (size_t)(T + row) * 1024 + c0;
    const u16* vp = P + (size_t)row * AB_INP + 2048 + c0;
    const u16* vpp = first ? vp : vp - AB_INP;
    const u16* vnp = last ? vp : vp + AB_INP;
    const u16* gp = G + (size_t)row * 1024 + c0;
    uint4 ra[2], rb[2], rv[2], rvp[2], rvn[2], rg[2];
#pragma unroll
    for (int i = 0; i < 2; ++i) {
      ra[i] = *(const uint4*)(y0p + i * 8); rb[i] = *(const uint4*)(y1p + i * 8);
      rv[i] = *(const uint4*)(vp + i * 8); rvp[i] = *(const uint4*)(vpp + i * 8); rvn[i] = *(const uint4*)(vnp + i * 8);
      rg[i] = *(const uint4*)(gp + i * 8);
    }
    const float rk = RK[(size_t)row * 16 + h] + RK[(size_t)(T + row) * 16 + h];
    const float fm = first ? 0.f : 1.f, lm = last ? 0.f : 1.f;
    float y[16], s1 = 0.f;
#pragma unroll
    for (int i = 0; i < 2; ++i) {
      float a[8], bq[8];
      unpack8(ra[i], a); unpack8(rb[i], bq);
#pragma unroll
      for (int e = 0; e < 8; ++e) { y[i * 8 + e] = a[e] + bq[e]; s1 += y[i * 8 + e]; }
    }
    s1 += dpp_xor1(s1); s1 += dpp_xor2(s1);
    const float mean = s1 * (1.f / 64.f);
    float s2 = 0.f;
#pragma unroll
    for (int e = 0; e < 16; ++e) { y[e] -= mean; s2 += y[e] * y[e]; }
    s2 += dpp_xor1(s2); s2 += dpp_xor2(s2);
    const float rs = rsqrtf(s2 * (1.f / 64.f) + 64e-5f);
#pragma unroll
    for (int i = 0; i < 2; ++i) {
      float vc[8], vq[8], vn[8], gg[8];
      unpack8(rv[i], vc); unpack8(rvp[i], vq); unpack8(rvn[i], vn); unpack8(rg[i], gg);
      unsigned o[4];
      const int cb = c0 + i * 8;
      float m0[8], m1[8], lg[8], lb[8];
      *(float4*)m0 = *(const float4*)(p.rwkv_mu + 2048 + cb); *(float4*)(m0 + 4) = *(const float4*)(p.rwkv_mu + 2048 + cb + 4);
      *(float4*)m1 = *(const float4*)(p.rwkv_mu + RCOLS + 2048 + cb); *(float4*)(m1 + 4) = *(const float4*)(p.rwkv_mu + RCOLS + 2048 + cb + 4);
      *(float4*)lg = *(const float4*)(p.rwkv_ln_g + cb); *(float4*)(lg + 4) = *(const float4*)(p.rwkv_ln_g + cb + 4);
      *(float4*)lb = *(const float4*)(p.rwkv_ln_b + cb); *(float4*)(lb + 4) = *(const float4*)(p.rwkv_ln_b + cb + 4);
#pragma unroll
      for (int e2 = 0; e2 < 4; ++e2) {
        float r2[2];
#pragma unroll
        for (int q = 0; q < 2; ++q) {
          int e = e2 * 2 + q;
          float v = vc[e] + m0[e] * (vq[e] * fm - vc[e]) + m1[e] * (vn[e] * lm - vc[e]);
          r2[q] = (y[i * 8 + e] * rs * lg[e] + lb[e] + rk * v) * gg[e];
        }
        o[e2] = pack2(r2[0], r2[1]);
      }
      *(uint4*)(CAT + (size_t)row * D + c0 + i * 8) = make_uint4(o[0], o[1], o[2], o[3]);
    }
  }
}

DEVI void ph_cd_prep(const Params& p, int bid, int nb, char* smem) {
  u16* P = (u16*)(p.ws + OFF_BIG + B1_P);
  u16* XBC = (u16*)(p.ws + OFF_BIG + B1_XBC);
  float* DT = (float*)(p.ws + OFF_DT);
  const size_t gtid = (size_t)bid * NTH + threadIdx.x, gstride = (size_t)nb * NTH;
  float2* tab = (float2*)smem;
  for (int i = threadIdx.x; i < 64 * 16; i += NTH) {
    int v = i >> 4, f = i & 15;
    float inv = exp2f(-(float)f * (13.287712379549449f / 16.f));
    float sn, cs;
    sincosf((float)v * inv, &sn, &cs);
    tab[i] = make_float2(cs, sn);
  }
  __syncthreads();
  for (size_t it = gtid; it < (size_t)T * 384; it += gstride) {
    int row = (int)(it / 384), c = (int)(it % 384) * 8;
    int pos = row % LT;
    int lo = pos < CL ? 0 : CL, hi = pos < CL ? CL : LT;
    float acc[8];
    {
      float4 b0 = *(const float4*)(p.ssd_conv_b + c), b1 = *(const float4*)(p.ssd_conv_b + c + 4);
      acc[0] = b0.x; acc[1] = b0.y; acc[2] = b0.z; acc[3] = b0.w; acc[4] = b1.x; acc[5] = b1.y; acc[6] = b1.z; acc[7] = b1.w;
    }
    uint4 xv[5];
#pragma unroll
    for (int j = 0; j < 5; ++j) {
      int pp = pos + j - 2;
      bool ok = (pp >= lo && pp < hi);
      xv[j] = *(const uint4*)(P + (size_t)(ok ? row + j - 2 : row) * CD_INP + 2048 + c);
    }
#pragma unroll
    for (int j = 0; j < 5; ++j) {
      int pp = pos + j - 2;
      float m = (pp >= lo && pp < hi) ? 1.f : 0.f;
      float x[8];
      unpack8(xv[j], x);
      float4 w0 = *(const float4*)(p.ssd_conv_w + j * 3072 + c), w1 = *(const float4*)(p.ssd_conv_w + j * 3072 + c + 4);
      acc[0] += m * w0.x * x[0]; acc[1] += m * w0.y * x[1]; acc[2] += m * w0.z * x[2]; acc[3] += m * w0.w * x[3];
      acc[4] += m * w1.x * x[4]; acc[5] += m * w1.y * x[5]; acc[6] += m * w1.z * x[6]; acc[7] += m * w1.w * x[7];
    }
    unsigned o[4];
#pragma unroll
    for (int e = 0; e < 4; ++e) {
      float a0 = acc[2 * e], a1 = acc[2 * e + 1];
      o[e] = pack2(a0 * sigmoidf(a0), a1 * sigmoidf(a1));
    }
    *(uint4*)(XBC + (size_t)row * 3072 + c) = make_uint4(o[0], o[1], o[2], o[3]);
  }
  for (size_t it = gtid; it < (size_t)T * 64; it += gstride) {
    int row = (int)(it >> 6), dh = (int)(it & 63);
    float x = bf2f(P[(size_t)row * CD_INP + 5120 + dh]) + p.ssd_dt_bias[dh];
    float sp = x > 20.f ? x : log1pf(expf(x));
    DT[((size_t)(dh >> 5) * T + row) * 32 + (dh & 31)] = sp;
  }
  for (size_t it = gtid; it < (size_t)NB * SEQ * 40; it += gstride) {
    int a = (int)(it & 1), hh = (int)((it >> 1) % 20);
    int tok = (int)(it / 40);
    int b = tok / SEQ, xp = tok % SEQ;
    int row = b * LT + CL + xp;
    int colbase = (hh < 16 ? 5184 + hh * 64 : 6208 + (hh - 16) * 64) + a * 32;
    const float2* tb = tab + (a == 0 ? (xp >> 6) : (xp & 63)) * 16;
    u16* q1 = P + (size_t)row * CD_INP + colbase;
    uint4 l0 = *(const uint4*)q1, l1 = *(const uint4*)(q1 + 8), h0 = *(const uint4*)(q1 + 16), h1 = *(const uint4*)(q1 + 24);
    float x1[16], x2[16];
    unpack8(l0, x1); unpack8(l1, x1 + 8); unpack8(h0, x2); unpack8(h1, x2 + 8);
    unsigned o1[8], o2[8];
#pragma unroll
    for (int e = 0; e < 8; ++e) {
      float2 t0 = tb[2 * e], t1 = tb[2 * e + 1];
      o1[e] = pack2(x1[2 * e] * t0.x - x2[2 * e] * t0.y, x1[2 * e + 1] * t1.x - x2[2 * e + 1] * t1.y);
      o2[e] = pack2(x1[2 * e] * t0.y + x2[2 * e] * t0.x, x1[2 * e + 1] * t1.y + x2[2 * e + 1] * t1.x);
    }
    *(uint4*)q1 = make_uint4(o1[0], o1[1], o1[2], o1[3]);
    *(uint4*)(q1 + 8) = make_uint4(o1[4], o1[5], o1[6], o1[7]);
    *(uint4*)(q1 + 16) = make_uint4(o2[0], o2[1], o2[2], o2[3]);
    *(uint4*)(q1 + 24) = make_uint4(o2[4], o2[5], o2[6], o2[7]);
  }
}

DEVI void ph_ssd_scan(const Params& p, int blk, char* smem) {
  const int d = blk & 1, h = (blk >> 1) & 31, b = blk >> 6;
  const int g = h >> 3;
  const int tid = threadIdx.x, wid = __builtin_amdgcn_readfirstlane(tid >> 6), lane = tid & 63, fr = lane & 15, fq = lane >> 4;
  const int lt = wid & 3, ph = wid >> 2;
  const int spt = wid & 3, snt0 = (wid >> 2) * 4;
  u16* Cs = (u16*)smem;
  u16* Bs = Cs + 64 * 136;
  u16* BTs = Bs + 64 * 136;
  u16* XT0 = BTs + 128 * 72;
  u16* XT1 = XT0 + 64 * 72;
  u16* Hb = XT1 + 64 * 72;
  float* cumt = (float*)(Hb + 64 * 136);
  const u16* XBC = (const u16*)(p.ws + OFF_BIG + B1_XBC);
  const float* DT = (const float*)(p.ws + OFF_DT) + (size_t)d * T * 32;
  u16* Y = d == 0 ? (u16*)(p.ws + OFF_H) : (u16*)(p.ws + OFF_BIG + B1_YB);
  const float A = -expf(p.ssd_A_log[d * 32 + h]);
  for (int i = tid; i < 64 * 136; i += NTH) Hb[i] = 0;
  f32x4 hst[4];
#pragma unroll
  for (int i = 0; i < 4; ++i) hst[i] = (f32x4){0.f, 0.f, 0.f, 0.f};
  const int ss = tid >> 3, sg = tid & 7;
  uint4 rB0, rB1, rC0, rC1, rX;
  float rdt;
  auto load_raw = [&](int ch) {
    int row = b * LT + dirpos(d, ch * 64 + ss);
    const u16* base = XBC + (size_t)row * 3072;
    rB0 = *(const uint4*)(base + 2048 + g * 128 + sg * 16);
    rB1 = *(const uint4*)(base + 2048 + g * 128 + sg * 16 + 8);
    rC0 = *(const uint4*)(base + 2560 + g * 128 + sg * 16);
    rC1 = *(const uint4*)(base + 2560 + g * 128 + sg * 16 + 8);
    rX = *(const uint4*)(base + h * 64 + sg * 8);
    int rowl = b * LT + dirpos(d, ch * 64 + lane);
    rdt = DT[(size_t)rowl * 32 + h];
  };
  constexpr int NCH = LT / 64;
  load_raw(0);
  for (int ch = 0; ch < NCH; ++ch) {
    float cum = rdt * A;
#pragma unroll
    for (int off = 1; off < 64; off <<= 1) {
      float t = __shfl_up(cum, off);
      if (lane >= off) cum += t;
    }
    const float cum63 = __shfl(cum, 63);
    const float my_cum = __shfl(cum, ss), my_dt = __shfl(rdt, ss);
    __syncthreads();
    {
      *(uint4*)(Bs + ss * 136 + sg * 16) = rB0;
      *(uint4*)(Bs + ss * 136 + sg * 16 + 8) = rB1;
      *(uint4*)(Cs + ss * 136 + sg * 16) = rC0;
      *(uint4*)(Cs + ss * 136 + sg * 16 + 8) = rC1;
      unsigned wb[8] = {rB0.x, rB0.y, rB0.z, rB0.w, rB1.x, rB1.y, rB1.z, rB1.w};
#pragma unroll
      for (int e = 0; e < 8; ++e) {
        BTs[(sg * 16 + 2 * e) * 72 + ss] = (u16)(wb[e] & 0xFFFFu);
        BTs[(sg * 16 + 2 * e + 1) * 72 + ss] = (u16)(wb[e] >> 16);
      }
      unsigned wx[4] = {rX.x, rX.y, rX.z, rX.w};
      const float s0 = my_dt, s1 = my_dt * __expf(cum63 - my_cum);
#pragma unroll
      for (int e = 0; e < 4; ++e) {
        float x0 = __uint_as_float(wx[e] << 16), x1 = __uint_as_float(wx[e] & 0xFFFF0000u);
        XT0[(sg * 8 + 2 * e) * 72 + ss] = f2bf(x0 * s0);
        XT0[(sg * 8 + 2 * e + 1) * 72 + ss] = f2bf(x1 * s0);
        XT1[(sg * 8 + 2 * e) * 72 + ss] = f2bf(x0 * s1);
        XT1[(sg * 8 + 2 * e + 1) * 72 + ss] = f2bf(x1 * s1);
      }
      if (wid == 0) cumt[lane] = cum;
#pragma unroll
      for (int i = 0; i < 4; ++i)
#pragma unroll
        for (int j = 0; j < 4; ++j) Hb[(spt * 16 + fq * 4 + j) * 136 + (snt0 + i) * 16 + fr] = f2bf(hst[i][j]);
    }
    __syncthreads();
    load_raw(ch + 1 < NCH ? ch + 1 : ch);
    if (ch >= CL / 64) {
      bf16x8 cf[4];
#pragma unroll
      for (int kn = 0; kn < 4; ++kn) cf[kn] = *(const bf16x8*)(Cs + (lt * 16 + fr) * 136 + kn * 32 + fq * 8);
      const float cl = cumt[lt * 16 + fr];
      float pv[4][4];
#pragma unroll
      for (int st = 0; st < 4; ++st) {
        if (st <= lt) {
          f32x4 acc = (f32x4){0.f, 0.f, 0.f, 0.f};
#pragma unroll
          for (int kn = 0; kn < 4; ++kn) {
            bf16x8 a = *(const bf16x8*)(Bs + (st * 16 + fr) * 136 + kn * 32 + fq * 8);
            acc = __builtin_amdgcn_mfma_f32_16x16x32_bf16(a, cf[kn], acc, 0, 0, 0);
          }
          const float4 cs4 = *(const float4*)(cumt + st * 16 + fq * 4);
          const float csv[4] = {cs4.x, cs4.y, cs4.z, cs4.w};
#pragma unroll
          for (int j = 0; j < 4; ++j) {
            const int sidx = st * 16 + fq * 4 + j, lidx = lt * 16 + fr;
            float w = acc[j] * __expf(fminf(cl - csv[j], 0.f));
            pv[st][j] = (sidx <= lidx) ? w : 0.f;
          }
        } else {
#pragma unroll
          for (int j = 0; j < 4; ++j) pv[st][j] = 0.f;
        }
      }
      bf16x8 pb[2];
#pragma unroll
      for (int ks = 0; ks < 2; ++ks) {
        pb[ks] = mk_bf16x8(pack2(pv[ks * 2][0], pv[ks * 2][1]), pack2(pv[ks * 2][2], pv[ks * 2][3]),
                           pack2(pv[ks * 2 + 1][0], pv[ks * 2 + 1][1]), pack2(pv[ks * 2 + 1][2], pv[ks * 2 + 1][3]));
      }
      const float ecl = __expf(cl);
      const int orow = b * LT + dirpos(d, ch * 64 + lt * 16 + fr);
#pragma unroll
      for (int pi = 0; pi < 2; ++pi) {
        const int pt = ph * 2 + pi;
        f32x4 ya = (f32x4){0.f, 0.f, 0.f, 0.f};
#pragma unroll
        for (int kn = 0; kn < 4; ++kn) {
          bf16x8 a = *(const bf16x8*)(Hb + (pt * 16 + fr) * 136 + kn * 32 + fq * 8);
          ya = __builtin_amdgcn_mfma_f32_16x16x32_bf16(a, cf[kn], ya, 0, 0, 0);
        }
        ya *= ecl;
#pragma unroll
        for (int ks = 0; ks < 2; ++ks) {
          if (ks * 2 <= lt) {
            const u16* xp = XT0 + (pt * 16 + fr) * 72 + ks * 32 + fq * 4;
            uint2 lo = *(const uint2*)xp, hi = *(const uint2*)(xp + 16);
            ya = __builtin_amdgcn_mfma_f32_16x16x32_bf16(mk_bf16x8(lo.x, lo.y, hi.x, hi.y), pb[ks], ya, 0, 0, 0);
          }
        }
        *(uint2*)(Y + (size_t)orow * 2048 + h * 64 + pt * 16 + fq * 4) = make_uint2(pack2(ya[0], ya[1]), pack2(ya[2], ya[3]));
      }
    }
    {
      const float e63 = __expf(cum63);
      bf16x8 xa[2];
#pragma unroll
      for (int ks = 0; ks < 2; ++ks) xa[ks] = *(const bf16x8*)(XT1 + (spt * 16 + fr) * 72 + ks * 32 + fq * 8);
#pragma unroll
      for (int i = 0; i < 4; ++i) {
        f32x4 acc = hst[i] * e63;
#pragma unroll
        for (int ks = 0; ks < 2; ++ks) {
          bf16x8 bq = *(const bf16x8*)(BTs + ((snt0 + i) * 16 + fr) * 72 + ks * 32 + fq * 8);
          acc = __builtin_amdgcn_mfma_f32_16x16x32_bf16(xa[ks], bq, acc, 0, 0, 0);
        }
        hst[i] = acc;
      }
    }
  }
  __syncthreads();
}

DEVI void ph_attn(const Params& p, int first_blk, int nblk, char* smem) {
  const int tid = threadIdx.x, wid = tid >> 6, lane = tid & 63;
  const int fr = lane & 15, fq = lane >> 4;
  const int hr = wid & 3, qsub = wid >> 2;
  u16* Ks = (u16*)smem;
  u16* VTs = Ks + 64 * 72;
  const u16* P = (const u16*)(p.ws + OFF_BIG + B1_P);
  u16* CAT = (u16*)(p.ws + OFF_BIG + B1_CAT);
  for (int task = first_blk; task < NB * 4 * 64; task += nblk) {
    const int qt = task & 63, hkv = (task >> 6) & 3, b = task >> 8;
    const int hq = hkv * 4 + hr;
    const int q0 = qt * 64;
    const int qw0 = q0 + qsub * 32;
    bf16x8 qf[2][2];
#pragma unroll
    for (int nt = 0; nt < 2; ++nt) {
      const u16* qp = P + (size_t)(b * LT + CL + qw0 + nt * 16 + fr) * CD_INP + 5184 + hq * 64 + fq * 8;
#pragma unroll
      for (int ks = 0; ks < 2; ++ks) {
        uint4 v = *(const uint4*)(qp + ks * 32);
        unsigned w[4] = {v.x, v.y, v.z, v.w};
        unsigned o[4];
#pragma unroll
        for (int e = 0; e < 4; ++e)
          o[e] = pack2(__uint_as_float(w[e] << 16) * 0.125f, __uint_as_float(w[e] & 0xFFFF0000u) * 0.125f);
        qf[nt][ks] = mk_bf16x8(o[0], o[1], o[2], o[3]);
      }
    }
    f32x4 O[4][2];
#pragma unroll
    for (int dt = 0; dt < 4; ++dt)
#pragma unroll
      for (int nt = 0; nt < 2; ++nt) O[dt][nt] = (f32x4){0.f, 0.f, 0.f, 0.f};
    float mrun[2], lrun[2];
    const float sink = p.attn_sink[hq];
#pragma unroll
    for (int nt = 0; nt < 2; ++nt) { mrun[nt] = sink; lrun[nt] = fq == 0 ? 1.f : 0.f; }
    const int kb0 = max(0, q0 - 128), kb1 = min(SEQ, q0 + 64 + 128);
    const int nband = (kb1 - kb0) >> 6;
    for (int tile = 0; tile < 4 + nband; ++tile) {
      const bool isctx = tile < 4;
      const int kbase = isctx ? tile * 64 : kb0 + (tile - 4) * 64;
      const int krow0 = b * LT + (isctx ? kbase : CL + kbase);
      __syncthreads();
      {
        int key = tid >> 3, seg = tid & 7;
        uint4 kv = *(const uint4*)(P + (size_t)(krow0 + key) * CD_INP + 6208 + hkv * 64 + seg * 8);
        *(uint4*)(Ks + key * 72 + seg * 8) = kv;
        int key2 = tid & 63, seg2 = tid >> 6;
        uint4 vv = *(const uint4*)(P + (size_t)(krow0 + key2) * CD_INP + 6464 + hkv * 64 + seg2 * 8);
        unsigned w[4] = {vv.x, vv.y, vv.z, vv.w};
#pragma unroll
        for (int e = 0; e < 4; ++e) {
          VTs[(seg2 * 8 + 2 * e) * 72 + key2] = (u16)(w[e] & 0xFFFFu);
          VTs[(seg2 * 8 + 2 * e + 1) * 72 + key2] = (u16)(w[e] >> 16);
        }
      }
      __syncthreads();
      f32x4 ST[4][2];
#pragma unroll
      for (int mt = 0; mt < 4; ++mt) {
        bf16x8 a0 = *(const bf16x8*)(Ks + (mt * 16 + fr) * 72 + fq * 8);
        bf16x8 a1 = *(const bf16x8*)(Ks + (mt * 16 + fr) * 72 + 32 + fq * 8);
#pragma unroll
        for (int nt = 0; nt < 2; ++nt) {
          f32x4 z = (f32x4){0.f, 0.f, 0.f, 0.f};
          z = __builtin_amdgcn_mfma_f32_16x16x32_bf16(a0, qf[nt][0], z, 0, 0, 0);
          ST[mt][nt] = __builtin_amdgcn_mfma_f32_16x16x32_bf16(a1, qf[nt][1], z, 0, 0, 0);
        }
      }
      if (!isctx) {
#pragma unroll
        for (int mt = 0; mt < 4; ++mt)
#pragma unroll
          for (int nt = 0; nt < 2; ++nt)
#pragma unroll
            for (int j = 0; j < 4; ++j) {
              int dlt = (qw0 + nt * 16 + fr) - (kbase + mt * 16 + fq * 4 + j);
              if (dlt > 128 || dlt < -128) ST[mt][nt][j] = -INFINITY;
            }
      }
      bf16x8 pb[2][2];
#pragma unroll
      for (int nt = 0; nt < 2; ++nt) {
        float mx = -INFINITY;
#pragma unroll
        for (int mt = 0; mt < 4; ++mt)
#pragma unroll
          for (int j = 0; j < 4; ++j) mx = fmaxf(mx, ST[mt][nt][j]);
        mx = fmaxf(mx, __shfl_xor(mx, 16));
        mx = fmaxf(mx, __shfl_xor(mx, 32));
        float mn = fmaxf(mrun[nt], mx);
        float alpha = __expf(mrun[nt] - mn);
        mrun[nt] = mn;
        float ls = 0.f;
        float pv[4][4];
#pragma unroll
        for (int mt = 0; mt < 4; ++mt)
#pragma unroll
          for (int j = 0; j < 4; ++j) { pv[mt][j] = __expf(ST[mt][nt][j] - mn); ls += pv[mt][j]; }
        lrun[nt] = lrun[nt] * alpha + ls;
#pragma unroll
        for (int dt = 0; dt < 4; ++dt) O[dt][nt] *= alpha;
#pragma unroll
        for (int ks = 0; ks < 2; ++ks) {
          pb[nt][ks] = mk_bf16x8(pack2(pv[ks * 2][0], pv[ks * 2][1]), pack2(pv[ks * 2][2], pv[ks * 2][3]),
                                 pack2(pv[ks * 2 + 1][0], pv[ks * 2 + 1][1]), pack2(pv[ks * 2 + 1][2], pv[ks * 2 + 1][3]));
        }
      }
#pragma unroll
      for (int dt = 0; dt < 4; ++dt)
#pragma unroll
        for (int ks = 0; ks < 2; ++ks) {
          const u16* vp = VTs + (dt * 16 + fr) * 72 + ks * 32 + fq * 4;
          uint2 lo = *(const uint2*)vp, hi = *(const uint2*)(vp + 16);
          bf16x8 a = mk_bf16x8(lo.x, lo.y, hi.x, hi.y);
#pragma unroll
          for (int nt = 0; nt < 2; ++nt) O[dt][nt] = __builtin_amdgcn_mfma_f32_16x16x32_bf16(a, pb[nt][ks], O[dt][nt], 0, 0, 0);
        }
    }
#pragma unroll
    for (int nt = 0; nt < 2; ++nt) {
      float l = lrun[nt];
      l += __shfl_xor(l, 16);
      l += __shfl_xor(l, 32);
      float inv = 1.f / l;
      u16* op = CAT + (size_t)(b * LT + CL + qw0 + nt * 16 + fr) * 3072 + 2048 + hq * 64 + fq * 4;
#pragma unroll
      for (int dt = 0; dt < 4; ++dt)
        *(uint2*)(op + dt * 16) = make_uint2(cvt_pk_bf16(O[dt][nt][0] * inv, O[dt][nt][1] * inv), cvt_pk_bf16(O[dt][nt][2] * inv, O[dt][nt][3] * inv));
    }
  }
}

DEVI void ph_ssd_combine(const Params& p, int gw, int nw) {
  int lane = threadIdx.x & 63;
  const u16* P = (const u16*)(p.ws + OFF_BIG + B1_P);
  const u16* XBC = (const u16*)(p.ws + OFF_BIG + B1_XBC);
  const u16* YF = (const u16*)(p.ws + OFF_H);
  const u16* YB = (const u16*)(p.ws + OFF_BIG + B1_YB);
  u16* CAT = (u16*)(p.ws + OFF_BIG + B1_CAT);
  for (int it = gw; it < NB * SEQ * 4; it += nw) {
    int grp = it & 3, tok = it >> 2;
    int row = (tok / SEQ) * LT + CL + (tok % SEQ);
    int ch = grp * 512 + lane * 8;
    float dsk = p.ssd_D[ch >> 6];
    uint4 yf = *(const uint4*)(YF + (size_t)row * 2048 + ch), yb = *(const uint4*)(YB + (size_t)row * 2048 + ch);
    uint4 xv = *(const uint4*)(XBC + (size_t)row * 3072 + ch), zv = *(const uint4*)(P + (size_t)row * CD_INP + ch);
    unsigned a[4] = {yf.x, yf.y, yf.z, yf.w}, bq[4] = {yb.x, yb.y, yb.z, yb.w}, xq[4] = {xv.x, xv.y, xv.z, xv.w},
             zq[4] = {zv.x, zv.y, zv.z, zv.w};
    float y[8];
    float ss = 0.f;
#pragma unroll
    for (int i = 0; i < 4; ++i) {
#pragma unroll
      for (int e = 0; e < 2; ++e) {
        float f = e ? __uint_as_float(a[i] & 0xFFFF0000u) : __uint_as_float(a[i] << 16);
        float bb = e ? __uint_as_float(bq[i] & 0xFFFF0000u) : __uint_as_float(bq[i] << 16);
        float xx = e ? __uint_as_float(xq[i] & 0xFFFF0000u) : __uint_as_float(xq[i] << 16);
        float zz = e ? __uint_as_float(zq[i] & 0xFFFF0000u) : __uint_as_float(zq[i] << 16);
        float v = (f + bb + dsk * xx) * (zz * sigmoidf(zz));
        y[i * 2 + e] = v;
        ss += v * v;
      }
    }
    ss = wave_sum(ss);
    float sc = rsqrtf(ss * (1.f / 512.f) + 1e-6f);
    float4 g0 = *(const float4*)(p.ssd_norm_g + ch), g1 = *(const float4*)(p.ssd_norm_g + ch + 4);
    *(uint4*)(CAT + (size_t)row * 3072 + ch) =
        make_uint4(pack2(y[0] * sc * g0.x, y[1] * sc * g0.y), pack2(y[2] * sc * g0.z, y[3] * sc * g0.w),
                   pack2(y[4] * sc * g1.x, y[5] * sc * g1.y), pack2(y[6] * sc * g1.z, y[7] * sc * g1.w));
  }
}

DEVI void ph_final(const Params& p, int gw, int nw) {
  int lane = threadIdx.x & 63;
  for (int it = gw; it < NB * SEQ; it += nw) {
    float* row = p.out + (size_t)it * D;
    float4 v[8];
    float ss = 0.f;
#pragma unroll
    for (int i = 0; i < 8; ++i) {
      v[i] = *(const float4*)(row + (i * 64 + lane) * 4);
      ss += v[i].x * v[i].x + v[i].y * v[i].y + v[i].z * v[i].z + v[i].w * v[i].w;
    }
    ss = wave_sum(ss);
    float rs = rsqrtf(ss * (1.f / D) + 1e-6f);
#pragma unroll
    for (int i = 0; i < 8; ++i) {
      int c = (i * 64 + lane) * 4;
      float4 g = *(const float4*)(p.final_g + c);
      *(float4*)(row + c) = make_float4(v[i].x * rs * g.x, v[i].y * rs * g.y, v[i].z * rs * g.z, v[i].w * rs * g.w);
    }
  }
}

#include <vector>

#define XB_TMO      128
#define XB_XCNT(j)  (256  + 64 * (j))
#define XB_XSUB(j)  (1280 + 64 * (j))
#define XB_XGEN(j)  (2304 + 64 * (j))
#define XB_TOP      3328
#define XB_TOPGEN   3392
#define XCD_BAR_WORDS 3456
#define XB_SPIN_CAP (1u << 21)

__device__ __forceinline__ unsigned xb_ld(unsigned* p)              { return __hip_atomic_load(p, __ATOMIC_RELAXED, __HIP_MEMORY_SCOPE_AGENT); }
__device__ __forceinline__ unsigned xb_add(unsigned* p, unsigned v) { return __hip_atomic_fetch_add(p, v, __ATOMIC_RELAXED, __HIP_MEMORY_SCOPE_AGENT); }
__device__ __forceinline__ unsigned xb_xcc_id() { return (unsigned)__builtin_amdgcn_s_getreg((3 << 11) | 20) & 0xFu; }
#define XB_SPIN(cond, bar) do { unsigned _sp = 0; while (cond) { __builtin_amdgcn_s_sleep(1); \
    if ((++_sp & 255u) == 0u) { if (xb_ld(&(bar)[XB_TMO])) break; if (_sp > XB_SPIN_CAP) { atomicAdd(&(bar)[XB_TMO], 1u); break; } } } } while (0)

struct XcdBarrier {
    unsigned* bar; unsigned x;
    volatile LAS unsigned* st;
};

__device__ __forceinline__ XcdBarrier xcd_barrier_post(unsigned* bar, volatile LAS unsigned* st) {
    XcdBarrier b; b.bar = bar; b.x = xb_xcc_id(); b.st = st;
    if (threadIdx.x == 0) (void)xb_add(&bar[XB_XCNT(b.x)], 1u);
    return b;
}
__device__ __forceinline__ void xcd_barrier_complete(unsigned* bar, unsigned x, unsigned& nloc, unsigned& nx) {
    const unsigned G = gridDim.x * gridDim.y * gridDim.z;
    unsigned sum, cnt, mine, sp = 0u;
    for (;;) {
        sum = 0u; cnt = 0u; mine = 0u;
#pragma unroll
        for (unsigned j = 0; j < 16; ++j) { const unsigned c = xb_ld(&bar[XB_XCNT(j)]); sum += c; cnt += (c > 0u) ? 1u : 0u; mine = (j == x) ? c : mine; }
        if (sum == G) break;
        __builtin_amdgcn_s_sleep(1);
        if ((++sp & 255u) == 0u) { if (xb_ld(&bar[XB_TMO])) break; if (sp > XB_SPIN_CAP) { atomicAdd(&bar[XB_TMO], 1u); break; } }
    }
    nloc = mine > 0u ? mine : 1u; nx = cnt > 0u ? cnt : 1u;
}

__device__ __forceinline__ void xcd_barrier(const XcdBarrier& b) {
    asm volatile("s_waitcnt vmcnt(0)" ::: "memory");
    __syncthreads();
    if (threadIdx.x == 0) {
        unsigned* bar = b.bar;
        __builtin_amdgcn_s_waitcnt(0);
        unsigned nloc = b.st[0], nx = b.st[1];
        if (nloc == 0u) { xcd_barrier_complete(bar, b.x, nloc, nx); b.st[0] = nloc; b.st[1] = nx; }
        const unsigned old = xb_add(&bar[XB_XSUB(b.x)], 1u);
        const unsigned gen = old / nloc;
        if (old + 1u == (gen + 1u) * nloc) {
            __builtin_amdgcn_fence(__ATOMIC_RELEASE, "agent");
            asm volatile("s_waitcnt vmcnt(0)" ::: "memory");
            const unsigned og = xb_add(&bar[XB_TOP], 1u);
            const unsigned tg = og / nx;
            if (og + 1u == (tg + 1u) * nx) xb_add(&bar[XB_TOPGEN], 1u);
            else XB_SPIN(xb_ld(&bar[XB_TOPGEN]) == tg, bar);
            __builtin_amdgcn_fence(__ATOMIC_ACQUIRE, "agent");
            xb_add(&bar[XB_XGEN(b.x)], 1u);
            asm volatile("s_waitcnt vmcnt(0)" ::: "memory");
        } else {
            XB_SPIN(xb_ld(&bar[XB_XGEN(b.x)]) == gen, bar);
            __builtin_amdgcn_fence(__ATOMIC_ACQUIRE, "agent");
            asm volatile("s_waitcnt vmcnt(0)" ::: "memory");
        }
    }
    __syncthreads();
}


#ifndef REPEAT_MASK
#define REPEAT_MASK 0
#endif
#ifndef PROBE_K
#define PROBE_K -1
#define PROBE_ID 0
#endif
constexpr int NPH = 21;
constexpr int SMEM_BYTES = STAGE_BYTES + 16;

template <class Epi>
DEVI void run_gemm(const Params& p, LAS unsigned char* lds, const u16* A, const u16* Bt, int K, int nN, int xonly, int bid, int nb,
                   const Epi& E) {
  Order S;
  S.init(xonly ? 64 : 68, nN, nb, bid, xonly);
  Gemm g{A, Bt, K};
  gemm_phase(lds, g, S, E);
}

DEVI void run_phase(const Params& p, int ph, int bid, int nb, char* smem, LAS unsigned char* lds) {
  char* ws = p.ws;
  u16* H = (u16*)(ws + OFF_H);
  const int gw = bid * NWV + (threadIdx.x >> 6), nw = nb * NWV;
#ifdef ONLY_PHASE
  ph = ONLY_PHASE;
#endif
  switch (ph) {
    case 0:
      ph_mod(p, bid, nb, smem);
      __syncthreads();
      ph_convert(p, 0, bid, nb, smem);
      break;
    case 1: ph_norm(p, 0, 0, true, false, bid, nb); break;
    case 2:
      run_gemm(p, lds, H, (const u16*)(ws + OFF_W16 + W0_IN), D, AB_INP / 256, 0, bid, nb,
               EpiBf16<0>{(u16*)(ws + OFF_BIG + B0_P), AB_INP, 0, 0});
      break;
    case 3:
      ph_lora_in(p, bid, nb);
      ph_s5_pass1(p, gw, nw, smem);
      break;
    case 4:
      ph_s5_prefix(p, gw, nw);
      run_gemm(p, lds, (const u16*)(ws + OFF_BIG + B0_LIN), (const u16*)(ws + OFF_W16 + W0_LORA), 512, 20, 0, bid, nb,
               EpiBf16<0>{(u16*)(ws + OFF_BIG + B0_WL), 1024, 1024, (size_t)T * 1024});
      break;
    case 5:
      if (bid < 128) ph_rwkv_scan(p, bid, smem);
      else ph_s5_pass2(p, (bid - 128) * NWV + (threadIdx.x >> 6), (nb - 128) * NWV, smem);
      break;
    case 6:
      ph_rwkv_post(p, gw, nw);
      run_gemm(p, lds, (const u16*)(ws + OFF_BIG + B0_YG), (const u16*)(ws + OFF_W16 + W0_GLU), 1024, 4, 0, bid, nb,
               EpiGlu{(const u16*)(ws + OFF_BIG + B0_YG), H, p.s5_glu_b});
      break;
    case 7:
      run_gemm(p, lds, H, (const u16*)(ws + OFF_W16 + W0_OUT), D, 8, 0, bid, nb, EpiResid{p, 0, 2, 1});
      break;
    case 8: ph_norm(p, 0, 1, false, false, bid, nb); break;
    case 9:
      run_gemm(p, lds, H, (const u16*)(ws + OFF_W16 + W_W1), D, 32, 0, bid, nb, EpiBf16<1>{(u16*)(ws + OFF_BIG), DFF, 0, 0});
      break;
    case 10:
      run_gemm(p, lds, (const u16*)(ws + OFF_BIG), (const u16*)(ws + OFF_W16 + W_W2), DFF, 8, 0, bid, nb, EpiResid{p, 0, 5, 0});
      break;
    case 11:
      ph_convert(p, 1, bid, nb, smem);
      ph_norm(p, 1, 0, false, false, bid, nb);
      break;
    case 12:
      run_gemm(p, lds, H, (const u16*)(ws + OFF_W16 + W1_IN), D, CD_INP / 256, 2, bid, nb,
               EpiBf16<0>{(u16*)(ws + OFF_BIG + B1_P), CD_INP, 0, 0});
      break;
    case 13: ph_cd_prep(p, bid, nb, smem); break;
    case 14:
      ph_ssd_scan(p, bid, smem);
      __syncthreads();
      ph_attn(p, bid, nb, smem);
      break;
    case 15: ph_ssd_combine(p, gw, nw); break;
    case 16:
      run_gemm(p, lds, (const u16*)(ws + OFF_BIG + B1_CAT), (const u16*)(ws + OFF_W16 + W1_OUT), 3072, 8, 1, bid, nb,
               EpiResid{p, 1, 2, 0});
      break;
    case 17: ph_norm(p, 1, 1, false, true, bid, nb); break;
    case 18:
      run_gemm(p, lds, H, (const u16*)(ws + OFF_W16 + W_W1), D, 32, 1, bid, nb, EpiBf16<1>{(u16*)(ws + OFF_BIG), DFF, 0, 0});
      break;
    case 19:
      run_gemm(p, lds, (const u16*)(ws + OFF_BIG), (const u16*)(ws + OFF_W16 + W_W2), DFF, 8, 1, bid, nb, EpiResid{p, 1, 5, 0});
      break;
    case 20: ph_final(p, gw, nw); break;
    case 105:
      if (bid >= 128) ph_s5_pass2(p, (bid - 128) * NWV + (threadIdx.x >> 6), (nb - 128) * NWV, smem);
      break;
    case 205:
      if (bid < 128) ph_rwkv_scan(p, bid, smem);
      break;
    case 114: ph_ssd_scan(p, bid, smem); break;
    case 214: ph_attn(p, bid, nb, smem); break;
    default: break;
  }
}

__global__ void __launch_bounds__(512, 2) fwd_megakernel(Params p) {
  extern __shared__ __attribute__((aligned(16))) unsigned char shm[];
  char* smem = (char*)shm;
  LAS unsigned char* lds = (LAS unsigned char*)shm;
  cg::grid_group grid = cg::this_grid();
  volatile LAS unsigned* bst = (volatile LAS unsigned*)(lds + STAGE_BYTES);
  if (threadIdx.x < 4) bst[threadIdx.x] = 0u;
  __syncthreads();
  const XcdBarrier xb = xcd_barrier_post((unsigned*)(p.ws + OFF_BAR), bst);
#define GSYNC(k) do { if ((k) == 0) grid.sync(); else xcd_barrier(xb); } while (0)
#define PHASE(k)                                                    \
  if (p.ph_lo <= (k) && (k) < p.ph_hi) {                            \
    run_phase(p, (k), blockIdx.x, gridDim.x, smem, lds);            \
    if ((REPEAT_MASK >> (k)) & 1) {                                 \
      GSYNC(k);                                                     \
      run_phase(p, (k), blockIdx.x, gridDim.x, smem, lds);          \
    }                                                               \
    if ((k) == PROBE_K) {                                           \
      GSYNC(k);                                                     \
      run_phase(p, PROBE_ID, blockIdx.x, gridDim.x, smem, lds);     \
    }                                                               \
    if ((k) + 1 < p.ph_hi) GSYNC(k);                                \
  }
  PHASE(0) PHASE(1) PHASE(2) PHASE(3) PHASE(4) PHASE(5) PHASE(6) PHASE(7) PHASE(8) PHASE(9) PHASE(10)
  PHASE(11) PHASE(12) PHASE(13) PHASE(14) PHASE(15) PHASE(16) PHASE(17) PHASE(18) PHASE(19) PHASE(20)
#undef PHASE
}

#ifndef SINGLE_LAUNCH
#define SINGLE_LAUNCH 1
#endif

extern "C" void kernel_launch(void* const* d_in, const int* in_sizes, int n_in, void* d_out, int out_size, void* d_ws,
                              size_t ws_size, hipStream_t stream) {
  if (ws_size < WS_NEEDED) {
    fprintf(stderr, "workspace too small: %zu < %zu\n", ws_size, (size_t)WS_NEEDED);
    return;
  }
  Params p{};
  const float** fp = (const float**)&p;
  for (int i = 0; i < 43; ++i) fp[i] = (const float*)d_in[i];
  p.out = (float*)d_out;
  p.ws = (char*)d_ws;
  static int grid_blocks = 0;
  if (!grid_blocks) {
    int dev = 0, cus = 0, per_cu = 0;
    hipGetDevice(&dev);
    hipDeviceGetAttribute(&cus, hipDeviceAttributeMultiprocessorCount, dev);
    hipFuncSetAttribute((const void*)fwd_megakernel, hipFuncAttributeMaxDynamicSharedMemorySize, SMEM_BYTES);
    hipOccupancyMaxActiveBlocksPerMultiprocessor(&per_cu, fwd_megakernel, NTH, SMEM_BYTES);
    if (per_cu > 1) per_cu = 1;
    grid_blocks = cus * per_cu;
  }
  hipMemsetAsync((char*)d_ws + OFF_BAR, 0, BAR_BYTES, stream);
#if SINGLE_LAUNCH
  p.ph_lo = 0;
  p.ph_hi = NPH;
  void* args[] = {&p};
  hipError_t e = hipLaunchCooperativeKernel((void*)fwd_megakernel, dim3(grid_blocks), dim3(NTH), args, SMEM_BYTES, stream);
  if (e != hipSuccess) fprintf(stderr, "cooperative launch failed: %s (grid %d)\n", hipGetErrorString(e), grid_blocks);
#else
  for (int ph = 0; ph < NPH; ++ph) {
    p.ph_lo = ph;
    p.ph_hi = ph + 1;
    fwd_megakernel<<<256, NTH, SMEM_BYTES, stream>>>(p);
  }
#endif
}
```

```cpp
#include <hip/hip_runtime.h>
#include <hip/hip_cooperative_groups.h>
#include <cstdio>
namespace cg = cooperative_groups;

typedef unsigned short u16;
using bf16x8 = __attribute__((ext_vector_type(8))) short;
using f32x4 = __attribute__((ext_vector_type(4))) float;
#define DEVI __device__ __forceinline__

constexpr int NB = 4, SEQ = 4096, CL = 256, LT = SEQ + CL, T = NB * LT, D = 2048, DFF = 8192;
constexpr int AB_IN = 4544, AB_INP = 4608, CD_IN = 6720, CD_INP = 6912;
constexpr int NTH = 512, NWV = 8;
constexpr int RCOLS = 3520;

constexpr size_t al256(size_t x) { return (x + 255) & ~(size_t)255; }
constexpr size_t OFF_MOD = 0;
constexpr size_t OFF_CX = al256(OFF_MOD + 2 * 5 * 12288 * 4);
constexpr size_t OFF_RK = al256(OFF_CX + (size_t)NB * CL * D * 4);
constexpr size_t OFF_DT = al256(OFF_RK + (size_t)2 * T * 16 * 4);
constexpr size_t OFF_S5E = al256(OFF_DT + (size_t)2 * T * 32 * 4);
constexpr size_t OFF_W16 = al256(OFF_S5E + (size_t)NB * 64 * 2 * 68 * 128 * 4);
constexpr size_t W_W1 = 0, W_W2 = 33554432, W_L = 67108864;
constexpr size_t W0_IN = W_L, W0_OUT = W0_IN + (size_t)AB_INP * D * 2, W0_LORA = W0_OUT + (size_t)D * D * 2,
                 W0_GLU = W0_LORA + (size_t)5120 * 512 * 2;
constexpr size_t W1_IN = W_L, W1_OUT = W1_IN + (size_t)CD_INP * D * 2;
constexpr size_t W16_SIZE = W1_OUT + (size_t)D * 3072 * 2;
constexpr size_t OFF_H = al256(OFF_W16 + W16_SIZE);
constexpr size_t OFF_BIG = al256(OFF_H + (size_t)T * D * 2);
constexpr size_t B0_P = 0, B0_LIN = B0_P + (size_t)T * AB_INP * 2, B0_WL = B0_LIN + (size_t)T * 512 * 2,
                 B0_AL = B0_WL + (size_t)2 * T * 1024 * 2, B0_G = B0_AL + (size_t)2 * T * 1024 * 2,
                 B0_YR = B0_G + (size_t)T * 1024 * 2, B0_YG = B0_YR + (size_t)2 * T * 1024 * 2,
                 B0_END = B0_YG + (size_t)T * 1024 * 2;
constexpr size_t B1_P = 0, B1_XBC = B1_P + (size_t)T * CD_INP * 2, B1_YB = B1_XBC + (size_t)T * 3072 * 2,
                 B1_CAT = B1_YB + (size_t)T * 2048 * 2, B1_END = B1_CAT + (size_t)T * 3072 * 2;
constexpr size_t BIG_SIZE = B1_END > B0_END ? B1_END : B0_END;
constexpr size_t OFF_BAR = al256(OFF_BIG + BIG_SIZE);
constexpr size_t BAR_BYTES = 16384;
constexpr size_t WS_NEEDED = OFF_BAR + BAR_BYTES;

struct Params {
  const float *x, *c, *ctx, *c_ctx, *ada_w, *ada_b, *norm1_g, *norm2_g, *mlp_w1, *mlp_w2, *final_g;
  const float *ab_w_in, *ab_w_out, *rwkv_mu, *rwkv_w0, *rwkv_w_up, *rwkv_a0, *rwkv_a_up, *rwkv_g_up;
  const float *rwkv_k_k, *rwkv_k_a, *rwkv_r_k, *rwkv_ln_g, *rwkv_ln_b;
  const float *s5_A_re, *s5_A_im, *s5_log_dt, *s5_B_re, *s5_B_im, *s5_C_re, *s5_C_im, *s5_D, *s5_glu_w, *s5_glu_b;
  const float *cd_w_in, *cd_w_out, *ssd_conv_w, *ssd_conv_b, *ssd_A_log, *ssd_dt_bias, *ssd_D, *ssd_norm_g, *attn_sink;
  float* out;
  char* ws;
  int ph_lo, ph_hi;
};

DEVI u16 f2bf(float f) {
  unsigned u = __float_as_uint(f);
  u += 0x7FFFu + ((u >> 16) & 1u);
  return (u16)(u >> 16);
}
DEVI float bf2f(u16 h) { return __uint_as_float(((unsigned)h) << 16); }
DEVI unsigned pack2(float a, float b) { return (unsigned)f2bf(a) | ((unsigned)f2bf(b) << 16); }
DEVI float sigmoidf(float x) { return 1.f / (1.f + __expf(-x)); }
DEVI float dpp_xor1(float v) {
  return __int_as_float(__builtin_amdgcn_update_dpp(0, __float_as_int(v), 0xB1, 0xF, 0xF, true));
}
DEVI float dpp_xor2(float v) {
  return __int_as_float(__builtin_amdgcn_update_dpp(0, __float_as_int(v), 0x4E, 0xF, 0xF, true));
}
DEVI float dpp_half_mirror(float v) {
  return __int_as_float(__builtin_amdgcn_update_dpp(0, __float_as_int(v), 0x141, 0xF, 0xF, true));
}
DEVI float dpp_ror4(float v) {
  return __int_as_float(__builtin_amdgcn_update_dpp(0, __float_as_int(v), 0x124, 0xF, 0xF, true));
}
DEVI float dpp_ror8(float v) {
  return __int_as_float(__builtin_amdgcn_update_dpp(0, __float_as_int(v), 0x128, 0xF, 0xF, true));
}
DEVI float sum16(float v) {
  v += dpp_xor1(v);
  v += dpp_xor2(v);
  v += dpp_ror4(v);
  v += dpp_ror8(v);
  return v;
}
DEVI float sum8(float v) {
  v += dpp_xor1(v);
  v += dpp_xor2(v);
  v += dpp_half_mirror(v);
  return v;
}
DEVI float wave_sum(float v) {
  v += dpp_xor1(v);
  v += dpp_xor2(v);
  v += __shfl_xor(v, 4);
  v += __shfl_xor(v, 8);
  v += __shfl_xor(v, 16);
  v += __shfl_xor(v, 32);
  return v;
}
DEVI void lds_barrier() { asm volatile("s_waitcnt lgkmcnt(0)\n\ts_barrier" ::: "memory"); }
DEVI void wave_lds_fence() { asm volatile("s_waitcnt lgkmcnt(0)" ::: "memory"); }

DEVI float* xrow_ptr(const Params& p, int row) {
  int b = row / LT, pos = row - b * LT;
  return pos < CL ? (float*)(p.ws + OFF_CX) + (size_t)(b * CL + pos) * D : p.out + (size_t)(b * SEQ + pos - CL) * D;
}
DEVI const float* inrow_ptr(const Params& p, int row) {
  int b = row / LT, pos = row - b * LT;
  return pos < CL ? p.ctx + (size_t)(b * CL + pos) * D : p.x + (size_t)(b * SEQ + pos - CL) * D;
}
DEVI int dirpos(int d, int j) { return d == 0 ? j : (j < CL ? CL - 1 - j : LT + CL - 1 - j); }
DEVI const float* mod_ptr(const Params& p, int layer, int row, int idx) {
  int b = row / LT, pos = row - b * LT;
  int r = pos < CL ? 4 : b;
  return (const float*)(p.ws + OFF_MOD) + (size_t)(layer * 5 + r) * 12288 + idx * 2048;
}

DEVI void tjob(const float* __restrict__ src, u16* __restrict__ dst, int K, int N, int Npad, int& t, int& off, int nb,
               char* smem) {
  float* sm = (float*)smem;
  int kt = (K + 63) / 64, nt = Npad / 256, ntiles = kt * nt;
  int tid = threadIdx.x;
  while (t < off + ntiles) {
    int lt = t - off;
    int tk = lt % kt, tn = lt / kt;
    int k0 = tk * 64, n0 = tn * 256;
    float4 v[8];
#pragma unroll
    for (int i = 0; i < 8; ++i) {
      int idx = i * 512 + tid;
      int kk = idx >> 6, c4 = idx & 63;
      v[i] = make_float4(0.f, 0.f, 0.f, 0.f);
      if (k0 + kk < K && n0 + c4 * 4 < N) v[i] = *(const float4*)(src + (size_t)(k0 + kk) * N + n0 + c4 * 4);
    }
    __syncthreads();
#pragma unroll
    for (int i = 0; i < 8; ++i) {
      int idx = i * 512 + tid;
      int kk = idx >> 6, c4 = idx & 63;
      float* d = sm + kk * 257 + c4 * 4;
      d[0] = v[i].x; d[1] = v[i].y; d[2] = v[i].z; d[3] = v[i].w;
    }
    __syncthreads();
#pragma unroll
    for (int i = 0; i < 4; ++i) {
      int gidx = i * 512 + tid;
      int nl = gidx >> 3, kg = gidx & 7;
      if (k0 + kg * 8 < K) {
        unsigned w[4];
#pragma unroll
        for (int j = 0; j < 4; ++j) w[j] = pack2(sm[(kg * 8 + 2 * j) * 257 + nl], sm[(kg * 8 + 2 * j + 1) * 257 + nl]);
        *(uint4*)(dst + (size_t)(n0 + nl) * K + k0 + kg * 8) = make_uint4(w[0], w[1], w[2], w[3]);
      }
    }
    t += nb;
  }
  off += ntiles;
}

DEVI void lora_w_job(const Params& p, u16* dst, int bid, int nb) {
  for (int it = bid * NTH + threadIdx.x; it < 5120 * 64; it += nb * NTH) {
    int n = it % 5120, kg = it / 5120;
    int blk = n >> 10, nn = n & 1023;
    unsigned w[4];
#pragma unroll
    for (int j = 0; j < 4; ++j) {
      float v[2];
#pragma unroll
      for (int e = 0; e < 2; ++e) {
        int k = kg * 8 + j * 2 + e;
        float x = 0.f;
        if (blk < 2) { if (k < 96) x = p.rwkv_w_up[((size_t)blk * 96 + k) * 1024 + nn]; }
        else if (blk < 4) { if (k >= 96 && k < 192) x = p.rwkv_a_up[((size_t)(blk - 2) * 96 + (k - 96)) * 1024 + nn]; }
        else { if (k >= 192 && k < 448) x = p.rwkv_g_up[(size_t)(k - 192) * 1024 + nn]; }
        v[e] = x;
      }
      w[j] = pack2(v[0], v[1]);
    }
    *(uint4*)(dst + (size_t)n * 512 + kg * 8) = make_uint4(w[0], w[1], w[2], w[3]);
  }
}

DEVI void ph_convert(const Params& p, int layer, int bid, int nb, char* smem) {
  char* w16 = p.ws + OFF_W16;
  int t = bid, off = 0;
  tjob(p.mlp_w1 + (size_t)layer * D * DFF, (u16*)(w16 + W_W1), D, DFF, DFF, t, off, nb, smem);
  tjob(p.mlp_w2 + (size_t)layer * D * DFF, (u16*)(w16 + W_W2), DFF, D, D, t, off, nb, smem);
  if (layer == 0) {
    tjob(p.ab_w_in, (u16*)(w16 + W0_IN), D, AB_IN, AB_INP, t, off, nb, smem);
    tjob(p.ab_w_out, (u16*)(w16 + W0_OUT), D, D, D, t, off, nb, smem);
    tjob(p.s5_glu_w, (u16*)(w16 + W0_GLU), 1024, 1024, 1024, t, off, nb, smem);
    lora_w_job(p, (u16*)(w16 + W0_LORA), bid, nb);
  } else {
    tjob(p.cd_w_in, (u16*)(w16 + W1_IN), D, CD_IN, CD_INP, t, off, nb, smem);
    tjob(p.cd_w_out, (u16*)(w16 + W1_OUT), 3072, D, D, t, off, nb, smem);
  }
  __syncthreads();
}

DEVI void ph_mod(const Params& p, int bid, int nb, char* smem) {
  if (bid >= 384) return;
  float* cond = (float*)smem;
  float* red = cond + 5 * 2048;
  int tid = threadIdx.x;
  for (int i = tid; i < 5 * 2048; i += NTH) {
    int r = i >> 11, k = i & 2047;
    float c = r < 4 ? p.c[r * 2048 + k] : p.c_ctx[k];
    cond[i] = c / (1.f + expf(-c));
  }
  __syncthreads();
  int cgp = tid & 15, ks = tid >> 4, lane = tid & 63, wid = tid >> 6;
  float* MOD = (float*)(p.ws + OFF_MOD);
  for (int item = bid; item < 384; item += nb) {
    int l = item / 192, n0 = (item % 192) * 64;
    const float* W = p.ada_w + (size_t)l * 2048 * 12288 + n0 + cgp * 4;
    float acc[5][4];
#pragma unroll
    for (int r = 0; r < 5; ++r)
#pragma unroll
      for (int j = 0; j < 4; ++j) acc[r][j] = 0.f;
#pragma unroll 8
    for (int i = 0; i < 64; ++i) {
      int k = ks + 32 * i;
      float4 w = *(const float4*)(W + (size_t)k * 12288);
#pragma unroll
      for (int r = 0; r < 5; ++r) {
        float c = cond[r * 2048 + k];
        acc[r][0] += c * w.x; acc[r][1] += c * w.y; acc[r][2] += c * w.z; acc[r][3] += c * w.w;
      }
    }
#pragma unroll
    for (int r = 0; r < 5; ++r)
#pragma unroll
      for (int j = 0; j < 4; ++j) {
        float v = acc[r][j];
        v += __shfl_xor(v, 16);
        v += __shfl_xor(v, 32);
        acc[r][j] = v;
      }
    if (lane < 16) {
#pragma unroll
      for (int r = 0; r < 5; ++r)
#pragma unroll
        for (int j = 0; j < 4; ++j) red[(wid * 16 + cgp) * 20 + r * 4 + j] = acc[r][j];
    }
    __syncthreads();
    for (int o = tid; o < 320; o += NTH) {
      int r = o >> 6, col = o & 63;
      int ci = col >> 2, j = col & 3;
      float sacc = 0.f;
#pragma unroll
      for (int w = 0; w < 8; ++w) sacc += red[(w * 16 + ci) * 20 + r * 4 + j];
      MOD[(size_t)(l * 5 + r) * 12288 + n0 + col] = sacc + p.ada_b[l * 12288 + n0 + col];
    }
    __syncthreads();
  }
}

DEVI void ph_norm(const Params& p, int layer, int which, bool src_in, bool xonly, int bid, int nb, bool add_part = false) {
  int wid = threadIdx.x >> 6, lane = threadIdx.x & 63;
  const float* gam = (which == 0 ? p.norm1_g : p.norm2_g) + layer * D;
  u16* H = (u16*)(p.ws + OFF_H);
  int nrows = xonly ? NB * SEQ : T;
  for (int it = bid * NWV + wid; it < nrows; it += nb * NWV) {
    int row = xonly ? (it / SEQ) * LT + CL + (it % SEQ) : it;
    const float* src = src_in ? inrow_ptr(p, row) : xrow_ptr(p, row);
    const float* sh = mod_ptr(p, layer, row, which * 3 + 0);
    const float* sc = mod_ptr(p, layer, row, which * 3 + 1);
    float4 v[8];
    float ss = 0.f;
#pragma unroll
    for (int i = 0; i < 8; ++i) v[i] = *(const float4*)(src + (i * 64 + lane) * 4);
    if (add_part && (row % LT) < CL) {
      const float* g2 = mod_ptr(p, layer - 1, row, 5);
      const float* part = (const float*)(p.ws + OFF_BIG + 300000000) + (size_t)((row / LT) * CL + (row % LT)) * 2048;
#pragma unroll
      for (int i = 0; i < 8; ++i) {
        const int c = (i * 64 + lane) * 4;
        float4 acc = make_float4(0.f, 0.f, 0.f, 0.f);
#pragma unroll
        for (int ks = 0; ks < 8; ++ks) {
          float4 q = *(const float4*)(part + (size_t)ks * (1024 * 2048) + c);
          acc.x += q.x; acc.y += q.y; acc.z += q.z; acc.w += q.w;
        }
        float4 gg = *(const float4*)(g2 + c);
        v[i].x += gg.x * acc.x; v[i].y += gg.y * acc.y; v[i].z += gg.z * acc.z; v[i].w += gg.w * acc.w;
      }
    }
#pragma unroll
    for (int i = 0; i < 8; ++i) ss += v[i].x * v[i].x + v[i].y * v[i].y + v[i].z * v[i].z + v[i].w * v[i].w;
    ss = wave_sum(ss);
    float rs = rsqrtf(ss * (1.f / D) + 1e-6f);
#pragma unroll
    for (int i = 0; i < 8; ++i) {
      int c = (i * 64 + lane) * 4;
      float4 g = *(const float4*)(gam + c);
      float4 s1 = *(const float4*)(sc + c);
      float4 s0 = *(const float4*)(sh + c);
      float a0 = v[i].x * rs * g.x * (1.f + s1.x) + s0.x;
      float a1 = v[i].y * rs * g.y * (1.f + s1.y) + s0.y;
      float a2 = v[i].z * rs * g.z * (1.f + s1.z) + s0.z;
      float a3 = v[i].w * rs * g.w * (1.f + s1.w) + s0.w;
      *(uint2*)(H + (size_t)row * D + c) = make_uint2(pack2(a0, a1), pack2(a2, a3));
    }
  }
}

#define LAS __attribute__((address_space(3)))
typedef unsigned u32x4 __attribute__((ext_vector_type(4)));
constexpr int BM = 256, BK = 64, HALF = 128, HTB = HALF * BK * 2, STAGE_BYTES = 8 * HTB, NXCD = 8, WGM = 8;
DEVI int lds_byte(int r, int c) {
  const int st = (r >> 4) * 2 + (c >> 5), rr = r & 15, cc = c & 31, ob = rr * 64 + cc * 2;
  return st * 1024 + (ob ^ (((ob >> 9) & 1) << 5));
}
DEVI void stage_rc(int b, int& R, int& C) {
  const int st = b / 1024, sb = b % 1024, swz = sb ^ (((sb >> 9) & 1) << 5);
  R = (st >> 1) * 16 + swz / 64;
  C = (st & 1) * 32 + (swz % 64) / 2;
}
DEVI int perm32(int rho) { const int n = rho >> 4, i = rho & 15; return 8 * (i >> 2) + 4 * n + (i & 3); }
struct Unit { int pm, pn, koff; };
struct Gemm { const u16* A; const u16* Bt; int K; int ld; };
struct Order {
  int nM, nN, nwg, G, c, xonly;
  DEVI void init(int nM_, int nN_, int G_, int c_, int xonly_) { nM = nM_; nN = nN_; nwg = nM * nN; G = G_; c = c_; xonly = xonly_; }
  DEVI bool next(int i, Unit& u) const {
    const long L = (long)i * G + c;
    u.koff = 0;
    if (xonly == 3) {
      if (L >= 4 * nN * 8) return false;
      u.pm = ((int)L & 3) * 17; u.pn = ((int)L >> 2) % nN; u.koff = ((int)L / (4 * nN)) * 1024;
      return true;
    }
    if (xonly == 2 && L >= nwg) {
      const int idx = (int)L - nwg;
      if (idx >= 64) return false;
      const int t = idx >> 2;
      u.pm = (idx & 3) * 17; u.pn = t < 13 ? 8 + t : 11 + t;
      return true;
    }
    if (L >= nwg) return false;
    int wgid = (int)L;
    { const int q = nwg / NXCD, r = nwg % NXCD, xcd = wgid % NXCD, off = wgid / NXCD; wgid = (xcd < r ? xcd * (q + 1) : r * (q + 1) + (xcd - r) * q) + off; }
    const int nig = WGM * nN, gid = wgid / nig, fm = gid * WGM, gsz = (nM - fm) < WGM ? (nM - fm) : WGM;
    int pm = fm + ((wgid % nig) % gsz);
    u.pn = (wgid % nig) / gsz;
    u.pm = xonly ? (pm >> 4) * 17 + 1 + (pm & 15) : pm;
    return true;
  }
};
DEVI bf16x8 mk_bf16x8(unsigned a, unsigned b, unsigned c, unsigned d) {
  u32x4 v = {a, b, c, d};
  return __builtin_bit_cast(bf16x8, v);
}
DEVI unsigned cvt_pk_bf16(float lo, float hi) { unsigned r; asm volatile("v_cvt_pk_bf16_f32 %0, %1, %2" : "=v"(r) : "v"(lo), "v"(hi)); return r; }

template <int ACT>
struct EpiBf16 {
  static constexpr bool PERM = true;
  u16* O; int ldc; int split_cols; size_t split_stride;
  DEVI void operator()(const f32x4 (&acc)[2][2][4][2], const Unit& u, int wr, int wc, int fr, int fq) const {
    const int row0 = u.pm * BM + wr * 64 + fr;
    int colt = u.pn * BM;
    u16* base = O;
    if (split_cols) { const int t = colt / split_cols; base += (size_t)t * split_stride; colt -= t * split_cols; }
    const int col0 = colt + wc * 32 + 8 * fq;
#pragma unroll
    for (int ai = 0; ai < 2; ++ai)
#pragma unroll
      for (int m = 0; m < 4; ++m) {
        u16* rowp = base + (size_t)(row0 + ai * HALF + m * 16) * ldc + col0;
#pragma unroll
        for (int bj = 0; bj < 2; ++bj) {
          f32x4 v0 = acc[ai][bj][m][0], v1 = acc[ai][bj][m][1];
          if (ACT == 1) {
#pragma unroll
            for (int j = 0; j < 4; ++j) { float a = fmaxf(v0[j], 0.f), b = fmaxf(v1[j], 0.f); v0[j] = a * a; v1[j] = b * b; }
          }
          u32x4 w;
          w.x = cvt_pk_bf16(v0[0], v0[1]); w.y = cvt_pk_bf16(v0[2], v0[3]); w.z = cvt_pk_bf16(v1[0], v1[1]); w.w = cvt_pk_bf16(v1[2], v1[3]);
          *(u32x4*)(rowp + bj * HALF) = w;
        }
      }
  }
};
struct EpiGlu {
  static constexpr bool PERM = true;
  const u16* YG; u16* CAT; const float* bias;
  DEVI void operator()(const f32x4 (&acc)[2][2][4][2], const Unit& u, int wr, int wc, int fr, int fq) const {
    const int row0 = u.pm * BM + wr * 64 + fr;
    const int col0 = u.pn * BM + wc * 32 + 8 * fq;
#pragma unroll
    for (int ai = 0; ai < 2; ++ai)
#pragma unroll
      for (int m = 0; m < 4; ++m) {
        const size_t row = (size_t)(row0 + ai * HALF + m * 16);
#pragma unroll
        for (int bj = 0; bj < 2; ++bj) {
          const int col = col0 + bj * HALF;
          u32x4 yv = *(const u32x4*)(YG + row * 1024 + col);
          f32x4 b0 = *(const f32x4*)(bias + col), b1 = *(const f32x4*)(bias + col + 4);
          f32x4 v0 = acc[ai][bj][m][0] + b0, v1 = acc[ai][bj][m][1] + b1;
          float y[8];
          unsigned yw[4] = {yv.x, yv.y, yv.z, yv.w};
#pragma unroll
          for (int j = 0; j < 4; ++j) { y[2 * j] = __uint_as_float(yw[j] << 16); y[2 * j + 1] = __uint_as_float(yw[j] & 0xFFFF0000u); }
          u32x4 w;
          w.x = cvt_pk_bf16(y[0] * sigmoidf(v0[0]), y[1] * sigmoidf(v0[1]));
          w.y = cvt_pk_bf16(y[2] * sigmoidf(v0[2]), y[3] * sigmoidf(v0[3]));
          w.z = cvt_pk_bf16(y[4] * sigmoidf(v1[0]), y[5] * sigmoidf(v1[1]));
          w.w = cvt_pk_bf16(y[6] * sigmoidf(v1[2]), y[7] * sigmoidf(v1[3]));
          *(u32x4*)(CAT + row * D + 1024 + col) = w;
        }
      }
  }
};
struct EpiResid {
  static constexpr bool PERM = false;
  Params p; int layer, gidx, from_in;
  DEVI void operator()(const f32x4 (&acc)[2][2][4][2], const Unit& u, int wr, int wc, int fr, int fq) const {
    const int row0 = u.pm * BM + wr * 64 + fr, col0 = u.pn * BM + wc * 32 + 4 * fq;
    const float* gate = mod_ptr(p, layer, row0, gidx);
    f32x4 gv[2][2];
#pragma unroll
    for (int bj = 0; bj < 2; ++bj)
#pragma unroll
      for (int n = 0; n < 2; ++n) gv[bj][n] = *(const f32x4*)(gate + col0 + bj * HALF + n * 16);
#pragma unroll
    for (int ai = 0; ai < 2; ++ai)
#pragma unroll
      for (int m = 0; m < 4; ++m) {
        const int row = row0 + ai * HALF + m * 16;
        float* dst = xrow_ptr(p, row) + col0;
        const float* src = from_in ? inrow_ptr(p, row) + col0 : dst;
#pragma unroll
        for (int bj = 0; bj < 2; ++bj)
#pragma unroll
          for (int n = 0; n < 2; ++n) {
            f32x4 sv = *(const f32x4*)(src + bj * HALF + n * 16);
            *(f32x4*)(dst + bj * HALF + n * 16) = sv + gv[bj][n] * acc[ai][bj][m][n];
          }
      }
  }
};

constexpr size_t B_PART = 300000000;
struct EpiPartial {
  static constexpr bool PERM = false;
  float* PART;
  DEVI void operator()(const f32x4 (&acc)[2][2][4][2], const Unit& u, int wr, int wc, int fr, int fq) const {
    const int lrow0 = (u.pm / 17) * 256 + wr * 64 + fr, col0 = u.pn * BM + wc * 32 + 4 * fq;
    float* base = PART + (size_t)(u.koff >> 10) * (1024 * 2048);
#pragma unroll
    for (int ai = 0; ai < 2; ++ai)
#pragma unroll
      for (int m = 0; m < 4; ++m) {
        float* dst = base + (size_t)(lrow0 + ai * HALF + m * 16) * 2048 + col0;
#pragma unroll
        for (int bj = 0; bj < 2; ++bj)
#pragma unroll
          for (int n = 0; n < 2; ++n) *(f32x4*)(dst + bj * HALF + n * 16) = acc[ai][bj][m][n];
      }
  }
};

template <class Epi>
DEVI void gemm_phase(LAS unsigned char* lds, const Gemm g, const Order& S, const Epi& E) {
  const int tid = threadIdx.x, wid = __builtin_amdgcn_readfirstlane(tid >> 6), lane = tid & 63, wr = wid >> 2, wc = wid & 3, fr = lane & 15, fq = lane >> 4;
  const int K = g.ld, nt = g.K / BK;
  unsigned voffA[2], voffB[2];
#pragma unroll
  for (int i = 0; i < 2; ++i) {
    int R, C;
    stage_rc(tid * 16 + i * 8192, R, C);
    const int Rb = Epi::PERM ? ((R & ~31) + perm32(R & 31)) : R;
    voffA[i] = (unsigned)(R * K + C) * 2u;
    voffB[i] = (unsigned)(Rb * K + C) * 2u;
  }
  const size_t kstep = (size_t)(BK * 2);
  const size_t hstep = (size_t)HALF * K * 2;
  const size_t tstep = 2 * hstep;
  const unsigned ldsw = (unsigned)wid * 1024u;
  const int aoff = lds_byte(wr * 64 + fr, fq * 8), boff = lds_byte(wc * 32 + fr, fq * 8);
#define PG8_SA(b, h) (((b) * 2 + (h)) * HTB)
#define PG8_SB(b, h) ((4 + (b) * 2 + (h)) * HTB)
#define PG8_STAGE(bufoff, gbase, voff) do { _Pragma("unroll") for (int _i = 0; _i < 2; ++_i) \
        __builtin_amdgcn_global_load_lds((const unsigned*)((const char*)(gbase) + (voff)[_i]), (LAS unsigned*)(lds + (bufoff) + ldsw + _i * 8192), 16, 0, 0); } while (0)
#define PG8_LDA(dst, b, h) do { _Pragma("unroll") for (int m = 0; m < 4; ++m) _Pragma("unroll") for (int k = 0; k < 2; ++k) dst[m][k] = *(const LAS bf16x8*)(lds + PG8_SA(b, h) + aoff + m * 2048 + k * 1024); } while (0)
#define PG8_LDB(dst, b, h) do { _Pragma("unroll") for (int n = 0; n < 2; ++n) _Pragma("unroll") for (int k = 0; k < 2; ++k) dst[n][k] = *(const LAS bf16x8*)(lds + PG8_SB(b, h) + boff + n * 2048 + k * 1024); } while (0)
#define PG8_MMA(ai, bj, At, Bt) do { __builtin_amdgcn_s_setprio(1); _Pragma("unroll") for (int m = 0; m < 4; ++m) _Pragma("unroll") for (int n = 0; n < 2; ++n) _Pragma("unroll") for (int k = 0; k < 2; ++k) \
        acc[ai][bj][m][n] = __builtin_amdgcn_mfma_f32_16x16x32_bf16(Bt[n][k], At[m][k], acc[ai][bj][m][n], 0, 0, 0); __builtin_amdgcn_s_setprio(0); } while (0)
#define PG8_WAIT_V(n) asm volatile("s_waitcnt vmcnt(" #n ")" ::: "memory")
#define PG8_WAIT_L(n) asm volatile("s_waitcnt lgkmcnt(" #n ")" ::: "memory")
#define PG8_BAR __builtin_amdgcn_s_barrier()
#define PG8_SCHED __builtin_amdgcn_sched_barrier(0)
  Unit cur, nxt;
  int ui = 0;
  if (!S.next(0, cur)) return;
  f32x4 acc[2][2][4][2];
#pragma unroll
  for (int a = 0; a < 2; ++a)
#pragma unroll
    for (int b = 0; b < 2; ++b)
#pragma unroll
      for (int m = 0; m < 4; ++m)
#pragma unroll
        for (int n = 0; n < 2; ++n) acc[a][b][m][n] = (f32x4){0.f, 0.f, 0.f, 0.f};
  bf16x8 At[4][2], B0[2][2], B1[2][2];
  const char* cA = (const char*)g.A + (size_t)cur.pm * tstep + (size_t)cur.koff * 2;
  const char* cB = (const char*)g.Bt + (size_t)cur.pn * tstep + (size_t)cur.koff * 2;
  PG8_STAGE(PG8_SB(0, 0), cB, voffB); PG8_STAGE(PG8_SA(0, 0), cA, voffA); PG8_STAGE(PG8_SB(0, 1), cB + hstep, voffB); PG8_STAGE(PG8_SA(0, 1), cA + hstep, voffA);
  if (wr == 1) PG8_BAR;
  PG8_WAIT_V(4); PG8_BAR;
  PG8_STAGE(PG8_SB(1, 0), cB + kstep, voffB); PG8_STAGE(PG8_SA(1, 0), cA + kstep, voffA); PG8_STAGE(PG8_SB(1, 1), cB + hstep + kstep, voffB);
  PG8_WAIT_V(6); PG8_BAR;
  for (;;) {
    const bool has_next = S.next(ui + 1, nxt);
    const char* nA = has_next ? (const char*)g.A + (size_t)nxt.pm * tstep + (size_t)nxt.koff * 2 : cA;
    const char* nB = has_next ? (const char*)g.Bt + (size_t)nxt.pn * tstep + (size_t)nxt.koff * 2 : cB;
    for (int t = 0; t < nt; t += 2) {
      const bool last = (t == nt - 2);
      const char* a1 = cA + (size_t)(t + 1) * kstep;
      const char* a2 = last ? nA : cA + (size_t)(t + 2) * kstep;
      const char* b2 = last ? nB : cB + (size_t)(t + 2) * kstep;
      const char* a3 = a2 + kstep;
      const char* b3 = b2 + kstep;
      PG8_LDB(B0, 0, 0); PG8_SCHED; PG8_LDA(At, 0, 0); PG8_STAGE(PG8_SA(1, 1), a1 + hstep, voffA);
      PG8_WAIT_L(8); PG8_BAR; PG8_WAIT_L(0); PG8_MMA(0, 0, At, B0); PG8_BAR; PG8_SCHED;
      PG8_LDB(B1, 0, 1); PG8_STAGE(PG8_SB(0, 0), b2, voffB);
      PG8_BAR; PG8_WAIT_L(0); PG8_MMA(0, 1, At, B1); PG8_BAR;
      PG8_LDA(At, 0, 1); PG8_STAGE(PG8_SA(0, 0), a2, voffA);
      PG8_BAR; PG8_WAIT_L(0); PG8_MMA(1, 0, At, B0); PG8_BAR; PG8_SCHED;
      PG8_STAGE(PG8_SB(0, 1), b2 + hstep, voffB);
      PG8_WAIT_V(6); PG8_BAR; PG8_MMA(1, 1, At, B1); PG8_BAR;
      PG8_LDB(B0, 1, 0); PG8_SCHED; PG8_LDA(At, 1, 0); PG8_STAGE(PG8_SA(0, 1), a2 + hstep, voffA);
      PG8_WAIT_L(8); PG8_BAR; PG8_WAIT_L(0); PG8_MMA(0, 0, At, B0); PG8_BAR; PG8_SCHED;
      PG8_LDB(B1, 1, 1); PG8_STAGE(PG8_SB(1, 0), b3, voffB);
      PG8_BAR; PG8_WAIT_L(0); PG8_MMA(0, 1, At, B1); PG8_BAR;
      PG8_LDA(At, 1, 1); PG8_STAGE(PG8_SA(1, 0), a3, voffA);
      PG8_BAR; PG8_WAIT_L(0); PG8_MMA(1, 0, At, B0); PG8_BAR; PG8_SCHED;
      PG8_STAGE(PG8_SB(1, 1), b3 + hstep, voffB);
      PG8_WAIT_V(6); PG8_BAR; PG8_MMA(1, 1, At, B1); PG8_BAR;
    }
    E(acc, cur, wr, wc, fr, fq);
    if (!has_next) break;
#pragma unroll
    for (int a = 0; a < 2; ++a)
#pragma unroll
      for (int b = 0; b < 2; ++b)
#pragma unroll
        for (int m = 0; m < 4; ++m)
#pragma unroll
          for (int n = 0; n < 2; ++n) acc[a][b][m][n] = (f32x4){0.f, 0.f, 0.f, 0.f};
    cur = nxt; cA = nA; cB = nB; ++ui;
  }
  PG8_WAIT_V(0);
  if (wr == 0) PG8_BAR;
  PG8_BAR;
#undef PG8_SA
#undef PG8_SB
#undef PG8_STAGE
#undef PG8_LDA
#undef PG8_LDB
#undef PG8_MMA
#undef PG8_WAIT_V
#undef PG8_WAIT_L
#undef PG8_BAR
#undef PG8_SCHED
}

struct S5C {
  float ab_re, ab_im;
  float bb_re[16], bb_im[16];
};
DEVI void s5_consts(const Params& p, int d, int g, int n, S5C& c) {
  int ix = (d * 64 + g) * 64 + n;
  float lam = fminf(p.s5_A_re[ix], -1e-4f), aim = p.s5_A_im[ix];
  float dt = expf(p.s5_log_dt[d * 64 + g]);
  float mag = expf(lam * dt), sn, cs;
  sincosf(aim * dt, &sn, &cs);
  c.ab_re = mag * cs;
  c.ab_im = mag * sn;
  float den = lam * lam + aim * aim;
  float f_re = ((c.ab_re - 1.f) * lam + c.ab_im * aim) / den;
  float f_im = (c.ab_im * lam - (c.ab_re - 1.f) * aim) / den;
  const float4* br = (const float4*)(p.s5_B_re + (size_t)ix * 16);
  const float4* bi = (const float4*)(p.s5_B_im + (size_t)ix * 16);
#pragma unroll
  for (int q = 0; q < 4; ++q) {
    float4 r = br[q], i = bi[q];
    c.bb_re[q * 4 + 0] = f_re * r.x - f_im * i.x; c.bb_im[q * 4 + 0] = f_re * i.x + f_im * r.x;
    c.bb_re[q * 4 + 1] = f_re * r.y - f_im * i.y; c.bb_im[q * 4 + 1] = f_re * i.y + f_im * r.y;
    c.bb_re[q * 4 + 2] = f_re * r.z - f_im * i.z; c.bb_im[q * 4 + 2] = f_re * i.z + f_im * r.z;
    c.bb_re[q * 4 + 3] = f_re * r.w - f_im * i.w; c.bb_im[q * 4 + 3] = f_re * i.w + f_im * r.w;
  }
}
DEVI void load_u16x16(const u16* ptr, float* u) {
  uint4 a = *(const uint4*)ptr, b = *(const uint4*)(ptr + 8);
  unsigned w[8] = {a.x, a.y, a.z, a.w, b.x, b.y, b.z, b.w};
#pragma unroll
  for (int i = 0; i < 8; ++i) {
    u[2 * i] = __uint_as_float(w[i] << 16);
    u[2 * i + 1] = __uint_as_float(w[i] & 0xFFFF0000u);
  }
}
DEVI int s5_cu(int d, int q) { return d == 0 ? q : (q < 4 ? 3 - q : 71 - q); }
DEVI int s5_q(int d, int cu) { return d == 0 ? cu : (cu < 4 ? 3 - cu : 71 - cu); }

DEVI void ph_s5_pass1(const Params& p, int gw, int nw, char* smem) {
  int lane = threadIdx.x & 63;
  u16* Us = (u16*)smem + (threadIdx.x >> 6) * 1024;
  const u16* P = (const u16*)(p.ws + OFF_BIG + B0_P);
  float* E = (float*)(p.ws + OFF_S5E);
  for (int task = gw; task < NB * 64 * 2 * 68; task += nw) {
    int q = task % 68, d = (task / 68) & 1, g = (task / 136) & 63, b = task / (136 * 64);
    S5C c;
    s5_consts(p, d, g, lane, c);
    int cu = s5_cu(d, q);
    {
      const u16* up = P + (size_t)(b * LT + cu * 64 + lane) * AB_INP + RCOLS + g * 16;
      uint4 u0 = *(const uint4*)up, u1 = *(const uint4*)(up + 8);
      wave_lds_fence();
      *(uint4*)(Us + lane * 16) = u0;
      *(uint4*)(Us + lane * 16 + 8) = u1;
      wave_lds_fence();
    }
    float hr = 0.f, hi = 0.f;
    for (int i = 0; i < 64; ++i) {
      int tl = d == 0 ? i : 63 - i;
      float u[16];
      load_u16x16(Us + tl * 16, u);
      float br = 0.f, bi = 0.f;
#pragma unroll
      for (int k = 0; k < 16; ++k) { br += c.bb_re[k] * u[k]; bi += c.bb_im[k] * u[k]; }
      float nr = c.ab_re * hr - c.ab_im * hi + br;
      float ni = c.ab_re * hi + c.ab_im * hr + bi;
      hr = nr; hi = ni;
    }
    size_t ei = ((((size_t)(b * 64 + g) * 2 + d) * 68 + q) * 64 + lane) * 2;
    *(float2*)(E + ei) = make_float2(hr, hi);
  }
}

DEVI void ph_s5_prefix(const Params& p, int gw, int nw) {
  const int lane = threadIdx.x & 63;
  float* E = (float*)(p.ws + OFF_S5E);
  for (int task = gw; task < NB * 64 * 2; task += nw) {
    const int d = task & 1, g = (task >> 1) & 63, b = task >> 7;
    const int ix = (d * 64 + g) * 64 + lane;
    const float lam = fminf(p.s5_A_re[ix], -1e-4f), aim = p.s5_A_im[ix];
    const float dt = expf(p.s5_log_dt[d * 64 + g]);
    const float mag = expf(lam * dt);
    float sn, cs;
    sincosf(aim * dt, &sn, &cs);
    float qr = mag * cs, qi = mag * sn;
#pragma unroll
    for (int sq = 0; sq < 6; ++sq) { float t0 = qr * qr - qi * qi, t1 = 2.f * qr * qi; qr = t0; qi = t1; }
    float* Eb = E + (((size_t)(b * 64 + g) * 2 + d) * 68) * 128 + lane * 2;
    float sr = 0.f, si = 0.f;
#pragma unroll 4
    for (int q = 0; q < 68; ++q) {
      float2 e = *(const float2*)(Eb + (size_t)q * 128);
      *(float2*)(Eb + (size_t)q * 128) = make_float2(sr, si);
      float nr = qr * sr - qi * si + e.x, ni = qr * si + qi * sr + e.y;
      sr = nr; si = ni;
    }
  }
}

DEVI void ph_s5_pass2(const Params& p, int gw, int nw, char* smem) {
  typedef float f32x2 __attribute__((ext_vector_type(2)));
  const int lane = threadIdx.x & 63, wid = threadIdx.x >> 6;
  constexpr int HP = 130;
  float* Hs = (float*)smem + wid * (16 * HP + 512);
  u16* Us = (u16*)(Hs + 16 * HP);
  const u16* P = (const u16*)(p.ws + OFF_BIG + B0_P);
  const float* E = (const float*)(p.ws + OFF_S5E);
  u16* YG = (u16*)(p.ws + OFF_BIG + B0_YG);
  const int mi = lane & 15, mk = lane >> 4;
  for (int task = gw; task < NB * 64 * 68; task += nw) {
    const int cu = task % 68, g = (task / 68) & 63, b = task / (68 * 64);
    f32x4 Y[4];
#pragma unroll
    for (int q = 0; q < 4; ++q) Y[q] = (f32x4){0.f, 0.f, 0.f, 0.f};
    {
      const u16* up = P + (size_t)(b * LT + cu * 64 + lane) * AB_INP + RCOLS + g * 16;
      uint4 u0 = *(const uint4*)up, u1 = *(const uint4*)(up + 8);
      wave_lds_fence();
      *(uint4*)(Us + lane * 16) = u0;
      *(uint4*)(Us + lane * 16 + 8) = u1;
      wave_lds_fence();
    }
    for (int d = 0; d < 2; ++d) {
      S5C c;
      s5_consts(p, d, g, lane, c);
      float cm[32];
#pragma unroll
      for (int kk = 0; kk < 32; ++kk) {
        int k = 4 * kk + mk, n = k >> 1;
        size_t ci = ((size_t)(d * 64 + g) * 16 + mi) * 64 + n;
        cm[kk] = (k & 1) ? -p.s5_C_im[ci] : p.s5_C_re[ci];
      }
      const int q = s5_q(d, cu);
      const float2 e0 = *(const float2*)(E + ((((size_t)(b * 64 + g) * 2 + d) * 68 + q) * 64 + lane) * 2);
      float hr = e0.x, hi = e0.y;
      for (int sb = 0; sb < 4; ++sb) {
        const int blk = d == 0 ? sb : 3 - sb;
        for (int i = 0; i < 16; ++i) {
          const int tl = d == 0 ? i : 15 - i;
          float u[16];
          load_u16x16(Us + (blk * 16 + tl) * 16, u);
          f32x2 bu = (f32x2){0.f, 0.f};
#pragma unroll
          for (int k = 0; k < 16; ++k) bu += (f32x2){c.bb_re[k], c.bb_im[k]} * u[k];
          float nr = c.ab_re * hr - c.ab_im * hi + bu.x;
          float ni = c.ab_re * hi + c.ab_im * hr + bu.y;
          hr = nr; hi = ni;
          *(float2*)(Hs + tl * HP + 2 * lane) = make_float2(hr, hi);
        }
        wave_lds_fence();
        f32x4 acc = Y[blk];
#pragma unroll
        for (int kk = 0; kk < 32; ++kk) {
          float a = Hs[mi * HP + 4 * kk + mk];
          acc = __builtin_amdgcn_mfma_f32_16x16x4f32(a, cm[kk], acc, 0, 0, 0);
        }
        Y[blk] = acc;
        wave_lds_fence();
      }
    }
    const float dsk = p.s5_D[g * 16 + mi];
#pragma unroll
    for (int blk = 0; blk < 4; ++blk)
#pragma unroll
      for (int r = 0; r < 4; ++r) {
        const int row = b * LT + cu * 64 + blk * 16 + 4 * mk + r;
        float uu = bf2f(Us[(blk * 16 + 4 * mk + r) * 16 + mi]);
        float y0 = Y[blk][r] + dsk * uu;
        y0 = 0.5f * y0 * (1.f + tanhf(0.7978845608f * (y0 + 0.044715f * y0 * y0 * y0)));
        YG[(size_t)row * 1024 + g * 16 + mi] = f2bf(y0);
      }
  }
}

DEVI void ph_lora_in(const Params& p, int bid, int nb) {
  const u16* P = (const u16*)(p.ws + OFF_BIG + B0_P);
  u16* LIN = (u16*)(p.ws + OFF_BIG + B0_LIN);
  const size_t total = (size_t)T * 256;
  for (size_t it = (size_t)bid * NTH + threadIdx.x; it < total; it += (size_t)nb * NTH) {
    int row = (int)(it >> 8), jp = (int)(it & 255);
    if (jp >= 224) { *(unsigned*)(LIN + (size_t)row * 512 + jp * 2) = 0u; continue; }
    int pos = row % LT;
    bool first = (pos == 0 || pos == CL), last = (pos == CL - 1 || pos == LT - 1);
    int col = 3072 + jp * 2;
    unsigned cu = *(const unsigned*)(P + (size_t)row * AB_INP + col);
    unsigned pv = first ? 0u : *(const unsigned*)(P + (size_t)(row - 1) * AB_INP + col);
    unsigned nx = last ? 0u : *(const unsigned*)(P + (size_t)(row + 1) * AB_INP + col);
    float o[2];
#pragma unroll
    for (int e = 0; e < 2; ++e) {
      float c = e ? __uint_as_float(cu & 0xFFFF0000u) : __uint_as_float(cu << 16);
      float pr = e ? __uint_as_float(pv & 0xFFFF0000u) : __uint_as_float(pv << 16);
      float nn = e ? __uint_as_float(nx & 0xFFFF0000u) : __uint_as_float(nx << 16);
      float m0 = p.rwkv_mu[col + e], m1 = p.rwkv_mu[RCOLS + col + e];
      float s = c + m0 * (pr - c) + m1 * (nn - c);
      int j = jp * 2 + e;
      o[e] = j < 96 ? tanhf(s) : (j < 192 ? s : sigmoidf(s));
    }
    *(unsigned*)(LIN + (size_t)row * 512 + jp * 2) = pack2(o[0], o[1]);
  }
}

DEVI void ph_rwkv_scan(const Params& p, int blk, char* smem) {
  const int d = blk & 1, h = (blk >> 1) & 15, b = blk >> 5;
  const int tid = threadIdx.x, wid = __builtin_amdgcn_readfirstlane(tid >> 6), lane = tid & 63;
  constexpr int NCH = LT / 8;
  constexpr int BW = 6 * 8 * 64;
  float* bufs = (float*)smem;
  float* ybuf = bufs + 2 * BW;
  const u16* P = (const u16*)(p.ws + OFF_BIG + B0_P);
  const u16* WL = (const u16*)(p.ws + OFF_BIG + B0_WL) + (size_t)d * T * 1024;
  const u16* AL = (const u16*)(p.ws + OFF_BIG + B0_AL) + (size_t)d * T * 1024;
  u16* YR = (u16*)(p.ws + OFF_BIG + B0_YR) + (size_t)d * T * 1024;
  float* RK = (float*)(p.ws + OFF_RK) + (size_t)d * T * 16;
  if (wid >= 4) {
    const int sw = wid - 4;
    const int c = h * 64 + lane;
    const float mr0 = p.rwkv_mu[c], mr1 = p.rwkv_mu[RCOLS + c];
    const float mk0 = p.rwkv_mu[1024 + c], mk1 = p.rwkv_mu[RCOLS + 1024 + c];
    const float mv0 = p.rwkv_mu[2048 + c], mv1 = p.rwkv_mu[RCOLS + 2048 + c];
    const float w0 = p.rwkv_w0[d * 1024 + c], a0 = p.rwkv_a0[d * 1024 + c];
    const float kkc = p.rwkv_k_k[c], kac = p.rwkv_k_a[c], rkc = p.rwkv_r_k[c];
    u16 R0[2][11], R1[2][11], R2[2][11], R3[2][11];
    auto load_raw = [&](int ch, u16 (&raw)[2][11]) {
      ch = ch < NCH ? ch : NCH - 1;
#pragma unroll
      for (int i = 0; i < 2; ++i) {
        int pos = dirpos(d, ch * 8 + sw * 2 + i);
        int row = b * LT + pos;
        bool first = (pos == 0 || pos == CL), last = (pos == CL - 1 || pos == LT - 1);
        const u16* pr = P + (size_t)row * AB_INP + c;
        const u16* pp = first ? pr : pr - AB_INP;
        const u16* pn = last ? pr : pr + AB_INP;
#pragma unroll
        for (int s3 = 0; s3 < 3; ++s3) {
          raw[i][s3 * 3 + 0] = pr[s3 * 1024];
          raw[i][s3 * 3 + 1] = pp[s3 * 1024];
          raw[i][s3 * 3 + 2] = pn[s3 * 1024];
        }
        raw[i][9] = WL[(size_t)row * 1024 + c];
        raw[i][10] = AL[(size_t)row * 1024 + c];
      }
    };
    auto process = [&](int ch, const u16 (&raw)[2][11], float* buf) {
      ch = ch < NCH ? ch : NCH - 1;
#pragma unroll
      for (int i = 0; i < 2; ++i) {
        int tt = sw * 2 + i;
        int pos = dirpos(d, ch * 8 + tt);
        int row = b * LT + pos;
        float fm = (pos == 0 || pos == CL) ? 0.f : 1.f, lm = (pos == CL - 1 || pos == LT - 1) ? 0.f : 1.f;
        float rc = bf2f(raw[i][0]), rp = bf2f(raw[i][1]) * fm, rn = bf2f(raw[i][2]) * lm;
        float kc = bf2f(raw[i][3]), kp = bf2f(raw[i][4]) * fm, kn = bf2f(raw[i][5]) * lm;
        float vc = bf2f(raw[i][6]), vp = bf2f(raw[i][7]) * fm, vn = bf2f(raw[i][8]) * lm;
        float r = rc + mr0 * (rp - rc) + mr1 * (rn - rc);
        float k = kc + mk0 * (kp - kc) + mk1 * (kn - kc);
        float v = vc + mv0 * (vp - vc) + mv1 * (vn - vc);
        float kkraw = k * kkc;
        float nrm = sqrtf(wave_sum(kkraw * kkraw));
        float kk = kkraw / fmaxf(nrm, 1e-12f);
        float z = w0 + bf2f(raw[i][9]);
        float sg = 1.f / (1.f + expf(-z));
        float decay = expf(-0.60653065971f * sg);
        float a = 1.f / (1.f + expf(-(a0 + bf2f(raw[i][10]))));
        float kd = k * (1.f + (a - 1.f) * kac);
        float rk = wave_sum(r * kd * rkc);
        if (lane == 0) RK[(size_t)row * 16 + h] = rk;
        buf[(0 * 8 + tt) * 64 + lane] = r;
        buf[(1 * 8 + tt) * 64 + lane] = decay;
        buf[(2 * 8 + tt) * 64 + lane] = kd;
        buf[(3 * 8 + tt) * 64 + lane] = kk;
        buf[(4 * 8 + tt) * 64 + lane] = kk * a;
        buf[(5 * 8 + tt) * 64 + lane] = v;
      }
    };
    auto bulk = [&](int ch) {
#pragma unroll
      for (int i = 0; i < 2; ++i) {
        const int tt = sw * 2 + i;
        const float4* yp = (const float4*)(ybuf + ((((ch & 1) * 8 + tt) * 32 + (lane >> 1)) * 8) * 2);
        float4 q0 = yp[0], q1 = yp[1], q2 = yp[2], q3 = yp[3];
        float ya = (q0.x + q0.z) + (q1.x + q1.z) + (q2.x + q2.z) + (q3.x + q3.z);
        float yb = (q0.y + q0.w) + (q1.y + q1.w) + (q2.y + q2.w) + (q3.y + q3.w);
        int row = b * LT + dirpos(d, ch * 8 + tt);
        YR[(size_t)row * 1024 + h * 64 + lane] = f2bf((lane & 1) ? yb : ya);
      }
    };
    load_raw(0, R0);
    process(0, R0, bufs);
    load_raw(1, R1);
    load_raw(2, R2);
    load_raw(3, R3);
    load_raw(4, R0);
    lds_barrier();
    for (int ch = 0; ch < NCH; ch += 4) {
      if (ch > 0) bulk(ch - 1);
      process(ch + 1, R1, bufs + BW);
      load_raw(ch + 5, R1);
      lds_barrier();
      bulk(ch);
      process(ch + 2, R2, bufs);
      load_raw(ch + 6, R2);
      lds_barrier();
      bulk(ch + 1);
      process(ch + 3, R3, bufs + BW);
      load_raw(ch + 7, R3);
      lds_barrier();
      bulk(ch + 2);
      process(ch + 4, R0, bufs);
      load_raw(ch + 8, R0);
      lds_barrier();
    }
    lds_barrier();
    bulk(NCH - 1);
  } else {
    const int rp = tid >> 3, ks = tid & 7;
    float S[16];
#pragma unroll
    for (int i = 0; i < 16; ++i) S[i] = 0.f;
    lds_barrier();
    for (int ch = 0; ch < NCH; ++ch) {
      const float* buf = bufs + (ch & 1) * BW;
      struct Ops { float4 r4[2], w4[2], kd4[2], kk4[2], bb4[2]; float2 vv; };
      auto fetch = [&](Ops& o, int tt) {
        const float* bs = buf + tt * 64 + ks * 8;
#pragma unroll
        for (int i = 0; i < 2; ++i) {
          o.r4[i] = *(const float4*)(bs + 0 * 512 + i * 4);
          o.w4[i] = *(const float4*)(bs + 1 * 512 + i * 4);
          o.kd4[i] = *(const float4*)(bs + 2 * 512 + i * 4);
          o.kk4[i] = *(const float4*)(bs + 3 * 512 + i * 4);
          o.bb4[i] = *(const float4*)(bs + 4 * 512 + i * 4);
        }
        o.vv = *(const float2*)(buf + 5 * 512 + tt * 64 + rp * 2);
      };
      auto compute = [&](const Ops& o, int tt) {
        float dotA = 0.f, dotB = 0.f;
#pragma unroll
        for (int i = 0; i < 2; ++i) {
          dotA = fmaf(S[i * 4 + 0], o.kk4[i].x, dotA); dotA = fmaf(S[i * 4 + 1], o.kk4[i].y, dotA);
          dotA = fmaf(S[i * 4 + 2], o.kk4[i].z, dotA); dotA = fmaf(S[i * 4 + 3], o.kk4[i].w, dotA);
          dotB = fmaf(S[8 + i * 4 + 0], o.kk4[i].x, dotB); dotB = fmaf(S[8 + i * 4 + 1], o.kk4[i].y, dotB);
          dotB = fmaf(S[8 + i * 4 + 2], o.kk4[i].z, dotB); dotB = fmaf(S[8 + i * 4 + 3], o.kk4[i].w, dotB);
        }
        dotA = sum8(dotA);
        dotB = sum8(dotB);
        float yA = 0.f, yB = 0.f;
#pragma unroll
        for (int i = 0; i < 2; ++i) {
          S[i * 4 + 0] = S[i * 4 + 0] * o.w4[i].x + (o.vv.x * o.kd4[i].x - dotA * o.bb4[i].x);
          S[i * 4 + 1] = S[i * 4 + 1] * o.w4[i].y + (o.vv.x * o.kd4[i].y - dotA * o.bb4[i].y);
          S[i * 4 + 2] = S[i * 4 + 2] * o.w4[i].z + (o.vv.x * o.kd4[i].z - dotA * o.bb4[i].z);
          S[i * 4 + 3] = S[i * 4 + 3] * o.w4[i].w + (o.vv.x * o.kd4[i].w - dotA * o.bb4[i].w);
          S[8 + i * 4 + 0] = S[8 + i * 4 + 0] * o.w4[i].x + (o.vv.y * o.kd4[i].x - dotB * o.bb4[i].x);
          S[8 + i * 4 + 1] = S[8 + i * 4 + 1] * o.w4[i].y + (o.vv.y * o.kd4[i].y - dotB * o.bb4[i].y);
          S[8 + i * 4 + 2] = S[8 + i * 4 + 2] * o.w4[i].z + (o.vv.y * o.kd4[i].z - dotB * o.bb4[i].z);
          S[8 + i * 4 + 3] = S[8 + i * 4 + 3] * o.w4[i].w + (o.vv.y * o.kd4[i].w - dotB * o.bb4[i].w);
          yA = fmaf(S[i * 4 + 0], o.r4[i].x, yA); yA = fmaf(S[i * 4 + 1], o.r4[i].y, yA);
          yA = fmaf(S[i * 4 + 2], o.r4[i].z, yA); yA = fmaf(S[i * 4 + 3], o.r4[i].w, yA);
          yB = fmaf(S[8 + i * 4 + 0], o.r4[i].x, yB); yB = fmaf(S[8 + i * 4 + 1], o.r4[i].y, yB);
          yB = fmaf(S[8 + i * 4 + 2], o.r4[i].z, yB); yB = fmaf(S[8 + i * 4 + 3], o.r4[i].w, yB);
        }
        *(float2*)(ybuf + ((((ch & 1) * 8 + tt) * 32 + rp) * 8 + ks) * 2) = make_float2(yA, yB);
      };
      Ops o0, o1;
      fetch(o0, 0);
#pragma unroll 2
      for (int tt = 0; tt < 8; tt += 2) {
        fetch(o1, tt + 1);
        compute(o0, tt);
        fetch(o0, tt + 2 < 8 ? tt + 2 : 7);
        compute(o1, tt + 1);
      }
      lds_barrier();
    }
    lds_barrier();
  }
  lds_barrier();
}

DEVI void unpack8(uint4 v, float* f) {
  unsigned w[4] = {v.x, v.y, v.z, v.w};
#pragma unroll
  for (int i = 0; i < 4; ++i) { f[2 * i] = __uint_as_float(w[i] << 16); f[2 * i + 1] = __uint_as_float(w[i] & 0xFFFF0000u); }
}
DEVI void ph_rwkv_post(const Params& p, int gw, int nw) {
  const int lane = threadIdx.x & 63;
  const u16* P = (const u16*)(p.ws + OFF_BIG + B0_P);
  const u16* YR = (const u16*)(p.ws + OFF_BIG + B0_YR);
  const u16* G = (const u16*)(p.ws + OFF_BIG + B0_G);
  const float* RK = (const float*)(p.ws + OFF_RK);
  u16* CAT = (u16*)(p.ws + OFF_H);
  const int c0 = lane * 16, h = lane >> 2;
  for (int row = gw; row < T; row += nw) {
    int pos = row % LT;
    bool first = (pos == 0 || pos == CL), last = (pos == CL - 1 || pos == LT - 1);
    const u16* y0p = YR + (size_t)row * 1024 + c0;
    const u16* y1p = YR + (size_t)(T + row) * 1024 + c0;
    const u16* vp = P + (size_t)row * AB_INP + 2048 + c0;
    const u16* vpp = first ? vp : vp - AB_INP;
    const u16* vnp = last ? vp : vp + AB_INP;
    const u16* gp = G + (size_t)row * 1024 + c0;
    uint4 ra[2], rb[2], rv[2], rvp[2], rvn[2], rg[2];
#pragma unroll
    for (int i = 0; i < 2; ++i) {
      ra[i] = *(const uint4*)(y0p + i * 8); rb[i] = *(const uint4*)(y1p + i * 8);
      rv[i] = *(const uint4*)(vp + i * 8); rvp[i] = *(const uint4*)(vpp + i * 8); rvn[i] = *(const uint4*)(vnp + i * 8);
      rg[i] = *(const uint4*)(gp + i * 8);
    }
    const float rk = RK[(size_t)row * 16 + h] + RK[(size_t)(T + row) * 16 + h];
    const float fm = first ? 0.f : 1.f, lm = last ? 0.f : 1.f;
    float y[16], s1 = 0.f;
#pragma unroll
    for (int i = 0; i < 2; ++i) {
      float a[8], bq[8];
      unpack8(ra[i], a); unpack8(rb[i], bq);
#pragma unroll
      for (int e = 0; e < 8; ++e) { y[i * 8 + e] = a[e] + bq[e]; s1 += y[i * 8 + e]; }
    }
    s1 += dpp_xor1(s1); s1 += dpp_xor2(s1);
    const float mean = s1 * (1.f / 64.f);
    float s2 = 0.f;
#pragma unroll
    for (int e = 0; e < 16; ++e) { y[e] -= mean; s2 += y[e] * y[e]; }
    s2 += dpp_xor1(s2); s2 += dpp_xor2(s2);
    const float rs = rsqrtf(s2 * (1.f / 64.f) + 64e-5f);
#pragma unroll
    for (int i = 0; i < 2; ++i) {
      float vc[8], vq[8], vn[8], gg[8];
      unpack8(rv[i], vc); unpack8(rvp[i], vq); unpack8(rvn[i], vn); unpack8(rg[i], gg);
      unsigned o[4];
      const int cb = c0 + i * 8;
      float m0[8], m1[8], lg[8], lb[8];
      *(float4*)m0 = *(const float4*)(p.rwkv_mu + 2048 + cb); *(float4*)(m0 + 4) = *(const float4*)(p.rwkv_mu + 2048 + cb + 4);
      *(float4*)m1 = *(const float4*)(p.rwkv_mu + RCOLS + 2048 + cb); *(float4*)(m1 + 4) = *(const float4*)(p.rwkv_mu + RCOLS + 2048 + cb + 4);
      *(float4*)lg = *(const float4*)(p.rwkv_ln_g + cb); *(float4*)(lg + 4) = *(const float4*)(p.rwkv_ln_g + cb + 4);
      *(float4*)lb = *(const float4*)(p.rwkv_ln_b + cb); *(float4*)(lb + 4) = *(const float4*)(p.rwkv_ln_b + cb + 4);
#pragma unroll
      for (int e2 = 0; e2 < 4; ++e2) {
        float r2[2];
#pragma unroll
        for (int q = 0; q < 2; ++q) {
          int e = e2 * 2 + q;
          float v = vc[e] + m0[e] * (vq[e] * fm - vc[e]) + m1[e] * (vn[e] * lm - vc[e]);
          r2[q] = (y[i * 8 + e] * rs * lg[e] + lb[e] + rk * v) * gg[e];
        }
        o[e2] = pack2(r2[0], r2[1]);
      }
      *(uint4*)(CAT + (size_t)row * D + c0 + i * 8) = make_uint4(o[0], o[1], o[2], o[3]);
    }
  }
}

DEVI void ph_cd_prep(const Params& p, int bid, int nb, char* smem) {
  u16* P = (u16*)(p.ws + OFF_BIG + B1_P);
  u16* XBC = (u16*)(p.ws + OFF_BIG + B1_XBC);
  float* DT = (float*)(p.ws + OFF_DT);
  const size_t gtid = (size_t)bid * NTH + threadIdx.x, gstride = (size_t)nb * NTH;
  float2* tab = (float2*)smem;
  for (int i = threadIdx.x; i < 64 * 16; i += NTH) {
    int v = i >> 4, f = i & 15;
    float inv = exp2f(-(float)f * (13.287712379549449f / 16.f));
    float sn, cs;
    sincosf((float)v * inv, &sn, &cs);
    tab[i] = make_float2(cs, sn);
  }
  __syncthreads();
  for (size_t it = gtid; it < (size_t)T * 384; it += gstride) {
    int row = (int)(it / 384), c = (int)(it % 384) * 8;
    int pos = row % LT;
    int lo = pos < CL ? 0 : CL, hi = pos < CL ? CL : LT;
    float acc[8];
    {
      float4 b0 = *(const float4*)(p.ssd_conv_b + c), b1 = *(const float4*)(p.ssd_conv_b + c + 4);
      acc[0] = b0.x; acc[1] = b0.y; acc[2] = b0.z; acc[3] = b0.w; acc[4] = b1.x; acc[5] = b1.y; acc[6] = b1.z; acc[7] = b1.w;
    }
    uint4 xv[5];
#pragma unroll
    for (int j = 0; j < 5; ++j) {
      int pp = pos + j - 2;
      bool ok = (pp >= lo && pp < hi);
      xv[j] = *(const uint4*)(P + (size_t)(ok ? row + j - 2 : row) * CD_INP + 2048 + c);
    }
#pragma unroll
    for (int j = 0; j < 5; ++j) {
      int pp = pos + j - 2;
      float m = (pp >= lo && pp < hi) ? 1.f : 0.f;
      float x[8];
      unpack8(xv[j], x);
      float4 w0 = *(const float4*)(p.ssd_conv_w + j * 3072 + c), w1 = *(const float4*)(p.ssd_conv_w + j * 3072 + c + 4);
      acc[0] += m * w0.x * x[0]; acc[1] += m * w0.y * x[1]; acc[2] += m * w0.z * x[2]; acc[3] += m * w0.w * x[3];
      acc[4] += m * w1.x * x[4]; acc[5] += m * w1.y * x[5]; acc[6] += m * w1.z * x[6]; acc[7] += m * w1.w * x[7];
    }
    unsigned o[4];
#pragma unroll
    for (int e = 0; e < 4; ++e) {
      float a0 = acc[2 * e], a1 = acc[2 * e + 1];
      o[e] = pack2(a0 * sigmoidf(a0), a1 * sigmoidf(a1));
    }
    *(uint4*)(XBC + (size_t)row * 3072 + c) = make_uint4(o[0], o[1], o[2], o[3]);
  }
  for (size_t it = gtid; it < (size_t)T * 64; it += gstride) {
    int row = (int)(it >> 6), dh = (int)(it & 63);
    float x = bf2f(P[(size_t)row * CD_INP + 5120 + dh]) + p.ssd_dt_bias[dh];
    float sp = x > 20.f ? x : log1pf(expf(x));
    DT[((size_t)(dh >> 5) * T + row) * 32 + (dh & 31)] = sp;
  }
  for (size_t it = gtid; it < (size_t)NB * SEQ * 40; it += gstride) {
    int a = (int)(it & 1), hh = (int)((it >> 1) % 20);
    int tok = (int)(it / 40);
    int b = tok / SEQ, xp = tok % SEQ;
    int row = b * LT + CL + xp;
    int colbase = (hh < 16 ? 5184 + hh * 64 : 6208 + (hh - 16) * 64) + a * 32;
    const float2* tb = tab + (a == 0 ? (xp >> 6) : (xp & 63)) * 16;
    u16* q1 = P + (size_t)row * CD_INP + colbase;
    uint4 l0 = *(const uint4*)q1, l1 = *(const uint4*)(q1 + 8), h0 = *(const uint4*)(q1 + 16), h1 = *(const uint4*)(q1 + 24);
    float x1[16], x2[16];
    unpack8(l0, x1); unpack8(l1, x1 + 8); unpack8(h0, x2); unpack8(h1, x2 + 8);
    unsigned o1[8], o2[8];
#pragma unroll
    for (int e = 0; e < 8; ++e) {
      float2 t0 = tb[2 * e], t1 = tb[2 * e + 1];
      o1[e] = pack2(x1[2 * e] * t0.x - x2[2 * e] * t0.y, x1[2 * e + 1] * t1.x - x2[2 * e + 1] * t1.y);
      o2[e] = pack2(x1[2 * e] * t0.y + x2[2 * e] * t0.x, x1[2 * e + 1] * t1.y + x2[2 * e + 1] * t1.x);
    }
    *(uint4*)q1 = make_uint4(o1[0], o1[1], o1[2], o1[3]);
    *(uint4*)(q1 + 8) = make_uint4(o1[4], o1[5], o1[6], o1[7]);
    *(uint4*)(q1 + 16) = make_uint4(o2[0], o2[1], o2[2], o2[3]);
    *(uint4*)(q1 + 24) = make_uint4(o2[4], o2[5], o2[6], o2[7]);
  }
}

DEVI void ph_ssd_scan(const Params& p, int blk, char* smem) {
  const int d = blk & 1, h = (blk >> 1) & 31, b = blk >> 6;
  const int g = h >> 3;
  const int tid = threadIdx.x, wid = __builtin_amdgcn_readfirstlane(tid >> 6), lane = tid & 63, fr = lane & 15, fq = lane >> 4;
  const int lt = wid & 3, ph = wid >> 2;
  const int spt = wid & 3, snt0 = (wid >> 2) * 4;
  u16* Cs = (u16*)smem;
  u16* Bs = Cs + 64 * 136;
  u16* BTs = Bs + 64 * 136;
  u16* XT0 = BTs + 128 * 72;
  u16* XT1 = XT0 + 64 * 72;
  u16* Hb = XT1 + 64 * 72;
  float* cumt = (float*)(Hb + 64 * 136);
  const u16* XBC = (const u16*)(p.ws + OFF_BIG + B1_XBC);
  const float* DT = (const float*)(p.ws + OFF_DT) + (size_t)d * T * 32;
  u16* Y = d == 0 ? (u16*)(p.ws + OFF_H) : (u16*)(p.ws + OFF_BIG + B1_YB);
  const float A = -expf(p.ssd_A_log[d * 32 + h]);
  for (int i = tid; i < 64 * 136; i += NTH) Hb[i] = 0;
  f32x4 hst[4];
#pragma unroll
  for (int i = 0; i < 4; ++i) hst[i] = (f32x4){0.f, 0.f, 0.f, 0.f};
  const int ss = tid >> 3, sg = tid & 7;
  uint4 rB0, rB1, rC0, rC1, rX;
  float rdt;
  auto load_raw = [&](int ch) {
    int row = b * LT + dirpos(d, ch * 64 + ss);
    const u16* base = XBC + (size_t)row * 3072;
    rB0 = *(const uint4*)(base + 2048 + g * 128 + sg * 16);
    rB1 = *(const uint4*)(base + 2048 + g * 128 + sg * 16 + 8);
    rC0 = *(const uint4*)(base + 2560 + g * 128 + sg * 16);
    rC1 = *(const uint4*)(base + 2560 + g * 128 + sg * 16 + 8);
    rX = *(const uint4*)(base + h * 64 + sg * 8);
    int rowl = b * LT + dirpos(d, ch * 64 + lane);
    rdt = DT[(size_t)rowl * 32 + h];
  };
  constexpr int NCH = LT / 64;
  load_raw(0);
  for (int ch = 0; ch < NCH; ++ch) {
    float cum = rdt * A;
#pragma unroll
    for (int off = 1; off < 64; off <<= 1) {
      float t = __shfl_up(cum, off);
      if (lane >= off) cum += t;
    }
    const float cum63 = __shfl(cum, 63);
    const float my_cum = __shfl(cum, ss), my_dt = __shfl(rdt, ss);
    __syncthreads();
    {
      *(uint4*)(Bs + ss * 136 + sg * 16) = rB0;
      *(uint4*)(Bs + ss * 136 + sg * 16 + 8) = rB1;
      *(uint4*)(Cs + ss * 136 + sg * 16) = rC0;
      *(uint4*)(Cs + ss * 136 + sg * 16 + 8) = rC1;
      unsigned wb[8] = {rB0.x, rB0.y, rB0.z, rB0.w, rB1.x, rB1.y, rB1.z, rB1.w};
#pragma unroll
      for (int e = 0; e < 8; ++e) {
        BTs[(sg * 16 + 2 * e) * 72 + ss] = (u16)(wb[e] & 0xFFFFu);
        BTs[(sg * 16 + 2 * e + 1) * 72 + ss] = (u16)(wb[e] >> 16);
      }
      unsigned wx[4] = {rX.x, rX.y, rX.z, rX.w};
      const float s0 = my_dt, s1 = my_dt * __expf(cum63 - my_cum);
#pragma unroll
      for (int e = 0; e < 4; ++e) {
        float x0 = __uint_as_float(wx[e] << 16), x1 = __uint_as_float(wx[e] & 0xFFFF0000u);
        XT0[(sg * 8 + 2 * e) * 72 + ss] = f2bf(x0 * s0);
        XT0[(sg * 8 + 2 * e + 1) * 72 + ss] = f2bf(x1 * s0);
        XT1[(sg * 8 + 2 * e) * 72 + ss] = f2bf(x0 * s1);
        XT1[(sg * 8 + 2 * e + 1) * 72 + ss] = f2bf(x1 * s1);
      }
      if (wid == 0) cumt[lane] = cum;
#pragma unroll
      for (int i = 0; i < 4; ++i)
#pragma unroll
        for (int j = 0; j < 4; ++j) Hb[(spt * 16 + fq * 4 + j) * 136 + (snt0 + i) * 16 + fr] = f2bf(hst[i][j]);
    }
    __syncthreads();
    load_raw(ch + 1 < NCH ? ch + 1 : ch);
    if (ch >= CL / 64) {
      bf16x8 cf[4];
#pragma unroll
      for (int kn = 0; kn < 4; ++kn) cf[kn] = *(const bf16x8*)(Cs + (lt * 16 + fr) * 136 + kn * 32 + fq * 8);
      const float cl = cumt[lt * 16 + fr];
      float pv[4][4];
#pragma unroll
      for (int st = 0; st < 4; ++st) {
        if (st <= lt) {
          f32x4 acc = (f32x4){0.f, 0.f, 0.f, 0.f};
#pragma unroll
          for (int kn = 0; kn < 4; ++kn) {
            bf16x8 a = *(const bf16x8*)(Bs + (st * 16 + fr) * 136 + kn * 32 + fq * 8);
            acc = __builtin_amdgcn_mfma_f32_16x16x32_bf16(a, cf[kn], acc, 0, 0, 0);
          }
          const float4 cs4 = *(const float4*)(cumt + st * 16 + fq * 4);
          const float csv[4] = {cs4.x, cs4.y, cs4.z, cs4.w};
#pragma unroll
          for (int j = 0; j < 4; ++j) {
            const int sidx = st * 16 + fq * 4 + j, lidx = lt * 16 + fr;
            float w = acc[j] * __expf(fminf(cl - csv[j], 0.f));
            pv[st][j] = (sidx <= lidx) ? w : 0.f;
          }
        } else {
#pragma unroll
          for (int j = 0; j < 4; ++j) pv[st][j] = 0.f;
        }
      }
      bf16x8 pb[2];
#pragma unroll
      for (int ks = 0; ks < 2; ++ks) {
        pb[ks] = mk_bf16x8(pack2(pv[ks * 2][0], pv[ks * 2][1]), pack2(pv[ks * 2][2], pv[ks * 2][3]),
                           pack2(pv[ks * 2 + 1][0], pv[ks * 2 + 1][1]), pack2(pv[ks * 2 + 1][2], pv[ks * 2 + 1][3]));
      }
      const float ecl = __expf(cl);
      const int orow = b * LT + dirpos(d, ch * 64 + lt * 16 + fr);
#pragma unroll
      for (int pi = 0; pi < 2; ++pi) {
        const int pt = ph * 2 + pi;
        f32x4 ya = (f32x4){0.f, 0.f, 0.f, 0.f};
#pragma unroll
        for (int kn = 0; kn < 4; ++kn) {
          bf16x8 a = *(const bf16x8*)(Hb + (pt * 16 + fr) * 136 + kn * 32 + fq * 8);
          ya = __builtin_amdgcn_mfma_f32_16x16x32_bf16(a, cf[kn], ya, 0, 0, 0);
        }
        ya *= ecl;
#pragma unroll
        for (int ks = 0; ks < 2; ++ks) {
          if (ks * 2 <= lt) {
            const u16* xp = XT0 + (pt * 16 + fr) * 72 + ks * 32 + fq * 4;
            uint2 lo = *(const uint2*)xp, hi = *(const uint2*)(xp + 16);
            ya = __builtin_amdgcn_mfma_f32_16x16x32_bf16(mk_bf16x8(lo.x, lo.y, hi.x, hi.y), pb[ks], ya, 0, 0, 0);
          }
        }
        *(uint2*)(Y + (size_t)orow * 2048 + h * 64 + pt * 16 + fq * 4) = make_uint2(pack2(ya[0], ya[1]), pack2(ya[2], ya[3]));
      }
    }
    {
      const float e63 = __expf(cum63);
      bf16x8 xa[2];
#pragma unroll
      for (int ks = 0; ks < 2; ++ks) xa[ks] = *(const bf16x8*)(XT1 + (spt * 16 + fr) * 72 + ks * 32 + fq * 8);
#pragma unroll
      for (int i = 0; i < 4; ++i) {
        f32x4 acc = hst[i] * e63;
#pragma unroll
        for (int ks = 0; ks < 2; ++ks) {
          bf16x8 bq = *(const bf16x8*)(BTs + ((snt0 + i) * 16 + fr) * 72 + ks * 32 + fq * 8);
          acc = __builtin_amdgcn_mfma_f32_16x16x32_bf16(xa[ks], bq, acc, 0, 0, 0);
        }
        hst[i] = acc;
      }
    }
  }
  __syncthreads();
}

DEVI void ph_attn(const Params& p, int first_blk, int nblk, char* smem) {
  const int tid = threadIdx.x, wid = tid >> 6, lane = tid & 63;
  const int fr = lane & 15, fq = lane >> 4;
  const int hr = wid & 3, qsub = wid >> 2;
  u16* Ks = (u16*)smem;
  u16* VTs = Ks + 64 * 72;
  const u16* P = (const u16*)(p.ws + OFF_BIG + B1_P);
  u16* CAT = (u16*)(p.ws + OFF_BIG + B1_CAT);
  for (int task = first_blk; task < NB * 4 * 64; task += nblk) {
    const int qt = task & 63, hkv = (task >> 6) & 3, b = task >> 8;
    const int hq = hkv * 4 + hr;
    const int q0 = qt * 64;
    const int qw0 = q0 + qsub * 32;
    bf16x8 qf[2][2];
#pragma unroll
    for (int nt = 0; nt < 2; ++nt) {
      const u16* qp = P + (size_t)(b * LT + CL + qw0 + nt * 16 + fr) * CD_INP + 5184 + hq * 64 + fq * 8;
#pragma unroll
      for (int ks = 0; ks < 2; ++ks) {
        uint4 v = *(const uint4*)(qp + ks * 32);
        unsigned w[4] = {v.x, v.y, v.z, v.w};
        unsigned o[4];
#pragma unroll
        for (int e = 0; e < 4; ++e)
          o[e] = pack2(__uint_as_float(w[e] << 16) * 0.125f, __uint_as_float(w[e] & 0xFFFF0000u) * 0.125f);
        qf[nt][ks] = mk_bf16x8(o[0], o[1], o[2], o[3]);
      }
    }
    f32x4 O[4][2];
#pragma unroll
    for (int dt = 0; dt < 4; ++dt)
#pragma unroll
      for (int nt = 0; nt < 2; ++nt) O[dt][nt] = (f32x4){0.f, 0.f, 0.f, 0.f};
    float mrun[2], lrun[2];
    const float sink = p.attn_sink[hq];
#pragma unroll
    for (int nt = 0; nt < 2; ++nt) { mrun[nt] = sink; lrun[nt] = fq == 0 ? 1.f : 0.f; }
    const int kb0 = max(0, q0 - 128), kb1 = min(SEQ, q0 + 64 + 128);
    const int nband = (kb1 - kb0) >> 6;
    for (int tile = 0; tile < 4 + nband; ++tile) {
      const bool isctx = tile < 4;
      const int kbase = isctx ? tile * 64 : kb0 + (tile - 4) * 64;
      const int krow0 = b * LT + (isctx ? kbase : CL + kbase);
      __syncthreads();
      {
        int key = tid >> 3, seg = tid & 7;
        uint4 kv = *(const uint4*)(P + (size_t)(krow0 + key) * CD_INP + 6208 + hkv * 64 + seg * 8);
        *(uint4*)(Ks + key * 72 + seg * 8) = kv;
        int key2 = tid & 63, seg2 = tid >> 6;
        uint4 vv = *(const uint4*)(P + (size_t)(krow0 + key2) * CD_INP + 6464 + hkv * 64 + seg2 * 8);
        unsigned w[4] = {vv.x, vv.y, vv.z, vv.w};
#pragma unroll
        for (int e = 0; e < 4; ++e) {
          VTs[(seg2 * 8 + 2 * e) * 72 + key2] = (u16)(w[e] & 0xFFFFu);
          VTs[(seg2 * 8 + 2 * e + 1) * 72 + key2] = (u16)(w[e] >> 16);
        }
      }
      __syncthreads();
      f32x4 ST[4][2];
#pragma unroll
      for (int mt = 0; mt < 4; ++mt) {
        bf16x8 a0 = *(const bf16x8*)(Ks + (mt * 16 + fr) * 72 + fq * 8);
        bf16x8 a1 = *(const bf16x8*)(Ks + (mt * 16 + fr) * 72 + 32 + fq * 8);
#pragma unroll
        for (int nt = 0; nt < 2; ++nt) {
          f32x4 z = (f32x4){0.f, 0.f, 0.f, 0.f};
          z = __builtin_amdgcn_mfma_f32_16x16x32_bf16(a0, qf[nt][0], z, 0, 0, 0);
          ST[mt][nt] = __builtin_amdgcn_mfma_f32_16x16x32_bf16(a1, qf[nt][1], z, 0, 0, 0);
        }
      }
      if (!isctx) {
#pragma unroll
        for (int mt = 0; mt < 4; ++mt)
#pragma unroll
          for (int nt = 0; nt < 2; ++nt)
#pragma unroll
            for (int j = 0; j < 4; ++j) {
              int dlt = (qw0 + nt * 16 + fr) - (kbase + mt * 16 + fq * 4 + j);
              if (dlt > 128 || dlt < -128) ST[mt][nt][j] = -INFINITY;
            }
      }
      bf16x8 pb[2][2];
#pragma unroll
      for (int nt = 0; nt < 2; ++nt) {
        float mx = -INFINITY;
#pragma unroll
        for (int mt = 0; mt < 4; ++mt)
#pragma unroll
          for (int j = 0; j < 4; ++j) mx = fmaxf(mx, ST[mt][nt][j]);
        mx = fmaxf(mx, __shfl_xor(mx, 16));
        mx = fmaxf(mx, __shfl_xor(mx, 32));
        float mn = fmaxf(mrun[nt], mx);
        float alpha = __expf(mrun[nt] - mn);
        mrun[nt] = mn;
        float ls = 0.f;
        float pv[4][4];
#pragma unroll
        for (int mt = 0; mt < 4; ++mt)
#pragma unroll
          for (int j = 0; j < 4; ++j) { pv[mt][j] = __expf(ST[mt][nt][j] - mn); ls += pv[mt][j]; }
        lrun[nt] = lrun[nt] * alpha + ls;
#pragma unroll
        for (int dt = 0; dt < 4; ++dt) O[dt][nt] *= alpha;
#pragma unroll
        for (int ks = 0; ks < 2; ++ks) {
          pb[nt][ks] = mk_bf16x8(pack2(pv[ks * 2][0], pv[ks * 2][1]), pack2(pv[ks * 2][2], pv[ks * 2][3]),
                                 pack2(pv[ks * 2 + 1][0], pv[ks * 2 + 1][1]), pack2(pv[ks * 2 + 1][2], pv[ks * 2 + 1][3]));
        }
      }
#pragma unroll
      for (int dt = 0; dt < 4; ++dt)
#pragma unroll
        for (int ks = 0; ks < 2; ++ks) {
          const u16* vp = VTs + (dt * 16 + fr) * 72 + ks * 32 + fq * 4;
          uint2 lo = *(const uint2*)vp, hi = *(const uint2*)(vp + 16);
          bf16x8 a = mk_bf16x8(lo.x, lo.y, hi.x, hi.y);
#pragma unroll
          for (int nt = 0; nt < 2; ++nt) O[dt][nt] = __builtin_amdgcn_mfma_f32_16x16x32_bf16(a, pb[nt][ks], O[dt][nt], 0, 0, 0);
        }
    }
#pragma unroll
    for (int nt = 0; nt < 2; ++nt) {
      float l = lrun[nt];
      l += __shfl_xor(l, 16);
      l += __shfl_xor(l, 32);
      float inv = 1.f / l;
      u16* op = CAT + (size_t)(b * LT + CL + qw0 + nt * 16 + fr) * 3072 + 2048 + hq * 64 + fq * 4;
#pragma unroll
      for (int dt = 0; dt < 4; ++dt)
        *(uint2*)(op + dt * 16) = make_uint2(cvt_pk_bf16(O[dt][nt][0] * inv, O[dt][nt][1] * inv), cvt_pk_bf16(O[dt][nt][2] * inv, O[dt][nt][3] * inv));
    }
  }
}

DEVI void ph_ssd_combine(const Params& p, int gw, int nw) {
  int lane = threadIdx.x & 63;
  const u16* P = (const u16*)(p.ws + OFF_BIG + B1_P);
  const u16* XBC = (const u16*)(p.ws + OFF_BIG + B1_XBC);
  const u16* YF = (const u16*)(p.ws + OFF_H);
  const u16* YB = (const u16*)(p.ws + OFF_BIG + B1_YB);
  u16* CAT = (u16*)(p.ws + OFF_BIG + B1_CAT);
  for (int it = gw; it < NB * SEQ * 4; it += nw) {
    int grp = it & 3, tok = it >> 2;
    int row = (tok / SEQ) * LT + CL + (tok % SEQ);
    int ch = grp * 512 + lane * 8;
    float dsk = p.ssd_D[ch >> 6];
    uint4 yf = *(const uint4*)(YF + (size_t)row * 2048 + ch), yb = *(const uint4*)(YB + (size_t)row * 2048 + ch);
    uint4 xv = *(const uint4*)(XBC + (size_t)row * 3072 + ch), zv = *(const uint4*)(P + (size_t)row * CD_INP + ch);
    unsigned a[4] = {yf.x, yf.y, yf.z, yf.w}, bq[4] = {yb.x, yb.y, yb.z, yb.w}, xq[4] = {xv.x, xv.y, xv.z, xv.w},
             zq[4] = {zv.x, zv.y, zv.z, zv.w};
    float y[8];
    float ss = 0.f;
#pragma unroll
    for (int i = 0; i < 4; ++i) {
#pragma unroll
      for (int e = 0; e < 2; ++e) {
        float f = e ? __uint_as_float(a[i] & 0xFFFF0000u) : __uint_as_float(a[i] << 16);
        float bb = e ? __uint_as_float(bq[i] & 0xFFFF0000u) : __uint_as_float(bq[i] << 16);
        float xx = e ? __uint_as_float(xq[i] & 0xFFFF0000u) : __uint_as_float(xq[i] << 16);
        float zz = e ? __uint_as_float(zq[i] & 0xFFFF0000u) : __uint_as_float(zq[i] << 16);
        float v = (f + bb + dsk * xx) * (zz * sigmoidf(zz));
        y[i * 2 + e] = v;
        ss += v * v;
      }
    }
    ss = wave_sum(ss);
    float sc = rsqrtf(ss * (1.f / 512.f) + 1e-6f);
    float4 g0 = *(const float4*)(p.ssd_norm_g + ch), g1 = *(const float4*)(p.ssd_norm_g + ch + 4);
    *(uint4*)(CAT + (size_t)row * 3072 + ch) =
        make_uint4(pack2(y[0] * sc * g0.x, y[1] * sc * g0.y), pack2(y[2] * sc * g0.z, y[3] * sc * g0.w),
                   pack2(y[4] * sc * g1.x, y[5] * sc * g1.y), pack2(y[6] * sc * g1.z, y[7] * sc * g1.w));
  }
}

DEVI void ph_final(const Params& p, int gw, int nw) {
  int lane = threadIdx.x & 63;
  for (int it = gw; it < NB * SEQ; it += nw) {
    float* row = p.out + (size_t)it * D;
    float4 v[8];
    float ss = 0.f;
#pragma unroll
    for (int i = 0; i < 8; ++i) {
      v[i] = *(const float4*)(row + (i * 64 + lane) * 4);
      ss += v[i].x * v[i].x + v[i].y * v[i].y + v[i].z * v[i].z + v[i].w * v[i].w;
    }
    ss = wave_sum(ss);
    float rs = rsqrtf(ss * (1.f / D) + 1e-6f);
#pragma unroll
    for (int i = 0; i < 8; ++i) {
      int c = (i * 64 + lane) * 4;
      float4 g = *(const float4*)(p.final_g + c);
      *(float4*)(row + c) = make_float4(v[i].x * rs * g.x, v[i].y * rs * g.y, v[i].z * rs * g.z, v[i].w * rs * g.w);
    }
  }
}

#include <vector>

#define XB_TMO      128
#define XB_XCNT(j)  (256  + 64 * (j))
#define XB_XSUB(j)  (1280 + 64 * (j))
#define XB_XGEN(j)  (2304 + 64 * (j))
#define XB_TOP      3328
#define XB_TOPGEN   3392
#define XCD_BAR_WORDS 3456
#define XB_SPIN_CAP (1u << 21)

__device__ __forceinline__ unsigned xb_ld(unsigned* p)              { return __hip_atomic_load(p, __ATOMIC_RELAXED, __HIP_MEMORY_SCOPE_AGENT); }
__device__ __forceinline__ unsigned xb_add(unsigned* p, unsigned v) { return __hip_atomic_fetch_add(p, v, __ATOMIC_RELAXED, __HIP_MEMORY_SCOPE_AGENT); }
__device__ __forceinline__ unsigned xb_xcc_id() { return (unsigned)__builtin_amdgcn_s_getreg((3 << 11) | 20) & 0xFu; }
#define XB_SPIN(cond, bar) do { unsigned _sp = 0; while (cond) { __builtin_amdgcn_s_sleep(1); \
    if ((++_sp & 255u) == 0u) { if (xb_ld(&(bar)[XB_TMO])) break; if (_sp > XB_SPIN_CAP) { atomicAdd(&(bar)[XB_TMO], 1u); break; } } } } while (0)

struct XcdBarrier {
    unsigned* bar; unsigned x;
    volatile LAS unsigned* st;
};

__device__ __forceinline__ XcdBarrier xcd_barrier_post(unsigned* bar, volatile LAS unsigned* st) {
    XcdBarrier b; b.bar = bar; b.x = xb_xcc_id(); b.st = st;
    if (threadIdx.x == 0) (void)xb_add(&bar[XB_XCNT(b.x)], 1u);
    return b;
}
__device__ __forceinline__ void xcd_barrier_complete(unsigned* bar, unsigned x, unsigned& nloc, unsigned& nx) {
    const unsigned G = gridDim.x * gridDim.y * gridDim.z;
    unsigned sum, cnt, mine, sp = 0u;
    for (;;) {
        sum = 0u; cnt = 0u; mine = 0u;
#pragma unroll
        for (unsigned j = 0; j < 16; ++j) { const unsigned c = xb_ld(&bar[XB_XCNT(j)]); sum += c; cnt += (c > 0u) ? 1u : 0u; mine = (j == x) ? c : mine; }
        if (sum == G) break;
        __builtin_amdgcn_s_sleep(1);
        if ((++sp & 255u) == 0u) { if (xb_ld(&bar[XB_TMO])) break; if (sp > XB_SPIN_CAP) { atomicAdd(&bar[XB_TMO], 1u); break; } }
    }
    nloc = mine > 0u ? mine : 1u; nx = cnt > 0u ? cnt : 1u;
}

__device__ __forceinline__ void xcd_barrier(const XcdBarrier& b) {
    asm volatile("s_waitcnt vmcnt(0)" ::: "memory");
    __syncthreads();
    if (threadIdx.x == 0) {
        unsigned* bar = b.bar;
        __builtin_amdgcn_s_waitcnt(0);
        unsigned nloc = b.st[0], nx = b.st[1];
        if (nloc == 0u) { xcd_barrier_complete(bar, b.x, nloc, nx); b.st[0] = nloc; b.st[1] = nx; }
        const unsigned old = xb_add(&bar[XB_XSUB(b.x)], 1u);
        const unsigned gen = old / nloc;
        if (old + 1u == (gen + 1u) * nloc) {
            __builtin_amdgcn_fence(__ATOMIC_RELEASE, "agent");
            asm volatile("s_waitcnt vmcnt(0)" ::: "memory");
            const unsigned og = xb_add(&bar[XB_TOP], 1u);
            const unsigned tg = og / nx;
            if (og + 1u == (tg + 1u) * nx) xb_add(&bar[XB_TOPGEN], 1u);
            else XB_SPIN(xb_ld(&bar[XB_TOPGEN]) == tg, bar);
            __builtin_amdgcn_fence(__ATOMIC_ACQUIRE, "agent");
            xb_add(&bar[XB_XGEN(b.x)], 1u);
            asm volatile("s_waitcnt vmcnt(0)" ::: "memory");
        } else {
            XB_SPIN(xb_ld(&bar[XB_XGEN(b.x)]) == gen, bar);
            __builtin_amdgcn_fence(__ATOMIC_ACQUIRE, "agent");
            asm volatile("s_waitcnt vmcnt(0)" ::: "memory");
        }
    }
    __syncthreads();
}


#ifndef REPEAT_MASK
#define REPEAT_MASK 0
#endif
#ifndef PROBE_K
#define PROBE_K -1
#define PROBE_ID 0
#endif
constexpr int NPH = 21;
constexpr int SMEM_BYTES = STAGE_BYTES + 16;

template <class Epi>
DEVI void run_gemm(const Params& p, LAS unsigned char* lds, const u16* A, const u16* Bt, int K, int nN, int xonly, int bid, int nb,
                   const Epi& E) {
  Order S;
  S.init(xonly ? 64 : 68, nN, nb, bid, xonly);
  Gemm g{A, Bt, xonly == 3 ? 1024 : K, K};
  gemm_phase(lds, g, S, E);
}

DEVI void run_phase(const Params& p, int ph, int bid, int nb, char* smem, LAS unsigned char* lds) {
  char* ws = p.ws;
  u16* H = (u16*)(ws + OFF_H);
  const int gw = bid * NWV + (threadIdx.x >> 6), nw = nb * NWV;
#ifdef ONLY_PHASE
  ph = ONLY_PHASE;
#endif
  switch (ph) {
    case 0:
      ph_mod(p, bid, nb, smem);
      __syncthreads();
      ph_convert(p, 0, bid, nb, smem);
      break;
    case 1: ph_norm(p, 0, 0, true, false, bid, nb); break;
    case 2:
      run_gemm(p, lds, H, (const u16*)(ws + OFF_W16 + W0_IN), D, AB_INP / 256, 0, bid, nb,
               EpiBf16<0>{(u16*)(ws + OFF_BIG + B0_P), AB_INP, 0, 0});
      break;
    case 3:
      ph_lora_in(p, bid, nb);
      ph_s5_pass1(p, gw, nw, smem);
      break;
    case 4:
      ph_s5_prefix(p, gw, nw);
      run_gemm(p, lds, (const u16*)(ws + OFF_BIG + B0_LIN), (const u16*)(ws + OFF_W16 + W0_LORA), 512, 20, 0, bid, nb,
               EpiBf16<0>{(u16*)(ws + OFF_BIG + B0_WL), 1024, 1024, (size_t)T * 1024});
      break;
    case 5:
      if (bid < 128) ph_rwkv_scan(p, bid, smem);
      else ph_s5_pass2(p, (bid - 128) * NWV + (threadIdx.x >> 6), (nb - 128) * NWV, smem);
      break;
    case 6:
      ph_rwkv_post(p, gw, nw);
      run_gemm(p, lds, (const u16*)(ws + OFF_BIG + B0_YG), (const u16*)(ws + OFF_W16 + W0_GLU), 1024, 4, 0, bid, nb,
               EpiGlu{(const u16*)(ws + OFF_BIG + B0_YG), H, p.s5_glu_b});
      break;
    case 7:
      run_gemm(p, lds, H, (const u16*)(ws + OFF_W16 + W0_OUT), D, 8, 0, bid, nb, EpiResid{p, 0, 2, 1});
      break;
    case 8: ph_norm(p, 0, 1, false, false, bid, nb); break;
    case 9:
      run_gemm(p, lds, H, (const u16*)(ws + OFF_W16 + W_W1), D, 32, 0, bid, nb, EpiBf16<1>{(u16*)(ws + OFF_BIG), DFF, 0, 0});
      break;
    case 10:
      run_gemm(p, lds, (const u16*)(ws + OFF_BIG), (const u16*)(ws + OFF_W16 + W_W2), DFF, 8, 1, bid, nb, EpiResid{p, 0, 5, 0});
      run_gemm(p, lds, (const u16*)(ws + OFF_BIG), (const u16*)(ws + OFF_W16 + W_W2), DFF, 8, 3, bid, nb,
               EpiPartial{(float*)(ws + OFF_BIG + B_PART)});
      break;
    case 11:
      ph_convert(p, 1, bid, nb, smem);
      ph_norm(p, 1, 0, false, false, bid, nb, true);
      break;
    case 12:
      run_gemm(p, lds, H, (const u16*)(ws + OFF_W16 + W1_IN), D, CD_INP / 256, 2, bid, nb,
               EpiBf16<0>{(u16*)(ws + OFF_BIG + B1_P), CD_INP, 0, 0});
      break;
    case 13: ph_cd_prep(p, bid, nb, smem); break;
    case 14:
      ph_ssd_scan(p, bid, smem);
      __syncthreads();
      ph_attn(p, bid, nb, smem);
      break;
    case 15: ph_ssd_combine(p, gw, nw); break;
    case 16:
      run_gemm(p, lds, (const u16*)(ws + OFF_BIG + B1_CAT), (const u16*)(ws + OFF_W16 + W1_OUT), 3072, 8, 1, bid, nb,
               EpiResid{p, 1, 2, 0});
      break;
    case 17: ph_norm(p, 1, 1, false, true, bid, nb); break;
    case 18:
      run_gemm(p, lds, H, (const u16*)(ws + OFF_W16 + W_W1), D, 32, 1, bid, nb, EpiBf16<1>{(u16*)(ws + OFF_BIG), DFF, 0, 0});
      break;
    case 19:
      run_gemm(p, lds, (const u16*)(ws + OFF_BIG), (const u16*)(ws + OFF_W16 + W_W2), DFF, 8, 1, bid, nb, EpiResid{p, 1, 5, 0});
      break;
    case 20: ph_final(p, gw, nw); break;
    case 105:
      if (bid >= 128) ph_s5_pass2(p, (bid - 128) * NWV + (threadIdx.x >> 6), (nb - 128) * NWV, smem);
      break;
    case 205:
      if (bid < 128) ph_rwkv_scan(p, bid, smem);
      break;
    case 114: ph_ssd_scan(p, bid, smem); break;
    case 214: ph_attn(p, bid, nb, smem); break;
    default: break;
  }
}

__global__ void __launch_bounds__(512, 2) fwd_megakernel(Params p) {
  extern __shared__ __attribute__((aligned(16))) unsigned char shm[];
  char* smem = (char*)shm;
  LAS unsigned char* lds = (LAS unsigned char*)shm;
  cg::grid_group grid = cg::this_grid();
  volatile LAS unsigned* bst = (volatile LAS unsigned*)(lds + STAGE_BYTES);
  if (threadIdx.x < 4) bst[threadIdx.x] = 0u;
  __syncthreads();
  const XcdBarrier xb = xcd_barrier_post((unsigned*)(p.ws + OFF_BAR), bst);
#define GSYNC(k) do { if ((k) == 0) grid.sync(); else xcd_barrier(xb); } while (0)
#define PHASE(k)                                                    \
  if (p.ph_lo <= (k) && (k) < p.ph_hi) {                            \
    run_phase(p, (k), blockIdx.x, gridDim.x, smem, lds);            \
    if ((REPEAT_MASK >> (k)) & 1) {                                 \
      GSYNC(k);                                                     \
      run_phase(p, (k), blockIdx.x, gridDim.x, smem, lds);          \
    }                                                               \
    if ((k) == PROBE_K) {                                           \
      GSYNC(k);                                                     \
      run_phase(p, PROBE_ID, blockIdx.x, gridDim.x, smem, lds);     \
    }                                                               \
    if ((k) + 1 < p.ph_hi) GSYNC(k);                                \
  }
  PHASE(0) PHASE(1) PHASE(2) PHASE(3) PHASE(4) PHASE(5) PHASE(6) PHASE(7) PHASE(8) PHASE(9) PHASE(10)
  PHASE(11) PHASE(12) PHASE(13) PHASE(14) PHASE(15) PHASE(16) PHASE(17) PHASE(18) PHASE(19) PHASE(20)
#undef PHASE
}

#ifndef SINGLE_LAUNCH
#define SINGLE_LAUNCH 1
#endif

extern "C" void kernel_launch(void* const* d_in, const int* in_sizes, int n_in, void* d_out, int out_size, void* d_ws,
                              size_t ws_size, hipStream_t stream) {
  if (ws_size < WS_NEEDED) {
    fprintf(stderr, "workspace too small: %zu < %zu\n", ws_size, (size_t)WS_NEEDED);
    return;
  }
  Params p{};
  const float** fp = (const float**)&p;
  for (int i = 0; i < 43; ++i) fp[i] = (const float*)d_in[i];
  p.out = (float*)d_out;
  p.ws = (char*)d_ws;
  static int grid_blocks = 0;
  if (!grid_blocks) {
    int dev = 0, cus = 0, per_cu = 0;
    hipGetDevice(&dev);
    hipDeviceGetAttribute(&cus, hipDeviceAttributeMultiprocessorCount, dev);
    hipFuncSetAttribute((const void*)fwd_megakernel, hipFuncAttributeMaxDynamicSharedMemorySize, SMEM_BYTES);
    hipOccupancyMaxActiveBlocksPerMultiprocessor(&per_cu, fwd_megakernel, NTH, SMEM_BYTES);
    if (per_cu > 1) per_cu = 1;
    grid_blocks = cus * per_cu;
  }
  hipMemsetAsync((char*)d_ws + OFF_BAR, 0, BAR_BYTES, stream);
#if SINGLE_LAUNCH
  p.ph_lo = 0;
  p.ph_hi = NPH;
  void* args[] = {&p};
  hipError_t e = hipLaunchCooperativeKernel((void*)fwd_megakernel, dim3(grid_blocks), dim3(NTH), args, SMEM_BYTES, stream);
  if (e != hipSuccess) fprintf(stderr, "cooperative launch failed: %s (grid %d)\n", hipGetErrorString(e), grid_blocks);
#else
  for (int ph = 0; ph < NPH; ++ph) {
    p.ph_lo = ph;
    p.ph_hi = ph + 1;
    fwd_megakernel<<<256, NTH, SMEM_BYTES, stream>>>(p);
  }
#endif
}
```
